# Optimizing an MI355X kernel written in HIP

```python
import jax, jax.numpy as jnp
from jax import lax
import numpy as np


D_MODEL = 1024
BATCH = 2
SEQ = 8192
DEPTH = 1

HEAD_DIM = 64
NSA_HEADS = 8
NSA_KV = 2
CMP_BLOCK = 32
CMP_STRIDE = 16
CMP_HIDDEN = 128
SEL_BLOCK = 64
SEL_TOPN = 16
NSA_WINDOW = 512
SWA_HEADS = 8
SWA_KV = 2
SWA_WINDOW = 128
Q_BLOCK = 128
ROPE_THETA = 10000.0
NEG = -1e30
N_EXPERTS = 32
TOP_K = 4
D_FF = 1024
SWIGLU_LIMIT = 7.0
SWIGLU_ALPHA = 1.702
MOE_BLOCK = 128
DN_ALPHA = (2.0 * DEPTH) ** 0.25
DN_BETA = (8.0 * DEPTH) ** -0.25
LN_EPS = 1e-5

NSA_Q = NSA_HEADS * HEAD_DIM
NSA_KVW = NSA_KV * HEAD_DIM
SWA_Q = SWA_HEADS * HEAD_DIM
SWA_KVW = SWA_KV * HEAD_DIM
IN_WIDTHS = (
    NSA_Q,
    NSA_KVW, NSA_KVW,
    NSA_KVW, NSA_KVW,
    NSA_KVW, NSA_KVW,
    NSA_HEADS * 3,
    SWA_Q, SWA_KVW, SWA_KVW,
    2 * D_MODEL,
)
IN_COLS = sum(IN_WIDTHS)
IN_SPLITS = tuple(sum(IN_WIDTHS[:i + 1]) for i in range(len(IN_WIDTHS) - 1))

kernel_name = 'hybrid_nsa_swasink_moe_deepnorm'


def layer_norm(x, g, b):
    xf = x.astype(jnp.float32)
    mu = jnp.mean(xf, -1, keepdims=True)
    var = jnp.mean(jnp.square(xf - mu), -1, keepdims=True)
    return ((xf - mu) * lax.rsqrt(var + LN_EPS) * g + b).astype(x.dtype)


def rope_tables(s):
    half = HEAD_DIM // 2
    inv = ROPE_THETA ** (-jnp.arange(half, dtype=jnp.float32) / half)
    ang = jnp.arange(s, dtype=jnp.float32)[:, None] * inv[None, :]
    return jnp.cos(ang), jnp.sin(ang)


def rope(t, cos, sin):
    half = HEAD_DIM // 2
    tf = t.astype(jnp.float32)
    t1, t2 = tf[..., :half], tf[..., half:]
    return jnp.concatenate([t1 * cos - t2 * sin, t2 * cos + t1 * sin], -1).astype(t.dtype)


def to_heads(t, n):
    b, s, _ = t.shape
    return t.reshape(b, s, n, HEAD_DIM).transpose(0, 2, 1, 3)


def from_heads(t):
    b, h, s, d = t.shape
    return t.transpose(0, 2, 1, 3).reshape(b, s, h * d)


def banded_attention(q, k, v, window, sinks=None):
    b, h, s, dh = q.shape
    g = k.shape[1]
    r = h // g
    nb = s // Q_BLOCK
    back = -(-window // Q_BLOCK)
    wlen = (back + 1) * Q_BLOCK
    qb = q.reshape(b, g, r, nb, Q_BLOCK, dh)

    def windows(t):
        tp = jnp.pad(t, ((0, 0), (0, 0), (back * Q_BLOCK, 0), (0, 0))).reshape(b, g, nb + back, Q_BLOCK, dh)
        return jnp.concatenate([tp[:, :, j:j + nb] for j in range(back + 1)], axis=3)

    kw, vw = windows(k), windows(v)
    qpos = jnp.arange(s).reshape(nb, Q_BLOCK)
    kpos = (jnp.arange(nb)[:, None] - back) * Q_BLOCK + jnp.arange(wlen)[None, :]
    rel = qpos[:, :, None] - kpos[:, None, :]
    mask = (rel >= 0) & (rel < window) & (kpos[:, None, :] >= 0)
    sc = jnp.einsum('bgrnqd,bgnkd->bgrnqk', qb, kw, preferred_element_type=jnp.float32) * (dh ** -0.5)
    sc = jnp.where(mask, sc, NEG)
    if sinks is None:
        p = jax.nn.softmax(sc, axis=-1)
    else:
        sk = sinks.astype(jnp.float32).reshape(1, g, r, 1, 1, 1)
        m = jnp.maximum(jnp.max(sc, -1, keepdims=True), sk)
        e = jnp.exp(sc - m)
        p = e / (jnp.sum(e, -1, keepdims=True) + jnp.exp(sk - m))
    o = jnp.einsum('bgrnqk,bgnkd->bgrnqd', p.astype(v.dtype), vw)
    return o.reshape(b, h, s, dh)


def nsa_compress(t, pe, w1, w2):
    s = t.shape[2]
    nc = (s - CMP_BLOCK) // CMP_STRIDE + 1
    idx = jnp.arange(nc)[:, None] * CMP_STRIDE + jnp.arange(CMP_BLOCK)[None, :]
    blk = t[:, :, idx] + pe
    flat = blk.reshape(blk.shape[0], blk.shape[1], nc, CMP_BLOCK * HEAD_DIM)
    return jax.nn.gelu(flat @ w1) @ w2


def nsa_attention(q, kc_raw, vc_raw, k_sel, v_sel, k_win, v_win, gate, cos, sin,
                  k_pe, k_w1, k_w2, v_pe, v_w1, v_w2):
    b, h, s, dh = q.shape
    g = NSA_KV
    r = h // g
    scale = dh ** -0.5
    pos = jnp.arange(s)
    kc = nsa_compress(kc_raw, k_pe, k_w1, k_w2)
    vc = nsa_compress(vc_raw, v_pe, v_w1, v_w2)
    nc = kc.shape[2]
    qg = q.reshape(b, g, r, s, dh)
    sc = jnp.einsum('bgrsd,bgcd->bgrsc', qg, kc, preferred_element_type=jnp.float32) * scale
    cend = jnp.arange(nc) * CMP_STRIDE + CMP_BLOCK - 1
    cmask = cend[None, :] <= pos[:, None]
    p_cmp = jax.nn.softmax(jnp.where(cmask, sc, NEG), axis=-1) * (pos >= CMP_BLOCK - 1)[:, None]
    o_cmp = jnp.einsum('bgrsc,bgcd->bgrsd', p_cmp.astype(vc.dtype), vc).reshape(b, h, s, dh)
    nsel = s // SEL_BLOCK
    cstart = jnp.arange(nc) * CMP_STRIDE
    sstart = jnp.arange(nsel) * SEL_BLOCK
    overlap = ((cstart[:, None] < sstart[None, :] + SEL_BLOCK) &
               (cstart[:, None] + CMP_BLOCK > sstart[None, :])).astype(jnp.float32)
    imp = jnp.einsum('bgrsc,cj->bgsj', p_cmp, overlap)
    cur = pos // SEL_BLOCK
    jb = jnp.arange(nsel)
    forced = (jb[None, :] == 0) | (jb[None, :] == cur[:, None]) | (jb[None, :] == cur[:, None] - 1)
    imp = jnp.where(jb[None, :] > cur[:, None], -1.0, jnp.where(forced, 1e6, imp))
    n_top = min(SEL_TOPN, nsel)
    _, sel = lax.top_k(imp, n_top)
    q_rot = rope(q, cos, sin)
    kb = rope(k_sel, cos, sin).reshape(b, g, nsel, SEL_BLOCK, dh)
    vb = v_sel.reshape(b, g, nsel, SEL_BLOCK, dh)
    nq = s // Q_BLOCK
    qr = q_rot.reshape(b, g, r, nq, Q_BLOCK, dh).transpose(3, 0, 1, 2, 4, 5)
    selr = sel.reshape(b, g, nq, Q_BLOCK, n_top).transpose(2, 0, 1, 3, 4)
    posr = pos.reshape(nq, Q_BLOCK)
    bi = jnp.arange(b)[:, None, None, None]
    gi = jnp.arange(g)[None, :, None, None]
    offs = jnp.arange(SEL_BLOCK)

    def sel_chunk(args):
        qc, sc_idx, pc = args
        ks = kb[bi, gi, sc_idx]
        vs = vb[bi, gi, sc_idx]
        kp = sc_idx[..., None] * SEL_BLOCK + offs
        msk = kp <= pc[None, None, :, None, None]
        ss = jnp.einsum('bgrqd,bgqnkd->bgrqnk', qc, ks, preferred_element_type=jnp.float32) * scale
        ss = jnp.where(msk[:, :, None], ss, NEG)
        p = jax.nn.softmax(ss, axis=(-2, -1))
        return jnp.einsum('bgrqnk,bgqnkd->bgrqd', p.astype(vs.dtype), vs)

    o_sel = lax.map(sel_chunk, (qr, selr, posr))
    o_sel = o_sel.transpose(1, 2, 3, 0, 4, 5).reshape(b, h, s, dh)
    o_win = banded_attention(q_rot, rope(k_win, cos, sin), v_win, NSA_WINDOW)
    gt = jax.nn.sigmoid(gate.astype(jnp.float32)).reshape(b, s, h, 3).transpose(0, 2, 1, 3)[..., None]
    o = gt[:, :, :, 0] * o_cmp + gt[:, :, :, 1] * o_sel + gt[:, :, :, 2] * o_win
    return o.astype(q.dtype)


def moe_ffn(x, w_router, b_router, w_e_in, b_e_in, w_e_out, b_e_out):
    b, s, d = x.shape
    t = b * s
    a = t * TOP_K
    xf = x.reshape(t, d)
    logits = (xf @ w_router).astype(jnp.float32) + b_router
    top_v, top_e = lax.top_k(logits, TOP_K)
    gates = jax.nn.softmax(top_v, axis=-1)
    flat_e = top_e.reshape(a)
    flat_t = jnp.arange(a, dtype=jnp.int32) // TOP_K
    flat_g = gates.reshape(a)
    order = jnp.argsort(flat_e)
    se = flat_e[order]
    counts = jnp.bincount(flat_e, length=N_EXPERTS)
    padded = (counts + MOE_BLOCK - 1) // MOE_BLOCK * MOE_BLOCK
    start = jnp.cumsum(counts) - counts
    pend = jnp.cumsum(padded)
    pstart = pend - padded
    dest = pstart[se] + jnp.arange(a) - start[se]
    n_blk = -(-a // MOE_BLOCK) + N_EXPERTS
    n_rows = n_blk * MOE_BLOCK
    row_t = jnp.zeros((n_rows,), jnp.int32).at[dest].set(flat_t[order])
    row_g = jnp.zeros((n_rows,), jnp.float32).at[dest].set(flat_g[order])
    blk_e = jnp.minimum(jnp.searchsorted(pend, jnp.arange(n_blk) * MOE_BLOCK, side='right'), N_EXPERTS - 1)
    xs = xf[row_t].reshape(n_blk, MOE_BLOCK, d)

    def expert_block(args):
        xb, e = args
        hdn = xb @ w_e_in[e] + b_e_in[e]
        hg = jnp.minimum(hdn[:, :D_FF], SWIGLU_LIMIT)
        hu = jnp.clip(hdn[:, D_FF:], -SWIGLU_LIMIT, SWIGLU_LIMIT)
        act = hg * jax.nn.sigmoid(SWIGLU_ALPHA * hg) * (hu + 1.0)
        return act @ w_e_out[e] + b_e_out[e]

    ys = lax.map(expert_block, (xs, blk_e)).reshape(n_rows, d)
    out = jax.ops.segment_sum(ys.astype(jnp.float32) * row_g[:, None], row_t, num_segments=t)
    return out.reshape(b, s, d).astype(x.dtype)


def hybrid_layer(x, cos, sin, w_in, nsa_k_pe, nsa_k_w1, nsa_k_w2, nsa_v_pe, nsa_v_w1, nsa_v_w2,
                 swa_sinks, w_br_nsa, w_br_swa, w_out, ln1_g, ln1_b, w_router, b_router,
                 w_expert_in, b_expert_in, w_expert_out, b_expert_out, ln2_g, ln2_b):
    d = x.shape[-1]
    proj = x @ w_in
    (q_n, kc_n, vc_n, ks_n, vs_n, kw_n, vw_n, g_n, q_s, k_s, v_s, g_m) = jnp.split(proj, IN_SPLITS, axis=-1)
    o_nsa = nsa_attention(to_heads(q_n, NSA_HEADS), to_heads(kc_n, NSA_KV), to_heads(vc_n, NSA_KV),
                          to_heads(ks_n, NSA_KV), to_heads(vs_n, NSA_KV), to_heads(kw_n, NSA_KV),
                          to_heads(vw_n, NSA_KV), g_n, cos, sin,
                          nsa_k_pe, nsa_k_w1, nsa_k_w2, nsa_v_pe, nsa_v_w1, nsa_v_w2)
    o_swa = banded_attention(rope(to_heads(q_s, SWA_HEADS), cos, sin), rope(to_heads(k_s, SWA_KV), cos, sin),
                             to_heads(v_s, SWA_KV), SWA_WINDOW, swa_sinks)
    y_nsa = from_heads(o_nsa) @ w_br_nsa
    y_swa = from_heads(o_swa) @ w_br_swa
    gm = jax.nn.sigmoid(g_m.astype(jnp.float32))
    mixed = (gm[..., :d] * y_nsa + gm[..., d:] * y_swa).astype(x.dtype)
    h = layer_norm(DN_ALPHA * x + mixed @ w_out, ln1_g, ln1_b)
    f = moe_ffn(h, w_router, b_router, w_expert_in, b_expert_in, w_expert_out, b_expert_out)
    return layer_norm(DN_ALPHA * h + f, ln2_g, ln2_b)


def setup_inputs(seed: int = 0) -> dict:
    key = jax.random.key(seed)
    ks = jax.random.split(key, 24)
    L, D, E, F = DEPTH, D_MODEL, N_EXPERTS, D_FF
    cw = CMP_BLOCK * HEAD_DIM

    def nrm(k, shape, scale):
        return jax.random.normal(k, shape, jnp.float32) * scale

    return {
        'x': nrm(ks[0], (BATCH, SEQ, D), 1.0),
        'w_in': nrm(ks[1], (L, D, IN_COLS), D ** -0.5),
        'nsa_k_pe': nrm(ks[2], (L, CMP_BLOCK, HEAD_DIM), 0.1),
        'nsa_k_w1': nrm(ks[3], (L, cw, CMP_HIDDEN), cw ** -0.5),
        'nsa_k_w2': nrm(ks[4], (L, CMP_HIDDEN, HEAD_DIM), CMP_HIDDEN ** -0.5),
        'nsa_v_pe': nrm(ks[5], (L, CMP_BLOCK, HEAD_DIM), 0.1),
        'nsa_v_w1': nrm(ks[6], (L, cw, CMP_HIDDEN), cw ** -0.5),
        'nsa_v_w2': nrm(ks[7], (L, CMP_HIDDEN, HEAD_DIM), CMP_HIDDEN ** -0.5),
        'swa_sinks': nrm(ks[8], (L, SWA_HEADS), 0.5),
        'w_br_nsa': nrm(ks[9], (L, NSA_Q, D), NSA_Q ** -0.5),
        'w_br_swa': nrm(ks[10], (L, SWA_Q, D), SWA_Q ** -0.5),
        'w_out': nrm(ks[11], (L, D, D), DN_BETA * D ** -0.5),
        'ln1_g': 1.0 + nrm(ks[12], (L, D), 0.01),
        'ln1_b': nrm(ks[13], (L, D), 0.01),
        'w_router': nrm(ks[14], (L, D, E), D ** -0.5),
        'b_router': nrm(ks[15], (L, E), 0.01),
        'w_expert_in': nrm(ks[16], (L, E, D, 2 * F), D ** -0.5),
        'b_expert_in': nrm(ks[17], (L, E, 2 * F), 0.01),
        'w_expert_out': nrm(ks[18], (L, E, F, D), DN_BETA * F ** -0.5),
        'b_expert_out': nrm(ks[19], (L, E, D), 0.01),
        'ln2_g': 1.0 + nrm(ks[20], (L, D), 0.01),
        'ln2_b': nrm(ks[21], (L, D), 0.01),
    }


def reference(x, w_in, nsa_k_pe, nsa_k_w1, nsa_k_w2, nsa_v_pe, nsa_v_w1, nsa_v_w2, swa_sinks,
              w_br_nsa, w_br_swa, w_out, ln1_g, ln1_b, w_router, b_router, w_expert_in, b_expert_in,
              w_expert_out, b_expert_out, ln2_g, ln2_b):
    cos, sin = rope_tables(x.shape[1])
    for l in range(DEPTH):
        x = hybrid_layer(x, cos, sin, w_in[l], nsa_k_pe[l], nsa_k_w1[l], nsa_k_w2[l], nsa_v_pe[l],
                         nsa_v_w1[l], nsa_v_w2[l], swa_sinks[l], w_br_nsa[l], w_br_swa[l], w_out[l],
                         ln1_g[l], ln1_b[l], w_router[l], b_router[l], w_expert_in[l], b_expert_in[l],
                         w_expert_out[l], b_expert_out[l], ln2_g[l], ln2_b[l])
    return x
```

```cpp
#include <hip/hip_runtime.h>
#include <cstdio>
#include <cstdint>

#ifndef MK_ONE_LAUNCH
#define MK_ONE_LAUNCH 0
#endif

#define LAS __attribute__((address_space(3)))
#define GAS __attribute__((address_space(1)))
typedef unsigned short bf16_t;
typedef short bf16x8 __attribute__((ext_vector_type(8)));
typedef float f32x4 __attribute__((ext_vector_type(4)));
typedef unsigned u32x4 __attribute__((ext_vector_type(4)));
typedef unsigned u32x2 __attribute__((ext_vector_type(2)));
typedef GAS unsigned gu32;
#define RLX_AGENT __ATOMIC_RELAXED, __HIP_MEMORY_SCOPE_AGENT
#define WSYNC() asm volatile("s_waitcnt lgkmcnt(0)" ::: "memory")
#define VM_WAIT() asm volatile("s_waitcnt vmcnt(0)" ::: "memory")

constexpr int NB = 2, SEQ = 8192, DM = 1024, NTOK = NB * SEQ, HD = 64;
constexpr int NVC = 4352;
constexpr int IN_COLS = 4120;
constexpr int NEXP = 32, DFF = 1024;
constexpr int NCMP = 511, NCMP_PAD = 512, NSEL = 128;
constexpr float C2 = 0.125f * 1.4426950408889634f;
constexpr float LOG2E = 1.4426950408889634f;
constexpr float DN_ALPHA = 1.189207115002721f;
constexpr float LN_EPS = 1e-5f;
constexpr int NWAVES = 8, NTHREADS = 512;
constexpr int MOE_RT = 128;

enum { I_X = 0, I_WIN, I_KPE, I_KW1, I_KW2, I_VPE, I_VW1, I_VW2, I_SINK, I_WBRN, I_WBRS, I_WOUT, I_LN1G, I_LN1B, I_WR, I_BR, I_WEIN, I_BEIN, I_WEOUT, I_BEOUT, I_LN2G, I_LN2B, N_IN };

constexpr size_t MiB = 1u << 20;
constexpr size_t WS_CTL = 0, CTL_ZERO_BYTES = 1 * MiB;
constexpr size_t WS_COS = 1 * MiB, WS_SIN = 2 * MiB;
constexpr size_t WS_C1K = 3 * MiB, WS_C1V = 3 * MiB + 4096;
constexpr size_t WS_W1KT = 3 * MiB + 65536, WS_W1VT = WS_W1KT + 524288;
constexpr size_t WS_W2KT = WS_W1VT + 524288, WS_W2VT = WS_W2KT + 32768;
constexpr size_t WS_WBRN = 5 * MiB, WS_WBRS = 6 * MiB;
constexpr size_t WS_WOUT = 7 * MiB;
constexpr size_t WS_WIN = 9 * MiB;
constexpr size_t WS_KV = 18 * MiB, KV_BYTES = 4 * MiB;
constexpr size_t WS_CMP = 50 * MiB;
constexpr size_t WS_KCMP = WS_CMP, WS_VCMP = WS_CMP + 262144, WS_HIDK = WS_CMP + 524288, WS_HIDV = WS_CMP + 1048576;
constexpr size_t WS_QC = 52 * MiB, WS_QR = 68 * MiB, WS_QS = 84 * MiB;
constexpr size_t WS_GN = 100 * MiB;
constexpr size_t WS_SEL = 102 * MiB;
constexpr size_t WS_TOPE = 103 * MiB, WS_TOPG = WS_TOPE + 262144, WS_TOPP = WS_TOPG + 262144, WS_TOK = 104 * MiB;
constexpr size_t WS_XB = 108 * MiB;
constexpr size_t WS_GM = 140 * MiB;
constexpr size_t WS_ONSA = 236 * MiB, WS_OSWA = 252 * MiB;
constexpr size_t WS_MIXED = 268 * MiB;
constexpr size_t WS_HB = 300 * MiB;
constexpr size_t WS_WEIN = 332 * MiB;
constexpr size_t WS_WEOUT = 460 * MiB;
constexpr size_t WS_ACT = 524 * MiB;
constexpr size_t WS_YS = 668 * MiB;
constexpr size_t WS_PROJ = 524 * MiB;
constexpr size_t WS_END = 812 * MiB;
constexpr int CW_BAR = 4096;
constexpr int CW_CNT = 16384;

constexpr int LDS_BYTES = 147456;
constexpr int WAVE_SCR = 18176;
constexpr int MISC_OFF = 145408;

__device__ __forceinline__ float bf2f(bf16_t v) { return __uint_as_float(((unsigned)v) << 16); }
__device__ __forceinline__ unsigned f2bf(float f) { unsigned u = __float_as_uint(f); return (u + 0x7fffu + ((u >> 16) & 1u)) >> 16; }
__device__ __forceinline__ unsigned pk2(float lo, float hi) { return f2bf(lo) | (f2bf(hi) << 16); }
__device__ __forceinline__ float sigmoidf_(float x) { return 1.0f / (1.0f + __expf(-x)); }
__device__ __forceinline__ float wave_sum(float v) {
#pragma unroll
    for (int o = 1; o < 64; o <<= 1) v += __shfl_xor(v, o);
    return v;
}
__device__ __forceinline__ float wave_max(float v) {
#pragma unroll
    for (int o = 1; o < 64; o <<= 1) v = fmaxf(v, __shfl_xor(v, o));
    return v;
}

#define XB_TMO      128
#define XB_XCNT(j)  (256  + 64 * (j))
#define XB_XSUB(j)  (1280 + 64 * (j))
#define XB_XGEN(j)  (2304 + 64 * (j))
#define XB_TOP      3328
#define XB_TOPGEN   3392
#define XCD_BAR_WORDS 3456
#define XB_SPIN_CAP (1u << 22)
__device__ __forceinline__ unsigned xb_ld(unsigned* p)              { return __hip_atomic_load(p, __ATOMIC_RELAXED, __HIP_MEMORY_SCOPE_AGENT); }
__device__ __forceinline__ unsigned xb_add(unsigned* p, unsigned v) { return __hip_atomic_fetch_add(p, v, __ATOMIC_RELAXED, __HIP_MEMORY_SCOPE_AGENT); }
__device__ __forceinline__ unsigned xb_xcc_id() { return (unsigned)__builtin_amdgcn_s_getreg((3 << 11) | 20) & 0xFu; }
#define XB_SPIN(cond, bar) do { unsigned _sp = 0; while (cond) { __builtin_amdgcn_s_sleep(1); \
    if ((++_sp & 255u) == 0u) { if (xb_ld(&(bar)[XB_TMO])) break; if (_sp > XB_SPIN_CAP) { atomicAdd(&(bar)[XB_TMO], 1u); break; } } } } while (0)
struct XcdBarrier { unsigned* bar; unsigned x; volatile LAS unsigned* st; };
__device__ __forceinline__ XcdBarrier xcd_barrier_post(unsigned* bar, volatile LAS unsigned* st) {
    XcdBarrier b; b.bar = bar; b.x = xb_xcc_id(); b.st = st;
    if (threadIdx.x == 0) (void)xb_add(&bar[XB_XCNT(b.x)], 1u);
    return b;
}
__device__ __forceinline__ void xcd_barrier_complete(unsigned* bar, unsigned x, unsigned& nloc, unsigned& nx) {
    const unsigned G = gridDim.x * gridDim.y * gridDim.z;
    unsigned sum, cnt, mine, sp = 0u;
    for (;;) {
        sum = 0u; cnt = 0u; mine = 0u;
#pragma unroll
        for (unsigned j = 0; j < 16; ++j) { const unsigned c = xb_ld(&bar[XB_XCNT(j)]); sum += c; cnt += (c > 0u) ? 1u : 0u; mine = (j == x) ? c : mine; }
        if (sum == G) break;
        __builtin_amdgcn_s_sleep(1);
        if ((++sp & 255u) == 0u) { if (xb_ld(&bar[XB_TMO])) break; if (sp > XB_SPIN_CAP) { atomicAdd(&bar[XB_TMO], 1u); break; } }
    }
    nloc = mine > 0u ? mine : 1u; nx = cnt > 0u ? cnt : 1u;
}
__device__ __forceinline__ void xcd_barrier(const XcdBarrier& b) {
    asm volatile("s_waitcnt vmcnt(0)" ::: "memory");
    __syncthreads();
    if (threadIdx.x == 0) {
        unsigned* bar = b.bar;
        __builtin_amdgcn_s_waitcnt(0);
        unsigned nloc = b.st[0], nx = b.st[1];
        if (nloc == 0u) { xcd_barrier_complete(bar, b.x, nloc, nx); b.st[0] = nloc; b.st[1] = nx; }
        const unsigned old = xb_add(&bar[XB_XSUB(b.x)], 1u);
        const unsigned gen = old / nloc;
        if (old + 1u == (gen + 1u) * nloc) {
            __builtin_amdgcn_fence(__ATOMIC_RELEASE, "agent");
            asm volatile("s_waitcnt vmcnt(0)" ::: "memory");
            const unsigned og = xb_add(&bar[XB_TOP], 1u);
            const unsigned tg = og / nx;
            if (og + 1u == (tg + 1u) * nx) xb_add(&bar[XB_TOPGEN], 1u);
            else XB_SPIN(xb_ld(&bar[XB_TOPGEN]) == tg, bar);
            __builtin_amdgcn_fence(__ATOMIC_ACQUIRE, "agent");
            xb_add(&bar[XB_XGEN(b.x)], 1u);
            asm volatile("s_waitcnt vmcnt(0)" ::: "memory");
        } else {
            XB_SPIN(xb_ld(&bar[XB_XGEN(b.x)]) == gen, bar);
            __builtin_amdgcn_fence(__ATOMIC_ACQUIRE, "agent");
            asm volatile("s_waitcnt vmcnt(0)" ::: "memory");
        }
    }
    __syncthreads();
}

struct Args { const float* in[N_IN]; float* out; unsigned char* ws; int ph_lo, ph_hi; };
struct Frame {
    LAS unsigned char* lds;
    unsigned char* ws;
    const float* const* in;
    float* out;
    int tid, lane, wave, G, bid;
};

template <bool HAS_B1>
__device__ __forceinline__ void gemm_kloop(LAS unsigned char* lds, const bf16_t* a, const bf16_t* b0, const bf16_t* b1, int K, f32x4 (&acc)[4][2][2], int wid, int lane) {
    const int wr = wid >> 2, wc = wid & 3, fr = lane & 15, fq = lane >> 4;
    const unsigned ldsw = (unsigned)wid * 1024u;
    for (int k0 = 0; k0 < K; k0 += 32) {
        __builtin_amdgcn_global_load_lds((const unsigned*)(a + k0), (LAS unsigned*)(lds + ldsw), 16, 0, 0);
        __builtin_amdgcn_global_load_lds((const unsigned*)(b0 + k0), (LAS unsigned*)(lds + 8192 + ldsw), 16, 0, 0);
        if (HAS_B1) __builtin_amdgcn_global_load_lds((const unsigned*)(b1 + k0), (LAS unsigned*)(lds + 16384 + ldsw), 16, 0, 0);
        asm volatile("s_waitcnt vmcnt(0)" ::: "memory");
        __syncthreads();
        bf16x8 af[4], bfr[2][2];
#pragma unroll
        for (int m = 0; m < 4; ++m) af[m] = *(const LAS bf16x8*)(lds + (wr * 64 + m * 16 + fr) * 64 + fq * 16);
#pragma unroll
        for (int bj = 0; bj < (HAS_B1 ? 2 : 1); ++bj)
#pragma unroll
            for (int n = 0; n < 2; ++n) bfr[bj][n] = *(const LAS bf16x8*)(lds + 8192 + bj * 8192 + (wc * 32 + n * 16 + fr) * 64 + fq * 16);
#pragma unroll
        for (int m = 0; m < 4; ++m)
#pragma unroll
            for (int bj = 0; bj < (HAS_B1 ? 2 : 1); ++bj)
#pragma unroll
                for (int n = 0; n < 2; ++n) acc[m][bj][n] = __builtin_amdgcn_mfma_f32_16x16x32_bf16(bfr[bj][n], af[m], acc[m][bj][n], 0, 0, 0);
        __syncthreads();
    }
}
__device__ __forceinline__ void acc_zero(f32x4 (&acc)[4][2][2]) {
#pragma unroll
    for (int m = 0; m < 4; ++m)
#pragma unroll
        for (int bj = 0; bj < 2; ++bj)
#pragma unroll
            for (int n = 0; n < 2; ++n) acc[m][bj][n] = (f32x4){0.f, 0.f, 0.f, 0.f};
}

__device__ __forceinline__ int win_src_col(int v, int& nvalid) {
    const int pn = v >> 8, bj = (v >> 7) & 1, hd = (v >> 5) & 3;
    nvalid = 32;
    if (pn < 2) return (4 * pn + hd) * 64 + 32 * bj;
    if (pn == 2) return (hd < 2 ? 512 + hd * 64 : 640 + (hd - 2) * 64) + 32 * bj;
    if (pn == 3) return (hd < 2 ? 768 + hd * 64 : 896 + (hd - 2) * 64) + 32 * bj;
    if (pn == 4) return (hd < 2 ? 1024 + hd * 64 : 1152 + (hd - 2) * 64) + 32 * bj;
    if (pn < 7) return 1304 + (4 * (pn - 5) + hd) * 64 + 32 * bj;
    if (pn == 7) return (hd < 2 ? 1816 + hd * 64 : 1944 + (hd - 2) * 64) + 32 * bj;
    if (pn < 16) return 2072 + (v - 2048);
    if (v == 4096) { nvalid = 24; return 1280; }
    nvalid = 0; return 0;
}
__device__ __forceinline__ void tr_item(const float* W, int ldw, int srccol0, int nvalid, int K, bf16_t* WT, int k0, LAS float* scr, int lane) {
#pragma unroll 8
    for (int i = 0; i < 32; ++i) { const int kk = 2 * i + (lane >> 5), n = lane & 31; scr[kk * 33 + n] = (n < nvalid) ? W[(size_t)(k0 + kk) * ldw + srccol0 + n] : 0.f; }
    WSYNC();
    const int c = lane & 7;
#pragma unroll
    for (int j = 0; j < 4; ++j) { const int n = (lane >> 3) + 8 * j; const LAS float* s = scr + (8 * c) * 33 + n;
        u32x4 o; o.x = pk2(s[0 * 33], s[1 * 33]); o.y = pk2(s[2 * 33], s[3 * 33]); o.z = pk2(s[4 * 33], s[5 * 33]); o.w = pk2(s[6 * 33], s[7 * 33]);
        *(u32x4*)(WT + (size_t)n * K + k0 + 8 * c) = o; }
    WSYNC();
}
__device__ __forceinline__ void phase_prologue(Frame& F) {
    const int gw = F.bid * NWAVES + F.wave, NGW = F.G * NWAVES;
    const int gt = F.bid * NTHREADS + F.tid, NGT = F.G * NTHREADS;
    LAS float* scr = (LAS float*)(F.lds + F.wave * 16384);
    unsigned char* ws = F.ws;
    { const f32x4* x4 = (const f32x4*)F.in[I_X]; u32x2* o = (u32x2*)(ws + WS_XB);
      for (int i = gt; i < NTOK * DM / 4; i += NGT) { const f32x4 v = x4[i]; u32x2 w; w.x = pk2(v.x, v.y); w.y = pk2(v.z, v.w); o[i] = w; } }
    { float* cs = (float*)(ws + WS_COS); float* sn = (float*)(ws + WS_SIN);
      for (int i = gt; i < SEQ * 32; i += NGT) { const int pos = i >> 5, j = i & 31;
          const float inv = powf(10000.0f, -(float)j / 32.0f); const float ang = (float)pos * inv;
          double t = (double)ang * 0.15915494309189535; t -= floor(t); const float tf = (float)t;
          cs[i] = __builtin_amdgcn_cosf(tf); sn[i] = __builtin_amdgcn_sinf(tf); } }
    { for (int i = gt; i < 256; i += NGT) { const int which = i >> 7, j = i & 127; const float* pe = F.in[which ? I_VPE : I_KPE]; const float* w1 = F.in[which ? I_VW1 : I_KW1];
          float s = 0.f; for (int f = 0; f < 2048; ++f) s += pe[f] * w1[(size_t)f * 128 + j];
          ((float*)(ws + (which ? WS_C1V : WS_C1K)))[j] = s; } }
    constexpr int IT_WIN = 16 * (NVC / 32), IT_BR = 8 * 32, IT_WOUT = 16 * 32, IT_W1 = 32 * 4, IT_W2 = 2 * 2, IT_EIN = 16 * 64, IT_EOUT = 16 * 32;
    constexpr int O_WIN = 0, O_BRN = O_WIN + IT_WIN, O_BRS = O_BRN + IT_BR, O_WOUT = O_BRS + IT_BR, O_W1K = O_WOUT + IT_WOUT, O_W1V = O_W1K + IT_W1, O_W2K = O_W1V + IT_W1, O_W2V = O_W2K + IT_W2,
                  O_EIN = O_W2V + IT_W2, O_EOUT = O_EIN + NEXP * IT_EIN, O_END = O_EOUT + NEXP * IT_EOUT;
    for (int it = gw; it < O_END; it += NGW) {
        if (it < O_BRN) { const int r = it - O_WIN, nblk = NVC / 32, kb = r / nblk, nb = r % nblk; int nv; const int sc = win_src_col(nb * 32, nv);
            tr_item(F.in[I_WIN], IN_COLS, sc, nv, 1024, (bf16_t*)(ws + WS_WIN) + (size_t)nb * 32 * 1024, kb * 64, scr, F.lane); }
        else if (it < O_WOUT) { const bool s = it >= O_BRS; const int r = it - (s ? O_BRS : O_BRN), kb = r / 32, nb = r % 32;
            tr_item(F.in[s ? I_WBRS : I_WBRN], 1024, nb * 32, 32, 512, (bf16_t*)(ws + (s ? WS_WBRS : WS_WBRN)) + (size_t)nb * 32 * 512, kb * 64, scr, F.lane); }
        else if (it < O_W1K) { const int r = it - O_WOUT, kb = r / 32, nb = r % 32;
            tr_item(F.in[I_WOUT], 1024, nb * 32, 32, 1024, (bf16_t*)(ws + WS_WOUT) + (size_t)nb * 32 * 1024, kb * 64, scr, F.lane); }
        else if (it < O_W2K) { const bool s = it >= O_W1V; const int r = it - (s ? O_W1V : O_W1K), kb = r / 4, nb = r % 4;
            tr_item(F.in[s ? I_VW1 : I_KW1], 128, nb * 32, 32, 2048, (bf16_t*)(ws + (s ? WS_W1VT : WS_W1KT)) + (size_t)nb * 32 * 2048, kb * 64, scr, F.lane); }
        else if (it < O_EIN) { const bool s = it >= O_W2V; const int r = it - (s ? O_W2V : O_W2K), kb = r / 2, nb = r % 2;
            tr_item(F.in[s ? I_VW2 : I_KW2], 64, nb * 32, 32, 128, (bf16_t*)(ws + (s ? WS_W2VT : WS_W2KT)) + (size_t)nb * 32 * 128, kb * 64, scr, F.lane); }
        else if (it < O_EOUT) { const int r0 = it - O_EIN, e = r0 / IT_EIN, r = r0 % IT_EIN, kb = r / 64, nb = r % 64;
            tr_item(F.in[I_WEIN] + (size_t)e * 1024 * 2048, 2048, nb * 32, 32, 1024, (bf16_t*)(ws + WS_WEIN) + ((size_t)e * 2048 + nb * 32) * 1024, kb * 64, scr, F.lane); }
        else { const int r0 = it - O_EOUT, e = r0 / IT_EOUT, r = r0 % IT_EOUT, kb = r / 32, nb = r % 32;
            tr_item(F.in[I_WEOUT] + (size_t)e * 1024 * 1024, 1024, nb * 32, 32, 1024, (bf16_t*)(ws + WS_WEOUT) + ((size_t)e * 1024 + nb * 32) * 1024, kb * 64, scr, F.lane); }
    }
}

__device__ __forceinline__ void phase_inproj(Frame& F) {
    const bf16_t* XB = (const bf16_t*)(F.ws + WS_XB); const bf16_t* WT = (const bf16_t*)(F.ws + WS_WIN); float* PROJ = (float*)(F.ws + WS_PROJ);
    const int wr = F.wave >> 2, wc = F.wave & 3, fr = F.lane & 15, fq = F.lane >> 4;
    constexpr int NPN = NVC / 256, NU = (NTOK / 128) * NPN;
    for (int u = F.bid; u < NU; u += F.G) {
        const int pm = u / NPN, pn = u % NPN;
        const bf16_t* a = XB + (size_t)(pm * 128 + (F.tid >> 2)) * 1024 + (F.tid & 3) * 8;
        const bf16_t* b0 = WT + (size_t)(pn * 256 + (F.tid >> 2)) * 1024 + (F.tid & 3) * 8;
        f32x4 acc[4][2][2]; acc_zero(acc);
        gemm_kloop<true>(F.lds, a, b0, b0 + 128 * 1024, 1024, acc, F.wave, F.lane);
#pragma unroll
        for (int m = 0; m < 4; ++m) { float* rp = PROJ + (size_t)(pm * 128 + wr * 64 + m * 16 + fr) * NVC + pn * 256 + wc * 32 + 4 * fq;
#pragma unroll
            for (int bj = 0; bj < 2; ++bj)
#pragma unroll
                for (int n = 0; n < 2; ++n) *(f32x4*)(rp + bj * 128 + n * 16) = acc[m][bj][n]; }
    }
}

__device__ __forceinline__ bf16_t* kv_tensor(unsigned char* ws, int idx) { return (bf16_t*)(ws + WS_KV + (size_t)idx * KV_BYTES); }
__device__ __forceinline__ void phase_scatter(Frame& F) {
    unsigned char* ws = F.ws; const float* PROJ = (const float*)(ws + WS_PROJ);
    const float* COS = (const float*)(ws + WS_COS); const float* SIN = (const float*)(ws + WS_SIN);
    const int gt = F.bid * NTHREADS + F.tid, NGT = F.G * NTHREADS;
    for (int it = gt; it < NTOK * 256; it += NGT) {
        const int row = it >> 8, r = it & 255, pn = r >> 5, hd = (r >> 3) & 3, dlo = (r & 7) * 4;
        const float* p = PROJ + (size_t)row * NVC + pn * 256 + hd * 32 + dlo;
        const f32x4 a = *(const f32x4*)p, b = *(const f32x4*)(p + 128);
        const int pos = row & (SEQ - 1), bb = row >> 13;
        const f32x4 cs = *(const f32x4*)(COS + pos * 32 + dlo), sn = *(const f32x4*)(SIN + pos * 32 + dlo);
        const f32x4 ra = a * cs - b * sn, rb = b * cs + a * sn;
        if (pn < 2 || pn == 5 || pn == 6) {
            const int head = (pn < 2 ? 4 * pn : 4 * (pn - 5)) + hd;
            bf16_t* qr = (bf16_t*)(ws + (pn < 2 ? WS_QR : WS_QS)) + (size_t)row * 512 + head * 64 + dlo;
            u32x2 w; w.x = pk2(ra.x * C2, ra.y * C2); w.y = pk2(ra.z * C2, ra.w * C2); *(u32x2*)qr = w;
            w.x = pk2(rb.x * C2, rb.y * C2); w.y = pk2(rb.z * C2, rb.w * C2); *(u32x2*)(qr + 32) = w;
            if (pn < 2) { bf16_t* qc = (bf16_t*)(ws + WS_QC) + (size_t)row * 512 + head * 64 + dlo;
                w.x = pk2(a.x * C2, a.y * C2); w.y = pk2(a.z * C2, a.w * C2); *(u32x2*)qc = w;
                w.x = pk2(b.x * C2, b.y * C2); w.y = pk2(b.z * C2, b.w * C2); *(u32x2*)(qc + 32) = w; }
        } else {
            const int pair = (pn == 2) ? 0 : (pn == 3) ? 1 : (pn == 4) ? 2 : 3;
            const bool isv = hd >= 2; const int g = hd & 1; const bool rope = !isv && pair != 0;
            bf16_t* dst = kv_tensor(ws, pair * 2 + (isv ? 1 : 0)) + ((size_t)(bb * 2 + g) * SEQ + pos) * 64 + dlo;
            const f32x4 oa = rope ? ra : a, ob = rope ? rb : b;
            u32x2 w; w.x = pk2(oa.x, oa.y); w.y = pk2(oa.z, oa.w); *(u32x2*)dst = w;
            w.x = pk2(ob.x, ob.y); w.y = pk2(ob.z, ob.w); *(u32x2*)(dst + 32) = w;
        }
    }
    { bf16_t* GM = (bf16_t*)(ws + WS_GM);
      for (int it = gt; it < NTOK * 512; it += NGT) { const int row = it >> 9, c = (it & 511) * 4;
          const f32x4 v = *(const f32x4*)(PROJ + (size_t)row * NVC + 2048 + c);
          u32x2 w; w.x = pk2(sigmoidf_(v.x), sigmoidf_(v.y)); w.y = pk2(sigmoidf_(v.z), sigmoidf_(v.w)); *(u32x2*)(GM + (size_t)row * 2048 + c) = w; } }
    { float* GN = (float*)(ws + WS_GN);
      for (int it = gt; it < NTOK * 24; it += NGT) { const int row = it / 24, c = it % 24; GN[it] = sigmoidf_(PROJ[(size_t)row * NVC + 4096 + c]); } }
}

__device__ __forceinline__ float gelu_tanh(float x) { const float u = 0.7978845608028654f * (x + 0.044715f * x * x * x); return 0.5f * x * (1.0f + tanhf(u)); }
__device__ __forceinline__ void phase_cmp1(Frame& F) {
    unsigned char* ws = F.ws;
    const int wr = F.wave >> 2, wc = F.wave & 3, fr = F.lane & 15, fq = F.lane >> 4;
    for (int u = F.bid; u < 32; u += F.G) {
        const int which = u >> 4, bg = (u >> 2) & 3, rt = u & 3;
        const bf16_t* src = kv_tensor(ws, which) + (size_t)bg * SEQ * 64;
        const bf16_t* a = src + (size_t)(rt * 128 + (F.tid >> 2)) * 1024 + (F.tid & 3) * 8;
        const bf16_t* b0 = (const bf16_t*)(ws + (which ? WS_W1VT : WS_W1KT)) + (size_t)(F.tid >> 2) * 2048 + (F.tid & 3) * 8;
        const float* c1 = (const float*)(ws + (which ? WS_C1V : WS_C1K));
        bf16_t* HID = (bf16_t*)(ws + (which ? WS_HIDV : WS_HIDK)) + (size_t)bg * 512 * 128;
        f32x4 acc[4][2][2]; acc_zero(acc);
        gemm_kloop<false>(F.lds, a, b0, b0, 2048, acc, F.wave, F.lane);
#pragma unroll
        for (int m = 0; m < 4; ++m) { const int row = rt * 128 + wr * 64 + m * 16 + fr;
#pragma unroll
            for (int n = 0; n < 2; ++n) { const int col = wc * 32 + n * 16 + 4 * fq; const f32x4 bv = *(const f32x4*)(c1 + col); const f32x4 v = acc[m][0][n] + bv;
                u32x2 w; w.x = pk2(gelu_tanh(v.x), gelu_tanh(v.y)); w.y = pk2(gelu_tanh(v.z), gelu_tanh(v.w)); *(u32x2*)(HID + (size_t)row * 128 + col) = w; } }
    }
}
__device__ __forceinline__ void phase_cmp2(Frame& F) {
    unsigned char* ws = F.ws;
    const int wr = F.wave >> 2, wc = F.wave & 3, fr = F.lane & 15, fq = F.lane >> 4;
    for (int u = F.bid; u < 32; u += F.G) {
        const int which = u >> 4, bg = (u >> 2) & 3, rt = u & 3;
        const bf16_t* HID = (const bf16_t*)(ws + (which ? WS_HIDV : WS_HIDK)) + (size_t)bg * 512 * 128;
        const bf16_t* a = HID + (size_t)(rt * 128 + (F.tid >> 2)) * 128 + (F.tid & 3) * 8;
        const bf16_t* b0 = (const bf16_t*)(ws + (which ? WS_W2VT : WS_W2KT)) + (size_t)(F.tid >> 2) * 128 + (F.tid & 3) * 8;
        bf16_t* OUT = (bf16_t*)(ws + (which ? WS_VCMP : WS_KCMP)) + (size_t)bg * 512 * 64;
        f32x4 acc[4][2][2]; acc_zero(acc);
        gemm_kloop<false>(F.lds, a, b0, b0, 128, acc, F.wave, F.lane);
        if (wc < 2) {
#pragma unroll
            for (int m = 0; m < 4; ++m) { const int row = rt * 128 + wr * 64 + m * 16 + fr;
#pragma unroll
                for (int n = 0; n < 2; ++n) { const int col = wc * 32 + n * 16 + 4 * fq; const f32x4 v = acc[m][0][n];
                    u32x2 w; w.x = pk2(v.x, v.y); w.y = pk2(v.z, v.w); *(u32x2*)(OUT + (size_t)row * 64 + col) = w; } }
        }
    }
}

struct KpLin { int start; __device__ __forceinline__ int pos(int i) const { return start + i; } __device__ __forceinline__ bool valid(int) const { return true; } };
struct KpSel { const LAS int* blk; int s; __device__ __forceinline__ int pos(int i) const { return blk[i >> 6] * 64 + (i & 63); } __device__ __forceinline__ bool valid(int i) const { return pos(i) <= s; } };
template <class KP>
__device__ __forceinline__ void naive_attn4(const LAS f32x4* Qs, const bf16_t* Kb, const bf16_t* Vb, int nk, const KP kp, LAS f32x4* P, int lane, bool use_sink, f32x4 sink2, f32x4& o, f32x4& rl) {
    const float NINF = -__builtin_inff();
    o = (f32x4){0.f, 0.f, 0.f, 0.f}; rl = o;
    if (nk <= 0) return;
    f32x4 mx = (f32x4){NINF, NINF, NINF, NINF};
    for (int i0 = 0; i0 < nk; i0 += 64) {
        const int i = i0 + lane;
        if (i < nk) {
            f32x4 s = (f32x4){NINF, NINF, NINF, NINF};
            if (kp.valid(i)) {
                s = (f32x4){0.f, 0.f, 0.f, 0.f};
                const u32x4* kr = (const u32x4*)(Kb + (size_t)kp.pos(i) * 64);
#pragma unroll
                for (int c = 0; c < 8; ++c) { const u32x4 w = kr[c];
#pragma unroll
                    for (int e = 0; e < 4; ++e) { const float lo = __uint_as_float(w[e] << 16), hi = __uint_as_float(w[e] & 0xffff0000u);
                        s += Qs[c * 8 + 2 * e] * lo + Qs[c * 8 + 2 * e + 1] * hi; } }
                mx.x = fmaxf(mx.x, s.x); mx.y = fmaxf(mx.y, s.y); mx.z = fmaxf(mx.z, s.z); mx.w = fmaxf(mx.w, s.w);
            }
            P[i] = s;
        }
    }
    mx.x = wave_max(mx.x); mx.y = wave_max(mx.y); mx.z = wave_max(mx.z); mx.w = wave_max(mx.w);
    if (use_sink) { mx.x = fmaxf(mx.x, sink2.x); mx.y = fmaxf(mx.y, sink2.y); mx.z = fmaxf(mx.z, sink2.z); mx.w = fmaxf(mx.w, sink2.w); }
    WSYNC();
    f32x4 l = (f32x4){0.f, 0.f, 0.f, 0.f};
    for (int i0 = 0; i0 < nk; i0 += 64) {
        const int i = i0 + lane;
        if (i < nk) { const f32x4 s = P[i]; f32x4 p; p.x = exp2f(s.x - mx.x); p.y = exp2f(s.y - mx.y); p.z = exp2f(s.z - mx.z); p.w = exp2f(s.w - mx.w); P[i] = p; l += p; }
    }
    l.x = wave_sum(l.x); l.y = wave_sum(l.y); l.z = wave_sum(l.z); l.w = wave_sum(l.w);
    if (use_sink) { l.x += exp2f(sink2.x - mx.x); l.y += exp2f(sink2.y - mx.y); l.z += exp2f(sink2.z - mx.z); l.w += exp2f(sink2.w - mx.w); }
    WSYNC();
    f32x4 acc = (f32x4){0.f, 0.f, 0.f, 0.f};
#pragma unroll 4
    for (int i = 0; i < nk; ++i) { const f32x4 p = P[i]; const float v = bf2f(Vb[(size_t)kp.pos(i) * 64 + lane]); acc += p * v; }
    rl.x = 1.0f / l.x; rl.y = 1.0f / l.y; rl.z = 1.0f / l.z; rl.w = 1.0f / l.w;
    o = acc * rl;
    WSYNC();
}
__device__ __forceinline__ void load_q4(LAS f32x4* Qs, const bf16_t* qrow  , int lane) {
    f32x4 q; q.x = bf2f(qrow[lane]); q.y = bf2f(qrow[64 + lane]); q.z = bf2f(qrow[128 + lane]); q.w = bf2f(qrow[192 + lane]);
    Qs[lane] = q; WSYNC();
}
__device__ __forceinline__ void phase_attn_naive(Frame& F) {
    unsigned char* ws = F.ws;
    LAS unsigned char* scr = F.lds + F.wave * WAVE_SCR;
    LAS f32x4* P = (LAS f32x4*)scr;
    LAS f32x4* Qs = (LAS f32x4*)(scr + 16384);
    LAS float* IMP = (LAS float*)(scr + 16384 + 1024);
    LAS int* BLK = (LAS int*)(scr + 16384 + 1024 + 512);
    const int lane = F.lane, gw = F.bid * NWAVES + F.wave, NGW = F.G * NWAVES;
    const float* GN = (const float*)(ws + WS_GN);
    const f32x4 zero4 = (f32x4){0.f, 0.f, 0.f, 0.f};
    for (int task = gw; task < 2 * NB * 2 * SEQ; task += NGW) {
        const bool is_swa = task >= NB * 2 * SEQ; const int t2 = is_swa ? task - NB * 2 * SEQ : task;
        const int s = t2 & (SEQ - 1), bg = t2 >> 13, b = bg >> 1, g = bg & 1; const size_t tok = (size_t)b * SEQ + s;
        if (is_swa) {
            load_q4(Qs, (const bf16_t*)(ws + WS_QS) + tok * 512 + g * 256, lane);
            const float* sk = F.in[I_SINK] + g * 4; const f32x4 sink2 = (f32x4){sk[0] * LOG2E, sk[1] * LOG2E, sk[2] * LOG2E, sk[3] * LOG2E};
            const int start = s >= 127 ? s - 127 : 0; KpLin kp{start}; f32x4 o, rl;
            naive_attn4(Qs, kv_tensor(ws, 6) + (size_t)bg * SEQ * 64, kv_tensor(ws, 7) + (size_t)bg * SEQ * 64, s - start + 1, kp, P, lane, true, sink2, o, rl);
            bf16_t* dst = (bf16_t*)(ws + WS_OSWA) + tok * 512 + g * 256 + lane;
            dst[0] = (bf16_t)f2bf(o.x); dst[64] = (bf16_t)f2bf(o.y); dst[128] = (bf16_t)f2bf(o.z); dst[192] = (bf16_t)f2bf(o.w);
            continue;
        }
        load_q4(Qs, (const bf16_t*)(ws + WS_QC) + tok * 512 + g * 256, lane);
        const int nkc = s < 31 ? 0 : ((s - 31) >> 4) + 1;
        f32x4 o_cmp, rlc;
        { KpLin kp{0}; naive_attn4(Qs, (const bf16_t*)(ws + WS_KCMP) + (size_t)bg * 512 * 64, (const bf16_t*)(ws + WS_VCMP) + (size_t)bg * 512 * 64, nkc, kp, P, lane, false, zero4, o_cmp, rlc); }
        const int cur = s >> 6;
#pragma unroll
        for (int jj = 0; jj < 2; ++jj) { const int j = lane + 64 * jj; float v = 0.f;
            for (int c = 4 * j - 1; c <= 4 * j + 3; ++c) if (c >= 0 && c < nkc) { const f32x4 p = P[c]; v += p.x * rlc.x + p.y * rlc.y + p.z * rlc.z + p.w * rlc.w; }
            if (j > cur) v = -1.0f; else if (j == 0 || j == cur || j == cur - 1) v = 1e6f;
            IMP[j] = v; }
        WSYNC();
        bool sel[2];
#pragma unroll
        for (int jj = 0; jj < 2; ++jj) { const int j = lane + 64 * jj; const float v = IMP[j]; int rank = 0;
            for (int i = 0; i < NSEL; ++i) { const float vi = IMP[i]; rank += (vi > v || (vi == v && i < j)) ? 1 : 0; }
            sel[jj] = (rank < 16) && (j <= cur); }
        const unsigned long long m0 = __ballot(sel[0]), m1 = __ballot(sel[1]);
        const unsigned long long lt = (lane == 0) ? 0ull : (~0ull >> (64 - lane));
        const int n0 = __popcll(m0), nblk = n0 + __popcll(m1);
        if (sel[0]) BLK[__popcll(m0 & lt)] = lane;
        if (sel[1]) BLK[n0 + __popcll(m1 & lt)] = lane + 64;
        if (lane == 0) { u32x4 w; w.x = (unsigned)m0; w.y = (unsigned)(m0 >> 32); w.z = (unsigned)m1; w.w = (unsigned)(m1 >> 32); *(u32x4*)(ws + WS_SEL + ((size_t)bg * SEQ + s) * 16) = w; }
        WSYNC();
        load_q4(Qs, (const bf16_t*)(ws + WS_QR) + tok * 512 + g * 256, lane);
        f32x4 o_sel, o_win, rl;
        { KpSel kp{BLK, s}; naive_attn4(Qs, kv_tensor(ws, 2) + (size_t)bg * SEQ * 64, kv_tensor(ws, 3) + (size_t)bg * SEQ * 64, nblk * 64, kp, P, lane, false, zero4, o_sel, rl); }
        { const int start = s >= 511 ? s - 511 : 0; KpLin kp{start}; naive_attn4(Qs, kv_tensor(ws, 4) + (size_t)bg * SEQ * 64, kv_tensor(ws, 5) + (size_t)bg * SEQ * 64, s - start + 1, kp, P, lane, false, zero4, o_win, rl); }
        const float* gt = GN + tok * 24 + g * 12;
        bf16_t* dst = (bf16_t*)(ws + WS_ONSA) + tok * 512 + g * 256 + lane;
        dst[0]   = (bf16_t)f2bf(gt[0] * o_cmp.x + gt[1]  * o_sel.x + gt[2]  * o_win.x);
        dst[64]  = (bf16_t)f2bf(gt[3] * o_cmp.y + gt[4]  * o_sel.y + gt[5]  * o_win.y);
        dst[128] = (bf16_t)f2bf(gt[6] * o_cmp.z + gt[7]  * o_sel.z + gt[8]  * o_win.z);
        dst[192] = (bf16_t)f2bf(gt[9] * o_cmp.w + gt[10] * o_sel.w + gt[11] * o_win.w);
    }
}

__device__ __forceinline__ void phase_branch(Frame& F) {
    unsigned char* ws = F.ws;
    const int wr = F.wave >> 2, wc = F.wave & 3, fr = F.lane & 15, fq = F.lane >> 4;
    const bf16_t* GM = (const bf16_t*)(ws + WS_GM); bf16_t* MIXED = (bf16_t*)(ws + WS_MIXED);
    for (int u = F.bid; u < (NTOK / 128) * 4; u += F.G) {
        const int pm = u >> 2, pn = u & 3;
        const size_t arow = (size_t)(pm * 128 + (F.tid >> 2)) * 512 + (F.tid & 3) * 8, brow = (size_t)(pn * 256 + (F.tid >> 2)) * 512 + (F.tid & 3) * 8;
        f32x4 acc1[4][2][2], acc2[4][2][2]; acc_zero(acc1); acc_zero(acc2);
        { const bf16_t* b0 = (const bf16_t*)(ws + WS_WBRN) + brow; gemm_kloop<true>(F.lds, (const bf16_t*)(ws + WS_ONSA) + arow, b0, b0 + 128 * 512, 512, acc1, F.wave, F.lane); }
        { const bf16_t* b0 = (const bf16_t*)(ws + WS_WBRS) + brow; gemm_kloop<true>(F.lds, (const bf16_t*)(ws + WS_OSWA) + arow, b0, b0 + 128 * 512, 512, acc2, F.wave, F.lane); }
#pragma unroll
        for (int m = 0; m < 4; ++m) { const size_t row = (size_t)pm * 128 + wr * 64 + m * 16 + fr;
#pragma unroll
            for (int bj = 0; bj < 2; ++bj)
#pragma unroll
                for (int n = 0; n < 2; ++n) { const int col = pn * 256 + bj * 128 + wc * 32 + n * 16 + 4 * fq;
                    const u32x2 g1 = *(const u32x2*)(GM + row * 2048 + col), g2 = *(const u32x2*)(GM + row * 2048 + 1024 + col);
                    const f32x4 a = acc1[m][bj][n], b = acc2[m][bj][n];
                    const float r0 = __uint_as_float(g1.x << 16) * a.x + __uint_as_float(g2.x << 16) * b.x, r1 = __uint_as_float(g1.x & 0xffff0000u) * a.y + __uint_as_float(g2.x & 0xffff0000u) * b.y;
                    const float r2 = __uint_as_float(g1.y << 16) * a.z + __uint_as_float(g2.y << 16) * b.z, r3 = __uint_as_float(g1.y & 0xffff0000u) * a.w + __uint_as_float(g2.y & 0xffff0000u) * b.w;
                    u32x2 w; w.x = pk2(r0, r1); w.y = pk2(r2, r3); *(u32x2*)(MIXED + row * 1024 + col) = w; } }
    }
}

__device__ __forceinline__ void phase_wout(Frame& F) {
    unsigned char* ws = F.ws;
    const int wr = F.wave >> 2, wc = F.wave & 3, fr = F.lane & 15, fq = F.lane >> 4;
    const float* X = F.in[I_X]; float* Z = F.out;
    for (int u = F.bid; u < (NTOK / 128) * 4; u += F.G) {
        const int pm = u >> 2, pn = u & 3;
        const bf16_t* a = (const bf16_t*)(ws + WS_MIXED) + (size_t)(pm * 128 + (F.tid >> 2)) * 1024 + (F.tid & 3) * 8;
        const bf16_t* b0 = (const bf16_t*)(ws + WS_WOUT) + (size_t)(pn * 256 + (F.tid >> 2)) * 1024 + (F.tid & 3) * 8;
        f32x4 acc[4][2][2]; acc_zero(acc);
        gemm_kloop<true>(F.lds, a, b0, b0 + 128 * 1024, 1024, acc, F.wave, F.lane);
#pragma unroll
        for (int m = 0; m < 4; ++m) { const size_t row = (size_t)pm * 128 + wr * 64 + m * 16 + fr;
#pragma unroll
            for (int bj = 0; bj < 2; ++bj)
#pragma unroll
                for (int n = 0; n < 2; ++n) { const int col = pn * 256 + bj * 128 + wc * 32 + n * 16 + 4 * fq;
                    const f32x4 xv = *(const f32x4*)(X + row * 1024 + col); *(f32x4*)(Z + row * 1024 + col) = xv * DN_ALPHA + acc[m][bj][n]; } }
    }
}

constexpr int WRP_LD = 33;
__device__ __forceinline__ void phase_ln_route(Frame& F) {
    unsigned char* ws = F.ws;
    LAS float* WRP = (LAS float*)F.lds;
    LAS float* LG = (LAS float*)(F.lds + 1024 * WRP_LD * 4);
    { const float* src = F.in[I_WR]; for (int i = F.tid; i < 1024 * 32; i += NTHREADS) WRP[(i >> 5) * WRP_LD + (i & 31)] = src[i]; }
    __syncthreads();
    const int lane = F.lane;
    const float* G1 = F.in[I_LN1G]; const float* B1 = F.in[I_LN1B]; const float* BR = F.in[I_BR];
    gu32* ctl = (gu32*)(ws + WS_CTL);
    int* TOPE = (int*)(ws + WS_TOPE); float* TOPG = (float*)(ws + WS_TOPG); int* TOPP = (int*)(ws + WS_TOPP); int* TOK = (int*)(ws + WS_TOK);
    for (int tb = F.bid; tb < NTOK / 64; tb += F.G) {
        for (int i = 0; i < 8; ++i) {
            const int t = tb * 64 + F.wave * 8 + i;
            float* zr = F.out + (size_t)t * 1024;
            f32x4 v[4]; float s = 0.f;
#pragma unroll
            for (int j = 0; j < 4; ++j) { v[j] = *(const f32x4*)(zr + 4 * (lane + 64 * j)); s += (v[j].x + v[j].y) + (v[j].z + v[j].w); }
            const float mean = wave_sum(s) * (1.0f / 1024.0f); float s2 = 0.f;
#pragma unroll
            for (int j = 0; j < 4; ++j) { v[j] = v[j] - mean; s2 += (v[j].x * v[j].x + v[j].y * v[j].y) + (v[j].z * v[j].z + v[j].w * v[j].w); }
            const float rstd = 1.0f / sqrtf(wave_sum(s2) * (1.0f / 1024.0f) + LN_EPS);
#pragma unroll
            for (int j = 0; j < 4; ++j) { const int c0 = 4 * (lane + 64 * j);
                const f32x4 gg = *(const f32x4*)(G1 + c0), bb = *(const f32x4*)(B1 + c0);
                const f32x4 h = v[j] * rstd * gg + bb;
                *(f32x4*)(zr + c0) = h;
                u32x2 w; w.x = pk2(h.x, h.y); w.y = pk2(h.z, h.w); *(u32x2*)((bf16_t*)(ws + WS_HB) + (size_t)t * 1024 + c0) = w; }
        }
        VM_WAIT();
        __syncthreads();
        { const int tg = F.wave >> 1, eh = F.wave & 1, kk = lane >> 4, n = lane & 15;
          const float* hrow = F.out + (size_t)(tb * 64 + tg * 16 + n) * 1024 + 4 * kk;
          const LAS float* wcol = WRP + (4 * kk) * WRP_LD + eh * 16 + n;
          f32x4 acc = (f32x4){0.f, 0.f, 0.f, 0.f};
#pragma unroll 4
          for (int s4 = 0; s4 < 64; ++s4) { const f32x4 a = *(const f32x4*)(hrow + 16 * s4); const LAS float* wp = wcol + 16 * s4 * WRP_LD;
              acc = __builtin_amdgcn_mfma_f32_16x16x4f32(a.x, wp[0], acc, 0, 0, 0);
              acc = __builtin_amdgcn_mfma_f32_16x16x4f32(a.y, wp[WRP_LD], acc, 0, 0, 0);
              acc = __builtin_amdgcn_mfma_f32_16x16x4f32(a.z, wp[2 * WRP_LD], acc, 0, 0, 0);
              acc = __builtin_amdgcn_mfma_f32_16x16x4f32(a.w, wp[3 * WRP_LD], acc, 0, 0, 0); }
          const float br = BR[eh * 16 + n];
#pragma unroll
          for (int r = 0; r < 4; ++r) LG[(tg * 16 + 4 * kk + r) * WRP_LD + eh * 16 + n] = acc[r] + br; }
        __syncthreads();
        if (F.tid < 64) {
            const int t = tb * 64 + F.tid; float lg[32];
#pragma unroll
            for (int e = 0; e < 32; ++e) lg[e] = LG[F.tid * WRP_LD + e];
            int be[4]; float bv[4];
#pragma unroll
            for (int k = 0; k < 4; ++k) { float best = -__builtin_inff(); int bi = 0;
#pragma unroll
                for (int e = 0; e < 32; ++e) if (lg[e] > best) { best = lg[e]; bi = e; }
                be[k] = bi; bv[k] = best;
#pragma unroll
                for (int e = 0; e < 32; ++e) if (e == bi) lg[e] = -__builtin_inff(); }
            const float e1 = __expf(bv[1] - bv[0]), e2 = __expf(bv[2] - bv[0]), e3 = __expf(bv[3] - bv[0]); const float rs = 1.0f / (1.0f + e1 + e2 + e3);
            const float gk0 = rs, gk1 = e1 * rs, gk2 = e2 * rs, gk3 = e3 * rs;
#pragma unroll
            for (int k = 0; k < 4; ++k) { const int pos = (int)__hip_atomic_fetch_add(ctl + CW_CNT + 64 * be[k], 1u, RLX_AGENT);
                TOK[be[k] * NTOK + pos] = t; TOPE[t * 4 + k] = be[k]; TOPP[t * 4 + k] = pos; TOPG[t * 4 + k] = (k == 0 ? gk0 : k == 1 ? gk1 : k == 2 ? gk2 : gk3); }
        }
        __syncthreads();
    }
}

struct ExpertMap { int base[NEXP + 1]; };
__device__ __forceinline__ void load_expert_map(Frame& F, LAS int* cnt_s, LAS int* base_s) {
    if (F.tid < NEXP) cnt_s[F.tid] = (int)__hip_atomic_load((gu32*)(F.ws + WS_CTL) + CW_CNT + 64 * F.tid, RLX_AGENT);
    __syncthreads();
    if (F.tid == 0) { int acc = 0; for (int e = 0; e < NEXP; ++e) { base_s[e] = acc; acc += (cnt_s[e] + MOE_RT - 1) / MOE_RT; } base_s[NEXP] = acc; }
    __syncthreads();
}
__device__ __forceinline__ void phase_expert_up(Frame& F) {
    unsigned char* ws = F.ws;
    LAS int* cnt_s = (LAS int*)(F.lds + 32768); LAS int* base_s = cnt_s + 64;
    load_expert_map(F, cnt_s, base_s);
    const int wr = F.wave >> 2, wc = F.wave & 3, fr = F.lane & 15, fq = F.lane >> 4;
    const int ntiles = base_s[NEXP], NU = ntiles * 8;
    const int* TOK = (const int*)(ws + WS_TOK); const bf16_t* HB = (const bf16_t*)(ws + WS_HB); bf16_t* ACT = (bf16_t*)(ws + WS_ACT);
    for (int u = F.bid; u < NU; u += F.G) {
        const int gt = u >> 3, pn = u & 7;
        int e = 0;
#pragma unroll 1
        for (int k = 1; k < NEXP; ++k) if (base_s[k] <= gt) e = k;
        const int rt = gt - base_s[e], cnt = cnt_s[e];
        const int r = rt * MOE_RT + (F.tid >> 2); const int tok = r < cnt ? TOK[e * NTOK + r] : 0;
        const bf16_t* a = HB + (size_t)tok * 1024 + (F.tid & 3) * 8;
        const bf16_t* b0 = (const bf16_t*)(ws + WS_WEIN) + ((size_t)e * 2048 + pn * 128 + (F.tid >> 2)) * 1024 + (F.tid & 3) * 8;
        f32x4 acc[4][2][2]; acc_zero(acc);
        gemm_kloop<true>(F.lds, a, b0, b0 + (size_t)1024 * 1024, 1024, acc, F.wave, F.lane);
        const float* bin = F.in[I_BEIN] + (size_t)e * 2048;
#pragma unroll
        for (int m = 0; m < 4; ++m) { const size_t row = (size_t)gt * MOE_RT + wr * 64 + m * 16 + fr;
#pragma unroll
            for (int n = 0; n < 2; ++n) { const int col = pn * 128 + wc * 32 + n * 16 + 4 * fq;
                const f32x4 bg = *(const f32x4*)(bin + col), bu = *(const f32x4*)(bin + 1024 + col);
                const f32x4 hg = acc[m][0][n] + bg, hu = acc[m][1][n] + bu; float o[4];
#pragma unroll
                for (int i = 0; i < 4; ++i) { const float g = fminf(hg[i], 7.0f), uu = fminf(fmaxf(hu[i], -7.0f), 7.0f); o[i] = g * sigmoidf_(1.702f * g) * (uu + 1.0f); }
                u32x2 w; w.x = pk2(o[0], o[1]); w.y = pk2(o[2], o[3]); *(u32x2*)(ACT + row * 1024 + col) = w; } }
    }
}
__device__ __forceinline__ void phase_expert_down(Frame& F) {
    unsigned char* ws = F.ws;
    LAS int* cnt_s = (LAS int*)(F.lds + 32768); LAS int* base_s = cnt_s + 64;
    load_expert_map(F, cnt_s, base_s);
    const int wr = F.wave >> 2, wc = F.wave & 3, fr = F.lane & 15, fq = F.lane >> 4;
    const int ntiles = base_s[NEXP], NU = ntiles * 4;
    const bf16_t* ACT = (const bf16_t*)(ws + WS_ACT); bf16_t* YS = (bf16_t*)(ws + WS_YS);
    for (int u = F.bid; u < NU; u += F.G) {
        const int gt = u >> 2, pn = u & 3;
        int e = 0;
#pragma unroll 1
        for (int k = 1; k < NEXP; ++k) if (base_s[k] <= gt) e = k;
        const bf16_t* a = ACT + ((size_t)gt * MOE_RT + (F.tid >> 2)) * 1024 + (F.tid & 3) * 8;
        const bf16_t* b0 = (const bf16_t*)(ws + WS_WEOUT) + ((size_t)e * 1024 + pn * 256 + (F.tid >> 2)) * 1024 + (F.tid & 3) * 8;
        f32x4 acc[4][2][2]; acc_zero(acc);
        gemm_kloop<true>(F.lds, a, b0, b0 + (size_t)128 * 1024, 1024, acc, F.wave, F.lane);
        const float* bo = F.in[I_BEOUT] + (size_t)e * 1024;
#pragma unroll
        for (int m = 0; m < 4; ++m) { const size_t row = (size_t)gt * MOE_RT + wr * 64 + m * 16 + fr;
#pragma unroll
            for (int bj = 0; bj < 2; ++bj)
#pragma unroll
                for (int n = 0; n < 2; ++n) { const int col = pn * 256 + bj * 128 + wc * 32 + n * 16 + 4 * fq;
                    const f32x4 v = acc[m][bj][n] + *(const f32x4*)(bo + col);
                    u32x2 w; w.x = pk2(v.x, v.y); w.y = pk2(v.z, v.w); *(u32x2*)(YS + row * 1024 + col) = w; } }
    }
}

__device__ __forceinline__ void phase_final(Frame& F) {
    unsigned char* ws = F.ws;
    LAS int* cnt_s = (LAS int*)(F.lds + 32768); LAS int* base_s = cnt_s + 64;
    load_expert_map(F, cnt_s, base_s);
    const int lane = F.lane, gw = F.bid * NWAVES + F.wave, NGW = F.G * NWAVES;
    const int* TOPE = (const int*)(ws + WS_TOPE); const float* TOPG = (const float*)(ws + WS_TOPG); const int* TOPP = (const int*)(ws + WS_TOPP);
    const bf16_t* YS = (const bf16_t*)(ws + WS_YS); const float* G2 = F.in[I_LN2G]; const float* B2 = F.in[I_LN2B];
    for (int t = gw; t < NTOK; t += NGW) {
        float* hr = F.out + (size_t)t * 1024;
        f32x4 v[4];
#pragma unroll
        for (int j = 0; j < 4; ++j) v[j] = *(const f32x4*)(hr + 4 * (lane + 64 * j)) * DN_ALPHA;
#pragma unroll
        for (int k = 0; k < 4; ++k) { const int e = TOPE[t * 4 + k]; const float g = TOPG[t * 4 + k]; const size_t row = (size_t)base_s[e] * MOE_RT + TOPP[t * 4 + k];
#pragma unroll
            for (int j = 0; j < 4; ++j) { const u32x2 w = *(const u32x2*)(YS + row * 1024 + 4 * (lane + 64 * j));
                v[j].x += g * __uint_as_float(w.x << 16); v[j].y += g * __uint_as_float(w.x & 0xffff0000u); v[j].z += g * __uint_as_float(w.y << 16); v[j].w += g * __uint_as_float(w.y & 0xffff0000u); } }
        float s = 0.f;
#pragma unroll
        for (int j = 0; j < 4; ++j) s += (v[j].x + v[j].y) + (v[j].z + v[j].w);
        const float mean = wave_sum(s) * (1.0f / 1024.0f); float s2 = 0.f;
#pragma unroll
        for (int j = 0; j < 4; ++j) { v[j] = v[j] - mean; s2 += (v[j].x * v[j].x + v[j].y * v[j].y) + (v[j].z * v[j].z + v[j].w * v[j].w); }
        const float rstd = 1.0f / sqrtf(wave_sum(s2) * (1.0f / 1024.0f) + LN_EPS);
#pragma unroll
        for (int j = 0; j < 4; ++j) { const int c0 = 4 * (lane + 64 * j); const f32x4 gg = *(const f32x4*)(G2 + c0), bb = *(const f32x4*)(B2 + c0); *(f32x4*)(hr + c0) = v[j] * rstd * gg + bb; }
    }
}

constexpr int N_PHASES = 12;
__global__ void __launch_bounds__(NTHREADS, 2) mk_fwd(Args args) {
    extern __shared__ __attribute__((aligned(16))) unsigned char lds_raw[];
    Frame F;
    F.lds = (LAS unsigned char*)lds_raw; F.ws = args.ws; F.in = args.in; F.out = args.out;
    F.tid = threadIdx.x; F.lane = F.tid & 63; F.wave = __builtin_amdgcn_readfirstlane(F.tid >> 6); F.G = gridDim.x; F.bid = blockIdx.x;
    volatile LAS unsigned* MISC = (volatile LAS unsigned*)(F.lds + MISC_OFF);
    if (F.tid < 64) MISC[F.tid] = 0u;
    __syncthreads();
    const int lo = args.ph_lo, hi = args.ph_hi;
    XcdBarrier bar; bar.bar = (unsigned*)(args.ws + WS_CTL) + CW_BAR; bar.x = 0; bar.st = nullptr;
    if (hi - lo > 1) bar = xcd_barrier_post((unsigned*)(args.ws + WS_CTL) + CW_BAR, MISC + 8);
#define IN(k) (lo <= (k) && (k) < hi)
#define SEAM(k) do { if (IN(k) && IN((k) + 1)) xcd_barrier(bar); } while (0)
    if (IN(0)) { phase_prologue(F); SEAM(0); }
    if (IN(1)) { phase_inproj(F); SEAM(1); }
    if (IN(2)) { phase_scatter(F); SEAM(2); }
    if (IN(3)) { phase_cmp1(F); SEAM(3); }
    if (IN(4)) { phase_cmp2(F); SEAM(4); }
    if (IN(5)) { phase_attn_naive(F); SEAM(5); }
    if (IN(6)) { phase_branch(F); SEAM(6); }
    if (IN(7)) { phase_wout(F); SEAM(7); }
    if (IN(8)) { phase_ln_route(F); SEAM(8); }
    if (IN(9)) { phase_expert_up(F); SEAM(9); }
    if (IN(10)) { phase_expert_down(F); SEAM(10); }
    if (IN(11)) { phase_final(F); }
#undef IN
#undef SEAM
}

extern "C" void kernel_launch(void* const* d_in, const int* in_sizes, int n_in, void* d_out, int out_size, void* d_ws, size_t ws_size, hipStream_t stream) {
    static int grid = 0;
    if (grid == 0) {
        if (n_in != N_IN || out_size != NTOK * DM || ws_size < WS_END) { fprintf(stderr, "kernel_launch: unexpected shapes (n_in %d, out %d, ws %zu)\n", n_in, out_size, ws_size); grid = -1; return; }
        int dev = 0, cus = 0;
        if (hipGetDevice(&dev) != hipSuccess || hipDeviceGetAttribute(&cus, hipDeviceAttributeMultiprocessorCount, dev) != hipSuccess) { grid = -1; return; }
        if (hipFuncSetAttribute((const void*)mk_fwd, hipFuncAttributeMaxDynamicSharedMemorySize, LDS_BYTES) != hipSuccess) { fprintf(stderr, "kernel_launch: hipFuncSetAttribute failed\n"); grid = -1; return; }
        int per_cu = 0;
        if (hipOccupancyMaxActiveBlocksPerMultiprocessor(&per_cu, (const void*)mk_fwd, NTHREADS, LDS_BYTES) != hipSuccess || per_cu < 1) { fprintf(stderr, "kernel_launch: occupancy query says %d\n", per_cu); }
        (void)hipGetLastError();
        grid = cus;
    }
    if (grid < 0) return;
    (void)hipMemsetAsync((char*)d_ws + WS_CTL, 0, CTL_ZERO_BYTES, stream);
    Args a{};
    for (int i = 0; i < N_IN; ++i) a.in[i] = (const float*)d_in[i];
    a.out = (float*)d_out; a.ws = (unsigned char*)d_ws;
#if MK_ONE_LAUNCH
    a.ph_lo = 0; a.ph_hi = N_PHASES;
    hipLaunchKernelGGL(mk_fwd, dim3(grid), dim3(NTHREADS), LDS_BYTES, stream, a);
#else
    for (int p = 0; p < N_PHASES; ++p) { a.ph_lo = p; a.ph_hi = p + 1; hipLaunchKernelGGL(mk_fwd, dim3(grid), dim3(NTHREADS), LDS_BYTES, stream, a); }
#endif
}
```

```cpp
#include <hip/hip_runtime.h>
#include <cstdio>
#include <cstdint>

#ifndef MK_ONE_LAUNCH
#define MK_ONE_LAUNCH 1
#endif

#define LAS __attribute__((address_space(3)))
#define GAS __attribute__((address_space(1)))
typedef unsigned short bf16_t;
typedef short bf16x8 __attribute__((ext_vector_type(8)));
typedef float f32x4 __attribute__((ext_vector_type(4)));
typedef unsigned u32x4 __attribute__((ext_vector_type(4)));
typedef unsigned u32x2 __attribute__((ext_vector_type(2)));
typedef GAS unsigned gu32;
#define RLX_AGENT __ATOMIC_RELAXED, __HIP_MEMORY_SCOPE_AGENT
#define WSYNC() asm volatile("s_waitcnt lgkmcnt(0)" ::: "memory")
#define VM_WAIT() asm volatile("s_waitcnt vmcnt(0)" ::: "memory")

constexpr int NB = 2, SEQ = 8192, DM = 1024, NTOK = NB * SEQ, HD = 64;
constexpr int NVG = 2048;
constexpr int NVC = 2048;
constexpr int IN_COLS = 4120;
constexpr int NEXP = 32, DFF = 1024;
constexpr int NCMP = 511, NCMP_PAD = 512, NSEL = 128;
constexpr float C2 = 0.125f * 1.4426950408889634f;
constexpr float LOG2E = 1.4426950408889634f;
constexpr float DN_ALPHA = 1.189207115002721f;
constexpr float LN_EPS = 1e-5f;
constexpr int NWAVES = 8, NTHREADS = 512;
constexpr int MOE_RT = 256;

enum { I_X = 0, I_WIN, I_KPE, I_KW1, I_KW2, I_VPE, I_VW1, I_VW2, I_SINK, I_WBRN, I_WBRS, I_WOUT, I_LN1G, I_LN1B, I_WR, I_BR, I_WEIN, I_BEIN, I_WEOUT, I_BEOUT, I_LN2G, I_LN2B, N_IN };

constexpr size_t MiB = 1u << 20;
constexpr size_t WS_CTL = 0, CTL_ZERO_BYTES = 1 * MiB;
constexpr size_t WS_COS = 1 * MiB, WS_SIN = 2 * MiB;
constexpr size_t WS_C1P = 3 * MiB + 8192;
constexpr size_t WS_C1K = 3 * MiB, WS_C1V = 3 * MiB + 4096;
constexpr size_t WS_W1KT = 3 * MiB + 65536, WS_W1VT = WS_W1KT + 524288;
constexpr size_t WS_W2KT = WS_W1VT + 524288, WS_W2VT = WS_W2KT + 32768;
constexpr size_t WS_WBRN = 5 * MiB, WS_WBRS = 6 * MiB;
constexpr size_t WS_WOUT = 7 * MiB;
constexpr size_t WS_WIN = 9 * MiB;
constexpr size_t WS_KV = 18 * MiB, KV_BYTES = 4 * MiB;
constexpr size_t WS_CMP = 50 * MiB;
constexpr size_t WS_KCMP = WS_CMP, WS_VCMP = WS_CMP + 262144, WS_HIDK = WS_CMP + 524288, WS_HIDV = WS_CMP + 1048576;
constexpr size_t WS_QC = 52 * MiB, WS_QR = 68 * MiB, WS_QS = 84 * MiB;
constexpr size_t WS_GN = 100 * MiB;
constexpr size_t WS_SEL = 102 * MiB;
constexpr size_t WS_TOPE = 103 * MiB, WS_TOPG = WS_TOPE + 262144, WS_TOPP = WS_TOPG + 262144, WS_TOK = 104 * MiB;
constexpr size_t WS_XB = 108 * MiB;
constexpr size_t WS_ZB = 108 * MiB;
constexpr size_t WS_GM = 140 * MiB;
constexpr size_t WS_OF32 = 204 * MiB;
constexpr size_t WS_ONSA = 236 * MiB, WS_OSWA = 252 * MiB;
constexpr size_t WS_OSEL = 812 * MiB, WS_OWIN = 828 * MiB;
constexpr size_t WS_HB16 = 268 * MiB;
constexpr size_t WS_MIXED = 268 * MiB;
constexpr size_t WS_HB = 300 * MiB;
constexpr size_t WS_WEIN = 332 * MiB;
constexpr size_t WS_WEOUT = 460 * MiB;
constexpr size_t WS_ACT = 524 * MiB;
constexpr size_t WS_YS = 668 * MiB;
constexpr size_t WS_XB8 = 316 * MiB;
constexpr size_t WS_WG8 = 13 * MiB, WS_SCG = 15 * MiB;
constexpr size_t WS_SC1 = 844 * MiB, WS_SC2 = 846 * MiB;
constexpr size_t WS_END = 848 * MiB;
constexpr int CW_BAR = 4096;
constexpr int CW_CNT = 16384;

constexpr int LDS_BYTES = 147456;
constexpr int MISC_OFF = 145408;

__device__ __forceinline__ float bf2f(bf16_t v) { return __uint_as_float(((unsigned)v) << 16); }
__device__ __forceinline__ unsigned f2bf(float f) { unsigned u = __float_as_uint(f); return (u + 0x7fffu + ((u >> 16) & 1u)) >> 16; }
__device__ __forceinline__ unsigned pk2(float lo, float hi) { return f2bf(lo) | (f2bf(hi) << 16); }
__device__ __forceinline__ unsigned f4_to_fp8(float a, float b, float c, float d) { int p = __builtin_amdgcn_cvt_pk_fp8_f32(a, b, 0, false); p = __builtin_amdgcn_cvt_pk_fp8_f32(c, d, p, true); return (unsigned)p; }
__device__ __forceinline__ float frcp(float x) { return __builtin_amdgcn_rcpf(x); }
__device__ __forceinline__ float sigmoidf_(float x) { return frcp(1.0f + __expf(-x)); }
__device__ __forceinline__ float dppf(float v, int ctrl_sel) {
    const int x = __builtin_bit_cast(int, v);
    int r = ctrl_sel == 0 ? __builtin_amdgcn_mov_dpp(x, 0xB1, 0xF, 0xF, true) : ctrl_sel == 1 ? __builtin_amdgcn_mov_dpp(x, 0x4E, 0xF, 0xF, true) : ctrl_sel == 2 ? __builtin_amdgcn_mov_dpp(x, 0x141, 0xF, 0xF, true) : __builtin_amdgcn_mov_dpp(x, 0x140, 0xF, 0xF, true);
    return __builtin_bit_cast(float, r);
}
__device__ __forceinline__ float wave_sum(float v) {
    v += dppf(v, 0); v += dppf(v, 1); v += dppf(v, 2); v += dppf(v, 3);
    { auto r = __builtin_amdgcn_permlane16_swap(__float_as_uint(v), __float_as_uint(v), false, false); v = __uint_as_float(r[0]) + __uint_as_float(r[1]); }
    { auto r = __builtin_amdgcn_permlane32_swap(__float_as_uint(v), __float_as_uint(v), false, false); v = __uint_as_float(r[0]) + __uint_as_float(r[1]); }
    return v;
}
__device__ __forceinline__ float wave_max(float v) {
    v = fmaxf(v, dppf(v, 0)); v = fmaxf(v, dppf(v, 1)); v = fmaxf(v, dppf(v, 2)); v = fmaxf(v, dppf(v, 3));
    { auto r = __builtin_amdgcn_permlane16_swap(__float_as_uint(v), __float_as_uint(v), false, false); v = fmaxf(__uint_as_float(r[0]), __uint_as_float(r[1])); }
    { auto r = __builtin_amdgcn_permlane32_swap(__float_as_uint(v), __float_as_uint(v), false, false); v = fmaxf(__uint_as_float(r[0]), __uint_as_float(r[1])); }
    return v;
}
#define XB_TMO      128
#define XB_XCNT(j)  (256  + 64 * (j))
#define XB_XSUB(j)  (1280 + 64 * (j))
#define XB_XGEN(j)  (2304 + 64 * (j))
#define XB_TOP      3328
#define XB_TOPGEN   3392
#define XCD_BAR_WORDS 3456
#define XB_SPIN_CAP (1u << 22)
__device__ __forceinline__ unsigned xb_ld(unsigned* p)              { return __hip_atomic_load(p, __ATOMIC_RELAXED, __HIP_MEMORY_SCOPE_AGENT); }
__device__ __forceinline__ unsigned xb_add(unsigned* p, unsigned v) { return __hip_atomic_fetch_add(p, v, __ATOMIC_RELAXED, __HIP_MEMORY_SCOPE_AGENT); }
__device__ __forceinline__ unsigned xb_xcc_id() { return (unsigned)__builtin_amdgcn_s_getreg((3 << 11) | 20) & 0xFu; }
#define XB_SPIN(cond, bar) do { unsigned _sp = 0; while (cond) { __builtin_amdgcn_s_sleep(1); \
    if ((++_sp & 255u) == 0u) { if (xb_ld(&(bar)[XB_TMO])) break; if (_sp > XB_SPIN_CAP) { atomicAdd(&(bar)[XB_TMO], 1u); break; } } } } while (0)
struct XcdBarrier { unsigned* bar; unsigned x; volatile LAS unsigned* st; };
__device__ __forceinline__ XcdBarrier xcd_barrier_post(unsigned* bar, volatile LAS unsigned* st) {
    XcdBarrier b; b.bar = bar; b.x = xb_xcc_id(); b.st = st;
    if (threadIdx.x == 0) (void)xb_add(&bar[XB_XCNT(b.x)], 1u);
    return b;
}
__device__ __forceinline__ void xcd_barrier_complete(unsigned* bar, unsigned x, unsigned& nloc, unsigned& nx) {
    const unsigned G = gridDim.x * gridDim.y * gridDim.z;
    unsigned sum, cnt, mine, sp = 0u;
    for (;;) {
        sum = 0u; cnt = 0u; mine = 0u;
#pragma unroll
        for (unsigned j = 0; j < 16; ++j) { const unsigned c = xb_ld(&bar[XB_XCNT(j)]); sum += c; cnt += (c > 0u) ? 1u : 0u; mine = (j == x) ? c : mine; }
        if (sum == G) break;
        __builtin_amdgcn_s_sleep(1);
        if ((++sp & 255u) == 0u) { if (xb_ld(&bar[XB_TMO])) break; if (sp > XB_SPIN_CAP) { atomicAdd(&bar[XB_TMO], 1u); break; } }
    }
    nloc = mine > 0u ? mine : 1u; nx = cnt > 0u ? cnt : 1u;
}
__device__ __forceinline__ void xcd_barrier(const XcdBarrier& b) {
    asm volatile("s_waitcnt vmcnt(0)" ::: "memory");
    __syncthreads();
    if (threadIdx.x == 0) {
        unsigned* bar = b.bar;
        __builtin_amdgcn_s_waitcnt(0);
        unsigned nloc = b.st[0], nx = b.st[1];
        if (nloc == 0u) { xcd_barrier_complete(bar, b.x, nloc, nx); b.st[0] = nloc; b.st[1] = nx; }
        const unsigned old = xb_add(&bar[XB_XSUB(b.x)], 1u);
        const unsigned gen = old / nloc;
        if (old + 1u == (gen + 1u) * nloc) {
            __builtin_amdgcn_fence(__ATOMIC_RELEASE, "agent");
            asm volatile("s_waitcnt vmcnt(0)" ::: "memory");
            const unsigned og = xb_add(&bar[XB_TOP], 1u);
            const unsigned tg = og / nx;
            if (og + 1u == (tg + 1u) * nx) xb_add(&bar[XB_TOPGEN], 1u);
            else XB_SPIN(xb_ld(&bar[XB_TOPGEN]) == tg, bar);
            __builtin_amdgcn_fence(__ATOMIC_ACQUIRE, "agent");
            xb_add(&bar[XB_XGEN(b.x)], 1u);
            asm volatile("s_waitcnt vmcnt(0)" ::: "memory");
        } else {
            XB_SPIN(xb_ld(&bar[XB_XGEN(b.x)]) == gen, bar);
            __builtin_amdgcn_fence(__ATOMIC_ACQUIRE, "agent");
            asm volatile("s_waitcnt vmcnt(0)" ::: "memory");
        }
    }
    __syncthreads();
}

struct Args { const float* in[N_IN]; float* out; unsigned char* ws; int ph_lo, ph_hi; };
struct Frame {
    LAS unsigned char* lds;
    unsigned char* ws;
    const float* const* in;
    float* out;
    int tid, lane, wave, G, bid;
};

template <bool HAS_B1>
__device__ __forceinline__ void gemm_kloop(LAS unsigned char* lds, const bf16_t* a, const bf16_t* b0, const bf16_t* b1, int K, f32x4 (&acc)[4][2][2], int wid, int lane) {
    const int wr = wid >> 2, wc = wid & 3, fr = lane & 15, fq = lane >> 4;
    const unsigned ldsw = (unsigned)wid * 1024u;
    constexpr int SB = 24576;
    const int nsteps = K / 32;
#define KL_STAGE(s) do { LAS unsigned char* d_ = lds + ((s) & 3) * SB + ldsw; \
        __builtin_amdgcn_global_load_lds((const unsigned*)(a + (s) * 32), (LAS unsigned*)(d_), 16, 0, 0); \
        __builtin_amdgcn_global_load_lds((const unsigned*)(b0 + (s) * 32), (LAS unsigned*)(d_ + 8192), 16, 0, 0); \
        if (HAS_B1) __builtin_amdgcn_global_load_lds((const unsigned*)(b1 + (s) * 32), (LAS unsigned*)(d_ + 16384), 16, 0, 0); } while (0)
    for (int s = 0; s < 3 && s < nsteps; ++s) KL_STAGE(s);
    for (int k = 0; k < nsteps; ++k) {
        const int rem = nsteps - 1 - k;
        if (rem >= 2) { if (HAS_B1) asm volatile("s_waitcnt vmcnt(6)" ::: "memory"); else asm volatile("s_waitcnt vmcnt(4)" ::: "memory"); }
        else if (rem == 1) { if (HAS_B1) asm volatile("s_waitcnt vmcnt(3)" ::: "memory"); else asm volatile("s_waitcnt vmcnt(2)" ::: "memory"); }
        else asm volatile("s_waitcnt vmcnt(0)" ::: "memory");
        asm volatile("s_waitcnt lgkmcnt(0)" ::: "memory"); __builtin_amdgcn_s_barrier(); asm volatile("" ::: "memory");
        if (k + 3 < nsteps) KL_STAGE(k + 3);
        const LAS unsigned char* bufp = lds + (k & 3) * SB;
        bf16x8 af[4], bfr[2][2];
#pragma unroll
        for (int m = 0; m < 4; ++m) af[m] = *(const LAS bf16x8*)(bufp + (wr * 64 + m * 16 + fr) * 64 + fq * 16);
#pragma unroll
        for (int bj = 0; bj < (HAS_B1 ? 2 : 1); ++bj)
#pragma unroll
            for (int n = 0; n < 2; ++n) bfr[bj][n] = *(const LAS bf16x8*)(bufp + 8192 + bj * 8192 + (wc * 32 + n * 16 + fr) * 64 + fq * 16);
#pragma unroll
        for (int m = 0; m < 4; ++m)
#pragma unroll
            for (int bj = 0; bj < (HAS_B1 ? 2 : 1); ++bj)
#pragma unroll
                for (int n = 0; n < 2; ++n) acc[m][bj][n] = __builtin_amdgcn_mfma_f32_16x16x32_bf16(bfr[bj][n], af[m], acc[m][bj][n], 0, 0, 0);
    }
    asm volatile("s_waitcnt vmcnt(0) lgkmcnt(0)" ::: "memory"); __builtin_amdgcn_s_barrier(); asm volatile("" ::: "memory");
#undef KL_STAGE
}
__device__ __forceinline__ void acc_zero(f32x4 (&acc)[4][2][2]) {
#pragma unroll
    for (int m = 0; m < 4; ++m)
#pragma unroll
        for (int bj = 0; bj < 2; ++bj)
#pragma unroll
            for (int n = 0; n < 2; ++n) acc[m][bj][n] = (f32x4){0.f, 0.f, 0.f, 0.f};
}

__device__ __forceinline__ int win_src_col(int v, int& nvalid) {
    const int pn = v >> 8, bj = (v >> 7) & 1, hd = (v >> 5) & 3;
    nvalid = 32;
    if (pn < 2) return (4 * pn + hd) * 64 + 32 * bj;
    if (pn == 2) return (hd < 2 ? 512 + hd * 64 : 640 + (hd - 2) * 64) + 32 * bj;
    if (pn == 3) return (hd < 2 ? 768 + hd * 64 : 896 + (hd - 2) * 64) + 32 * bj;
    if (pn == 4) return (hd < 2 ? 1024 + hd * 64 : 1152 + (hd - 2) * 64) + 32 * bj;
    if (pn < 7) return 1304 + (4 * (pn - 5) + hd) * 64 + 32 * bj;
    if (pn == 7) return (hd < 2 ? 1816 + hd * 64 : 1944 + (hd - 2) * 64) + 32 * bj;
    return 2072 + (v - 2048);
}
struct TrItem { const float* W; bf16_t* WT; int ldw, srccol0, nvalid, K, k0; };
__device__ __forceinline__ void tr_load(const TrItem& it, float (&r)[32], int lane) {
    const int n = lane & 31; const float* p = it.W + (size_t)(it.k0 + (lane >> 5)) * it.ldw + it.srccol0 + n; const bool ok = n < it.nvalid;
#pragma unroll
    for (int i = 0; i < 32; ++i) r[i] = ok ? p[(size_t)(2 * i) * it.ldw] : 0.f;
}
__device__ __forceinline__ void tr_finish(const TrItem& it, const float (&r)[32], LAS float* scr, int lane) {
#pragma unroll
    for (int i = 0; i < 32; ++i) scr[(2 * i + (lane >> 5)) * 33 + (lane & 31)] = r[i];
    WSYNC();
    const int c = lane & 7;
#pragma unroll
    for (int j = 0; j < 4; ++j) { const int n = (lane >> 3) + 8 * j; const LAS float* s = scr + (8 * c) * 33 + n;
        u32x4 o; o.x = pk2(s[0 * 33], s[1 * 33]); o.y = pk2(s[2 * 33], s[3 * 33]); o.z = pk2(s[4 * 33], s[5 * 33]); o.w = pk2(s[6 * 33], s[7 * 33]);
        *(u32x4*)(it.WT + (size_t)n * it.K + it.k0 + 8 * c) = o; }
    WSYNC();
}
__device__ __forceinline__ void tr_item64(const float* W, int ldw, int sc0, int K, bf16_t* WT, int k0, LAS float* scr, int lane, int sc1 = -1, int nv0 = 32, int nv1 = 32) {
    const int kr = lane >> 4, nq = lane & 15;
    f32x4 r[16];
    { const int sc = (sc1 < 0) ? sc0 + 4 * nq : ((nq < 8 ? sc0 : sc1) + 4 * (nq & 7)); const bool ok = 4 * (nq & 7) + 3 < (nq < 8 ? nv0 : nv1);
      const float* p = W + (size_t)(k0 + kr) * ldw + sc;
#pragma unroll
      for (int i = 0; i < 16; ++i) r[i] = ok ? *(const f32x4*)(p + (size_t)(4 * i) * ldw) : (f32x4){0.f, 0.f, 0.f, 0.f}; }
#pragma unroll
    for (int i = 0; i < 16; ++i) { LAS float* d = scr + (4 * i + kr) * 65 + 4 * nq; d[0] = r[i].x; d[1] = r[i].y; d[2] = r[i].z; d[3] = r[i].w; }
    WSYNC();
    const int c = lane & 7;
#pragma unroll
    for (int j = 0; j < 8; ++j) { const int n = (lane >> 3) + 8 * j; const LAS float* s = scr + (8 * c) * 65 + n;
        u32x4 o; o.x = pk2(s[0 * 65], s[1 * 65]); o.y = pk2(s[2 * 65], s[3 * 65]); o.z = pk2(s[4 * 65], s[5 * 65]); o.w = pk2(s[6 * 65], s[7 * 65]);
        *(u32x4*)(WT + (size_t)n * K + k0 + 8 * c) = o; }
    WSYNC();
}
__device__ __forceinline__ void tr_item8(const float* W, int ldw, int sc_lo, int sc_hi, int k0, unsigned char* W8, unsigned char* SB, LAS float* scr, int lane) {
    const int kr = lane >> 3, nq = lane & 7;
    f32x4 r[16]; float amax = 0.f;
    { const float* p = W + (size_t)(k0 + kr) * ldw + (nq < 4 ? sc_lo + 4 * nq : sc_hi + 4 * (nq - 4));
#pragma unroll
      for (int i = 0; i < 16; ++i) r[i] = *(const f32x4*)(p + (size_t)(8 * i) * ldw); }
#pragma unroll
    for (int i = 0; i < 16; ++i) { LAS float* d = scr + (8 * i + kr) * 33 + 4 * nq; d[0] = r[i].x; d[1] = r[i].y; d[2] = r[i].z; d[3] = r[i].w;
        amax = fmaxf(amax, fmaxf(fmaxf(fabsf(r[i].x), fabsf(r[i].y)), fmaxf(fabsf(r[i].z), fabsf(r[i].w)))); }
    amax = wave_max(amax);
    int e = (int)((__float_as_uint(amax) >> 23) & 0xffu) - 127 - 8; e = e < -127 ? -127 : e;
    const float inv = __uint_as_float((unsigned)(127 - e) << 23);
    WSYNC();
    const int c = lane & 7;
#pragma unroll
    for (int j = 0; j < 4; ++j) { const int n = (lane >> 3) + 8 * j; const LAS float* s = scr + (16 * c) * 33 + n; float v[16];
#pragma unroll
        for (int q = 0; q < 16; ++q) v[q] = fminf(fmaxf(s[q * 33] * inv, -448.0f), 448.0f);
        u32x4 o; o.x = f4_to_fp8(v[0], v[1], v[2], v[3]); o.y = f4_to_fp8(v[4], v[5], v[6], v[7]); o.z = f4_to_fp8(v[8], v[9], v[10], v[11]); o.w = f4_to_fp8(v[12], v[13], v[14], v[15]);
        *(u32x4*)(W8 + (size_t)n * 1024 + k0 + 16 * c) = o; }
    if (lane == 0) SB[k0 >> 7] = (unsigned char)(e + 127);
    WSYNC();
}
template <int PART>
__device__ __forceinline__ void phase_prologue(Frame& F) {
    const int gw = F.bid * NWAVES + F.wave, NGW = F.G * NWAVES;
    const int gt = F.bid * NTHREADS + F.tid, NGT = F.G * NTHREADS;
    LAS float* scr = (LAS float*)(F.lds + F.wave * 17408);
    unsigned char* ws = F.ws;
    if (PART == 0) {
        constexpr int WGS = 1024 + 16;
        LAS bf16_t* wg = (LAS bf16_t*)F.lds;
        for (int r = F.tid; r < 1024; r += NTHREADS) { const float* p = F.in[I_WIN] + (size_t)r * IN_COLS + 1280;
#pragma unroll
            for (int j = 0; j < 6; ++j) { const f32x4 v = *(const f32x4*)(p + 4 * j); wg[(4 * j) * WGS + r] = (bf16_t)f2bf(v.x); wg[(4 * j + 1) * WGS + r] = (bf16_t)f2bf(v.y); wg[(4 * j + 2) * WGS + r] = (bf16_t)f2bf(v.z); wg[(4 * j + 3) * WGS + r] = (bf16_t)f2bf(v.w); }
#pragma unroll
            for (int j = 24; j < 32; ++j) wg[j * WGS + r] = 0; }
        __syncthreads();
        const int fr = F.lane & 15, fq = F.lane >> 4, kh = F.wave >> 2, wq = F.wave & 3;
        LAS float* part = (LAS float*)(F.lds + 69632) + (wq * 64 + F.lane) * 8;
        for (int base = 0; base < NTOK / 16; base += 4 * F.G) {
            const int grp = base + wq * F.G + F.bid; const bool act = grp < NTOK / 16;
            f32x4 a0 = {0.f, 0.f, 0.f, 0.f}, a1 = {0.f, 0.f, 0.f, 0.f};
            if (act) {
                const size_t o = (size_t)(grp * 16 + fr) * 1024 + 8 * fq + 512 * kh;
                const float* xr = F.in[I_X] + o; bf16_t* xb = (bf16_t*)(ws + WS_XB) + o; unsigned char* xb8 = ws + WS_XB8 + o;
                const LAS bf16_t* w0 = wg + fr * WGS + 8 * fq + 512 * kh; const LAS bf16_t* w1 = wg + (16 + fr) * WGS + 8 * fq + 512 * kh;
#pragma unroll 8
                for (int st = 0; st < 16; ++st) { const f32x4 v0 = *(const f32x4*)(xr + st * 32), v1 = *(const f32x4*)(xr + st * 32 + 4);
                    u32x4 w; w.x = pk2(v0.x, v0.y); w.y = pk2(v0.z, v0.w); w.z = pk2(v1.x, v1.y); w.w = pk2(v1.z, v1.w); *(u32x4*)(xb + st * 32) = w;
                    { const f32x4 lo4 = {-448.f, -448.f, -448.f, -448.f}, hi4 = {448.f, 448.f, 448.f, 448.f}; const f32x4 c0 = __builtin_elementwise_min(__builtin_elementwise_max(v0 * 16.0f, lo4), hi4), c1 = __builtin_elementwise_min(__builtin_elementwise_max(v1 * 16.0f, lo4), hi4);
                      u32x2 w8; w8.x = f4_to_fp8(c0.x, c0.y, c0.z, c0.w); w8.y = f4_to_fp8(c1.x, c1.y, c1.z, c1.w); *(u32x2*)(xb8 + st * 32) = w8; }
                    const bf16x8 xa = __builtin_bit_cast(bf16x8, w);
                    a0 = __builtin_amdgcn_mfma_f32_16x16x32_bf16(*(const LAS bf16x8*)(w0 + st * 32), xa, a0, 0, 0, 0);
                    a1 = __builtin_amdgcn_mfma_f32_16x16x32_bf16(*(const LAS bf16x8*)(w1 + st * 32), xa, a1, 0, 0, 0); }
            }
            if (kh == 1) { *(LAS f32x4*)part = a0; *(LAS f32x4*)(part + 4) = a1; }
            __syncthreads();
            if (kh == 0 && act) { a0 += *(const LAS f32x4*)part; a1 += *(const LAS f32x4*)(part + 4);
                float* gn = (float*)(ws + WS_GN) + (size_t)(grp * 16 + fr) * 24 + 4 * fq;
                f32x4 s0, s1;
#pragma unroll
                for (int i = 0; i < 4; ++i) { s0[i] = sigmoidf_(a0[i]); s1[i] = sigmoidf_(a1[i]); }
                *(f32x4*)gn = s0; if (fq < 2) *(f32x4*)(gn + 16) = s1; }
            __syncthreads();
        }
    }
    if (PART == 0) { float* cs = (float*)(ws + WS_COS); float* sn = (float*)(ws + WS_SIN);
      for (int i = gt; i < SEQ * 32; i += NGT) { const int pos = i >> 5, j = i & 31;
          const float inv = powf(10000.0f, -(float)j / 32.0f); const float ang = (float)pos * inv;
          double t = (double)ang * 0.15915494309189535; t -= floor(t); const float tf = (float)t;
          cs[i] = __builtin_amdgcn_cosf(tf); sn[i] = __builtin_amdgcn_sinf(tf); } }
    if (PART == 0) { for (int o = F.wave * F.G + F.bid; o < 64; o += NWAVES * F.G) { const int which = o >> 5, ch = o & 31; const float* pe = F.in[which ? I_VPE : I_KPE] + ch * 64; const float* w1 = F.in[which ? I_VW1 : I_KW1] + (size_t)ch * 64 * 128;
          float s0 = 0.f, s1 = 0.f;
#pragma unroll 16
          for (int i = 0; i < 64; ++i) { const float p = pe[i]; s0 += p * w1[(size_t)i * 128 + F.lane]; s1 += p * w1[(size_t)i * 128 + 64 + F.lane]; }
          float* dst = (float*)(ws + WS_C1P) + (size_t)o * 128; dst[F.lane] = s0; dst[64 + F.lane] = s1; } }
    constexpr int IT_WIN = 16 * (NVC / 32), IT_BR = 8 * 32, IT_WOUT = 16 * 32, IT_W1 = 32 * 4, IT_W2 = 2 * 2, IT_EIN = 16 * 64, IT_EOUT = 16 * 32;
    constexpr int O_WIN = 0, O_BRN = O_WIN + IT_WIN, O_BRS = O_BRN + IT_BR, O_WOUT = O_BRS + IT_BR, O_W1K = O_WOUT + IT_WOUT, O_W1V = O_W1K + IT_W1, O_W2K = O_W1V + IT_W1, O_W2V = O_W2K + IT_W2,
                  O_EIN = O_W2V + IT_W2, O_EOUT = O_EIN + NEXP * IT_EIN, O_END = O_EOUT + NEXP * IT_EOUT;
    auto decode = [&](int it, TrItem& T) {
        if (it < O_BRN) { const int r = it - O_WIN, nblk = NVC / 32, kb = r / nblk, nb = r % nblk; int nv; const int sc = win_src_col(nb * 32, nv);
            T = TrItem{F.in[I_WIN], (bf16_t*)(ws + WS_WIN) + (size_t)nb * 32 * 1024, IN_COLS, sc, nv, 1024, kb * 64}; }
        else if (it < O_WOUT) { const bool s = it >= O_BRS; const int r = it - (s ? O_BRS : O_BRN), kb = r / 32, nb = r % 32;
            T = TrItem{F.in[s ? I_WBRS : I_WBRN], (bf16_t*)(ws + (s ? WS_WBRS : WS_WBRN)) + (size_t)nb * 32 * 512, 1024, nb * 32, 32, 512, kb * 64}; }
        else if (it < O_W1K) { const int r = it - O_WOUT, kb = r / 32, nb = r % 32;
            T = TrItem{F.in[I_WOUT], (bf16_t*)(ws + WS_WOUT) + (size_t)nb * 32 * 1024, 1024, nb * 32, 32, 1024, kb * 64}; }
        else if (it < O_W2K) { const bool s = it >= O_W1V; const int r = it - (s ? O_W1V : O_W1K), kb = r / 4, nb = r % 4;
            T = TrItem{F.in[s ? I_VW1 : I_KW1], (bf16_t*)(ws + (s ? WS_W1VT : WS_W1KT)) + (size_t)nb * 32 * 2048, 128, nb * 32, 32, 2048, kb * 64}; }
        else if (it < O_EIN) { const bool s = it >= O_W2V; const int r = it - (s ? O_W2V : O_W2K), kb = r / 2, nb = r % 2;
            T = TrItem{F.in[s ? I_VW2 : I_KW2], (bf16_t*)(ws + (s ? WS_W2VT : WS_W2KT)) + (size_t)nb * 32 * 128, 64, nb * 32, 32, 128, kb * 64}; }
        else if (it < O_EOUT) { const int r0 = it - O_EIN, e = r0 / IT_EIN, r = r0 % IT_EIN, kb = r / 64, nb = r % 64;
            const int sc = ((nb >> 2) & 1) * 1024 + (nb >> 3) * 128 + (nb & 3) * 32;
            T = TrItem{F.in[I_WEIN] + (size_t)e * 1024 * 2048, (bf16_t*)(ws + WS_WEIN) + ((size_t)e * 2048 + nb * 32) * 1024, 2048, sc, 32, 1024, kb * 64}; }
        else { const int r0 = it - O_EOUT, e = r0 / IT_EOUT, r = r0 % IT_EOUT, kb = r / 32, nb = r % 32;
            T = TrItem{F.in[I_WEOUT] + (size_t)e * 1024 * 1024, (bf16_t*)(ws + WS_WEOUT) + ((size_t)e * 1024 + nb * 32) * 1024, 1024, nb * 32, 32, 1024, kb * 64}; }
    };
    LAS float* scr2 = scr + 64 * 33;
    if (PART == 1) {
        for (int it = gw; it < NEXP * 512; it += NGW) { const int e = it >> 9, r = it & 511, kb = r >> 6, nb = r & 63; const size_t row0 = (size_t)e * 2048 + nb * 32;
            const int sc = ((nb >> 2) & 1) * 1024 + (nb >> 3) * 128 + (nb & 3) * 32;
            tr_item8(F.in[I_WEIN] + (size_t)e * 1024 * 2048, 2048, sc, sc + 16, kb * 128, (unsigned char*)(ws + WS_WEIN) + row0 * 1024, (unsigned char*)(ws + WS_SC1) + (row0 >> 5) * 8, scr, F.lane); }
        return;
    }
    if (PART == 2) {
        for (int it = gw; it < NEXP * 256; it += NGW) { const int e = it >> 8, r = it & 255, kb = r >> 5, nb = r & 31; const size_t row0 = (size_t)e * 1024 + nb * 32;
            tr_item8(F.in[I_WEOUT] + (size_t)e * 1024 * 1024, 1024, nb * 32, nb * 32 + 16, kb * 128, (unsigned char*)(ws + WS_WEOUT) + row0 * 1024, (unsigned char*)(ws + WS_SC2) + (row0 >> 5) * 8, scr, F.lane); }
        return;
    }
    for (int it = gw; it < 8 * 64; it += NGW) { const int kb = it >> 6, nb = it & 63;
        tr_item8(F.in[I_WIN], IN_COLS, 2072 + 32 * nb, 2072 + 32 * nb + 16, kb * 128, (unsigned char*)(ws + WS_WG8) + (size_t)nb * 32 * 1024, (unsigned char*)(ws + WS_SCG) + nb * 8, scr, F.lane); }
    for (int it = gw; it < 16 * (NVC / 64); it += NGW) { const int kb = it / (NVC / 64), nb = it % (NVC / 64); int nv0, nv1; const int s0 = win_src_col(nb * 64, nv0), s1 = win_src_col(nb * 64 + 32, nv1);
        tr_item64(F.in[I_WIN], IN_COLS, s0, 1024, (bf16_t*)(ws + WS_WIN) + (size_t)nb * 64 * 1024, kb * 64, scr, F.lane, s1, nv0, nv1); }
    for (int it = O_BRN + gw; it < O_EIN; it += 2 * NGW) {
        TrItem Ta, Tb; float ra[32], rb[32]; const bool two = it + NGW < O_EIN;
        decode(it, Ta); tr_load(Ta, ra, F.lane);
        if (two) { decode(it + NGW, Tb); tr_load(Tb, rb, F.lane); }
        tr_finish(Ta, ra, scr, F.lane);
        if (two) tr_finish(Tb, rb, scr2, F.lane);
    }
}

__device__ __forceinline__ bf16_t* kv_tensor(unsigned char* ws, int idx) { return (bf16_t*)(ws + WS_KV + (size_t)idx * KV_BYTES); }
namespace pg8 {
#define PG8_LAS __attribute__((address_space(3)))
typedef unsigned short bf16_t;
typedef short bf16x8 __attribute__((ext_vector_type(8)));
typedef float f32x4 __attribute__((ext_vector_type(4)));
typedef unsigned u32x4 __attribute__((ext_vector_type(4)));
typedef int i32x4 __attribute__((ext_vector_type(4)));
typedef int i32x8 __attribute__((ext_vector_type(8)));
constexpr int BM = 256, BK = 64, HALF = 128, HTB = HALF * BK * 2  , STAGE_BYTES = 8 * HTB, NXCD = 8, WGM = 8;

__host__ __device__ __forceinline__ int lds_byte(int r, int c) { const int st = (r >> 4) * 2 + (c >> 5), rr = r & 15, cc = c & 31, ob = rr * 64 + cc * 2; return st * 1024 + (ob ^ (((ob >> 9) & 1) << 5)); }
__host__ __device__ __forceinline__ void stage_rc(int b, int& R, int& C) { const int st = b / 1024, sb = b % 1024, swz = sb ^ (((sb >> 9) & 1) << 5); R = (st >> 1) * 16 + swz / 64; C = (st & 1) * 32 + (swz % 64) / 2; }
__host__ __device__ __forceinline__ int perm32(int rho) { const int n = rho >> 4, i = rho & 15; return 8 * (i >> 2) + 4 * n + (i & 3); }

struct Unit { int pm, pn; };
struct Gemm { const bf16_t* A; const bf16_t* Bt; int M, N, K; const unsigned char* Bs = nullptr; unsigned ascale = 0x7f7f7f7fu; };

struct StaticOrder {
    static constexpr bool GATHER = false;
    int nM, nN, nwg, G, c;
    __host__ __device__ void init(int M, int N, int G_, int c_) { nM = M / BM; nN = N / BM; nwg = nM * nN; G = G_; c = c_; }
    __host__ __device__ bool next(int i, Unit& u) const {
        const long L = (long)i * G + c; if (L >= nwg) return false;
        int wgid = (int)L; { const int q = nwg / NXCD, r = nwg % NXCD, xcd = wgid % NXCD, off = wgid / NXCD; wgid = (xcd < r ? xcd * (q + 1) : r * (q + 1) + (xcd - r) * q) + off; }
        const int nig = WGM * nN, gid = wgid / nig, fm = gid * WGM, gsz = (nM - fm) < WGM ? (nM - fm) : WGM;
        u.pm = fm + ((wgid % nig) % gsz); u.pn = (wgid % nig) / gsz; return true;
    }
    __device__ __forceinline__ void a_ready(const Unit&) const {}
    __device__ __forceinline__ void done(const Unit&) const {}
};

__device__ __forceinline__ unsigned cvt_pk_bf16(float lo, float hi) { typedef float f2_ __attribute__((ext_vector_type(2))); typedef __bf16 b2_ __attribute__((ext_vector_type(2))); const f2_ v = {lo, hi}; return __builtin_bit_cast(unsigned, __builtin_convertvector(v, b2_)); }
__device__ __forceinline__ unsigned pk2e(float lo, float hi) { return cvt_pk_bf16(lo, hi); }
__device__ __forceinline__ u32x4 pack8(const f32x4 a, const f32x4 b) { u32x4 w; w.x = pk2e(a[0], a[1]); w.y = pk2e(a[2], a[3]); w.z = pk2e(b[0], b[1]); w.w = pk2e(b[2], b[3]); return w; }
__device__ __forceinline__ f32x4 sig4(const f32x4 v) { f32x4 r; r[0] = frcp(1.0f + __expf(-v[0])); r[1] = frcp(1.0f + __expf(-v[1])); r[2] = frcp(1.0f + __expf(-v[2])); r[3] = frcp(1.0f + __expf(-v[3])); return r; }
struct EpiInProj {
    static constexpr bool CHAIN = false;
    static constexpr bool PERM = true, AFTER_DRAIN = false;
    unsigned char* ws;
    __device__ __forceinline__ void operator()(const f32x4 (&acc)[2][2][4][2], const Unit& u, int wr, int wc, int fr, int fq) const {
        const int pn = u.pn; const float* COS = (const float*)(ws + WS_COS); const float* SIN = (const float*)(ws + WS_SIN);
#pragma unroll
        for (int ai = 0; ai < 2; ++ai)
#pragma unroll
            for (int m = 0; m < 4; ++m) {
                const int row = u.pm * BM + ai * HALF + wr * 64 + m * 16 + fr;
                if (pn < 8) {
                    const int pos = row & (SEQ - 1), bb = row >> 13, dlo = 8 * fq;
                    const f32x4 a0 = acc[ai][0][m][0], a1 = acc[ai][0][m][1], b0 = acc[ai][1][m][0], b1 = acc[ai][1][m][1];
                    const bool isq = (pn < 2) || pn == 5 || pn == 6;
                    const int pair = (pn == 2) ? 0 : (pn == 3) ? 1 : (pn == 4) ? 2 : 3; const bool isv = wc >= 2;
                    const bool rope = isq || (!isv && pair != 0);
                    f32x4 ra0 = a0, ra1 = a1, rb0 = b0, rb1 = b1;
                    if (rope) { const f32x4 c0 = *(const f32x4*)(COS + pos * 32 + dlo), c1 = *(const f32x4*)(COS + pos * 32 + dlo + 4), s0 = *(const f32x4*)(SIN + pos * 32 + dlo), s1 = *(const f32x4*)(SIN + pos * 32 + dlo + 4);
                        ra0 = a0 * c0 - b0 * s0; ra1 = a1 * c1 - b1 * s1; rb0 = b0 * c0 + a0 * s0; rb1 = b1 * c1 + a1 * s1; }
                    if (isq) {
                        const int head = (pn < 2 ? 4 * pn : 4 * (pn - 5)) + wc;
                        bf16_t* qr = (bf16_t*)(ws + (pn < 2 ? WS_QR : WS_QS)) + (size_t)row * 512 + head * 64 + dlo;
                        *(u32x4*)qr = pack8(ra0 * C2, ra1 * C2); *(u32x4*)(qr + 32) = pack8(rb0 * C2, rb1 * C2);
                        if (pn < 2) { bf16_t* qc = (bf16_t*)(ws + WS_QC) + (size_t)row * 512 + head * 64 + dlo; *(u32x4*)qc = pack8(a0 * C2, a1 * C2); *(u32x4*)(qc + 32) = pack8(b0 * C2, b1 * C2); }
                    } else {
                        bf16_t* dst = kv_tensor(ws, pair * 2 + (isv ? 1 : 0)) + ((size_t)(bb * 2 + (wc & 1)) * SEQ + pos) * 64 + dlo;
                        *(u32x4*)dst = pack8(ra0, ra1); *(u32x4*)(dst + 32) = pack8(rb0, rb1);
                    }
                }
            }
    }
};
struct EpiGate {
    static constexpr bool CHAIN = false;
    static constexpr bool PERM = true, AFTER_DRAIN = false;
    unsigned char* ws;
    __device__ __forceinline__ void operator()(const f32x4 (&acc)[2][2][4][2], const Unit& u, int wr, int wc, int fr, int fq) const {
#pragma unroll
        for (int ai = 0; ai < 2; ++ai)
#pragma unroll
            for (int m = 0; m < 4; ++m) { const int row = u.pm * BM + ai * HALF + wr * 64 + m * 16 + fr;
                bf16_t* gm = (bf16_t*)(ws + WS_GM) + (size_t)row * 2048 + u.pn * 256 + wc * 32 + 8 * fq;
#pragma unroll
                for (int bj = 0; bj < 2; ++bj) *(u32x4*)(gm + bj * HALF) = pack8(sig4(acc[ai][bj][m][0]), sig4(acc[ai][bj][m][1])); }
    }
};
struct EpiResid {
    static constexpr bool CHAIN = false;
    static constexpr bool PERM = true, AFTER_DRAIN = false;
    const float* X; bf16_t* Z;
    __device__ __forceinline__ void operator()(const f32x4 (&acc)[2][2][4][2], const Unit& u, int wr, int wc, int fr, int fq) const {
#pragma unroll
        for (int ai = 0; ai < 2; ++ai)
#pragma unroll
            for (int m = 0; m < 4; ++m) { const size_t off = (size_t)(u.pm * BM + ai * HALF + wr * 64 + m * 16 + fr) * 1024 + u.pn * BM + wc * 32 + 8 * fq;
#pragma unroll
                for (int bj = 0; bj < 2; ++bj) { const size_t o = off + bj * HALF;
                    *(u32x4*)(Z + o) = pack8(*(const f32x4*)(X + o) * DN_ALPHA + acc[ai][bj][m][0], *(const f32x4*)(X + o + 4) * DN_ALPHA + acc[ai][bj][m][1]); } }
    }
};
struct EpiSwiGLU {
    static constexpr bool CHAIN = false;
    static constexpr bool PERM = true, AFTER_DRAIN = false;
    const float* bin; unsigned char* ACT;
    __device__ __forceinline__ void operator()(const f32x4 (&acc)[2][2][4][2], const Unit& u, int wr, int wc, int fr, int fq) const {
        const int e = u.pn >> 3, col0 = (u.pn & 7) * 128 + wc * 32 + 8 * fq; const float* be = bin + (size_t)e * 2048 + col0;
        const f32x4 bg0 = *(const f32x4*)be, bg1 = *(const f32x4*)(be + 4), bu0 = *(const f32x4*)(be + 1024), bu1 = *(const f32x4*)(be + 1028);
#pragma unroll
        for (int ai = 0; ai < 2; ++ai)
#pragma unroll
            for (int m = 0; m < 4; ++m) { const size_t row = (size_t)u.pm * BM + ai * HALF + wr * 64 + m * 16 + fr;
                f32x4 o[2];
#pragma unroll
                for (int n = 0; n < 2; ++n) { const f32x4 hg = acc[ai][0][m][n] + (n ? bg1 : bg0), hu = acc[ai][1][m][n] + (n ? bu1 : bu0);
#pragma unroll
                    for (int i = 0; i < 4; ++i) { const float g = fminf(hg[i], 7.0f), uu = fminf(fmaxf(hu[i], -7.0f), 7.0f); o[n][i] = g * frcp(1.0f + __expf(-1.702f * g)) * (uu + 1.0f); } }
                u32x2 w8; w8.x = f4_to_fp8(o[0][0], o[0][1], o[0][2], o[0][3]); w8.y = f4_to_fp8(o[1][0], o[1][1], o[1][2], o[1][3]); *(u32x2*)(ACT + row * 1024 + col0) = w8; }
    }
};
struct EpiDown {
    static constexpr bool CHAIN = false;
    static constexpr bool PERM = true, AFTER_DRAIN = false;
    const float* bout; bf16_t* YS;
    __device__ __forceinline__ void operator()(const f32x4 (&acc)[2][2][4][2], const Unit& u, int wr, int wc, int fr, int fq) const {
        const int e = u.pn >> 2, col0 = (u.pn & 3) * 256 + wc * 32 + 8 * fq; const float* be = bout + (size_t)e * 1024 + col0;
#pragma unroll
        for (int bj = 0; bj < 2; ++bj) { const f32x4 b0 = *(const f32x4*)(be + bj * HALF), b1 = *(const f32x4*)(be + bj * HALF + 4);
#pragma unroll
            for (int ai = 0; ai < 2; ++ai)
#pragma unroll
                for (int m = 0; m < 4; ++m) { const size_t row = (size_t)u.pm * BM + ai * HALF + wr * 64 + m * 16 + fr;
                    const f32x4 lo4 = {-448.f, -448.f, -448.f, -448.f}, hi4 = {448.f, 448.f, 448.f, 448.f};
                    const f32x4 c0 = __builtin_elementwise_min(__builtin_elementwise_max((acc[ai][bj][m][0] + b0) * 16.0f, lo4), hi4), c1 = __builtin_elementwise_min(__builtin_elementwise_max((acc[ai][bj][m][1] + b1) * 16.0f, lo4), hi4);
                    u32x2 w8; w8.x = f4_to_fp8(c0[0], c0[1], c0[2], c0[3]); w8.y = f4_to_fp8(c1[0], c1[1], c1[2], c1[3]); *(u32x2*)((unsigned char*)YS + row * 1024 + col0 + bj * HALF) = w8; } }
    }
};
struct EpiBranch {
    static constexpr bool CHAIN = true;
    static constexpr bool PERM = true, AFTER_DRAIN = false;
    const bf16_t* GM; bf16_t* MIXED;
    __device__ __forceinline__ bool keep(const Unit& u) const { return u.pm < 64; }
    __device__ __forceinline__ void mid(f32x4 (&acc)[2][2][4][2], const Unit& u, int wr, int wc, int fr, int fq) const {
#pragma unroll
        for (int ai = 0; ai < 2; ++ai)
#pragma unroll
            for (int m = 0; m < 4; ++m) { const size_t row = (size_t)(u.pm & 63) * BM + ai * HALF + wr * 64 + m * 16 + fr;
#pragma unroll
                for (int bj = 0; bj < 2; ++bj) { const int col0 = (u.pn & 3) * BM + bj * HALF + wc * 32 + 8 * fq;
                    const u32x4 g1 = *(const u32x4*)(GM + row * 2048 + col0), g2 = *(const u32x4*)(GM + row * 2048 + 1024 + col0);
#pragma unroll
                    for (int q = 0; q < 4; ++q) { const float a1 = __uint_as_float(g1[q] << 16), b1 = __uint_as_float(g1[q] & 0xffff0000u), a2 = fmaxf(__uint_as_float(g2[q] << 16), 1e-30f), b2 = fmaxf(__uint_as_float(g2[q] & 0xffff0000u), 1e-30f);
                        acc[ai][bj][m][q >> 1][2 * (q & 1)] *= a1 * frcp(a2); acc[ai][bj][m][q >> 1][2 * (q & 1) + 1] *= b1 * frcp(b2); } } }
    }
    __device__ __forceinline__ void operator()(const f32x4 (&acc)[2][2][4][2], const Unit& u, int wr, int wc, int fr, int fq) const {
#pragma unroll
        for (int ai = 0; ai < 2; ++ai)
#pragma unroll
            for (int m = 0; m < 4; ++m) { const size_t row = (size_t)(u.pm & 63) * BM + ai * HALF + wr * 64 + m * 16 + fr;
#pragma unroll
                for (int bj = 0; bj < 2; ++bj) { const int col0 = (u.pn & 3) * BM + bj * HALF + wc * 32 + 8 * fq;
                    const u32x4 g2 = *(const u32x4*)(GM + row * 2048 + 1024 + col0); f32x4 o0, o1;
#pragma unroll
                    for (int q = 0; q < 4; ++q) { const float a2 = fmaxf(__uint_as_float(g2[q] << 16), 1e-30f), b2 = fmaxf(__uint_as_float(g2[q] & 0xffff0000u), 1e-30f);
                        const float v0 = acc[ai][bj][m][q >> 1][2 * (q & 1)] * a2, v1 = acc[ai][bj][m][q >> 1][2 * (q & 1) + 1] * b2;
                        if (q < 2) { o0[2 * q] = v0; o0[2 * q + 1] = v1; } else { o1[2 * (q - 2)] = v0; o1[2 * (q - 2) + 1] = v1; } }
                    *(u32x4*)(MIXED + row * 1024 + col0) = pack8(o0, o1); } }
    }
};
struct BranchOrder {
    static constexpr bool GATHER = false;
    StaticOrder so;
    __device__ __forceinline__ bool next(int i, Unit& u) const { if (!so.next(i >> 1, u)) return false; u.pm += (i & 1) * 64; u.pn += (i & 1) * 4; return true; }
    __device__ __forceinline__ void a_ready(const Unit&) const {}
    __device__ __forceinline__ void done(const Unit&) const {}
    __device__ __forceinline__ int a_row(const Unit&, int) const { return 0; }
};
template <bool GATHER_>
struct ExpertOrder {
    static constexpr bool GATHER = GATHER_;
    const PG8_LAS int* base_s; int ntiles, npn, G, c; const PG8_LAS int* cnt_s; const int* TOK;
    __device__ __forceinline__ bool next(int i, Unit& u) const {
        const int nwg = ntiles * npn; const int L = i * G + c; if (L >= nwg) return false;
        int wgid = L; { const int q = nwg / NXCD, r = nwg % NXCD, xcd = wgid % NXCD, off = wgid / NXCD; wgid = (xcd < r ? xcd * (q + 1) : r * (q + 1) + (xcd - r) * q) + off; }
        const int gt = wgid / npn, pp = wgid % npn; const int e = base_s[64 + gt];
        u.pm = gt; u.pn = e * npn + pp; return true;
    }
    __device__ __forceinline__ int a_row(const Unit& u, int r) const {
        const int e = u.pn / npn; int pos = (u.pm - base_s[e]) * BM + r; const int last = cnt_s[e] - 1; pos = pos < last ? pos : last;
        return TOK[e * NTOK + pos];
    }
    __device__ __forceinline__ void a_ready(const Unit&) const {}
    __device__ __forceinline__ void done(const Unit&) const {}
};
template <class Epi, class Sched, bool ALIGN_EPI = false, bool SP2 = false, bool FP8 = false, bool HALFN = false>
__device__ __forceinline__ void gemm_phase(PG8_LAS unsigned char* lds, const Gemm g, const Sched& S, const Epi& E) {
    const int tid = threadIdx.x, wid = __builtin_amdgcn_readfirstlane(tid >> 6), lane = tid & 63, wr = wid >> 2, wc = wid & 3, fr = lane & 15, fq = lane >> 4;
    static_assert((!FP8 && !HALFN) || SP2, "the FP8 / HALFN paths are written for the SP2 loop");
    const int K = g.K, nt = K / BK;
    unsigned voffA[2][2], voffN[2][2], voffB[2]; int stR[2], stC[2];
#pragma unroll
    for (int i = 0; i < 2; ++i) { int R, C; stage_rc(tid * 16 + i * 8192, R, C); const int Rb = Epi::PERM ? ((R & ~31) + perm32(R & 31)) : R; stR[i] = R; stC[i] = C;
        voffA[0][i] = (unsigned)(R * K + C) * 2u; voffA[1][i] = (unsigned)((R + HALF) * K + C) * 2u; voffB[i] = (unsigned)(Rb * K + C) * 2u;
        voffN[0][i] = voffA[0][i]; voffN[1][i] = voffA[1][i]; }
#define PG8_AOFF(dst, u) do { if constexpr (Sched::GATHER) { _Pragma("unroll") for (int h_ = 0; h_ < 2; ++h_) _Pragma("unroll") for (int i_ = 0; i_ < 2; ++i_) \
        dst[h_][i_] = (unsigned)(S.a_row(u, h_ * HALF + stR[i_]) * K + stC[i_]) * 2u; } } while (0)
    const size_t kstep = (size_t)(BK * 2);
    const size_t hstep = (size_t)HALF * K * 2;
    const size_t tstep = 2 * hstep;
    const unsigned ldsw = (unsigned)wid * 1024u;
    const int aoff = lds_byte(wr * 64 + fr, fq * 8), boff = lds_byte(wc * 32 + fr, fq * 8);
    constexpr int KFS = 1024;
#define PG8_SA(b, h) (((b) * 2 + (h)) * HTB)
#define PG8_SB(b, h) ((4 + (b) * 2 + (h)) * HTB)
#define PG8_STAGE(bufoff, gbase, voff) do { _Pragma("unroll") for (int _i = 0; _i < 2; ++_i) \
        __builtin_amdgcn_global_load_lds((const unsigned*)((const char*)(gbase) + (voff)[_i]), (PG8_LAS unsigned*)(lds + (bufoff) + ldsw + _i * 8192), 16, 0, 0); } while (0)
#define PG8_LDA(dst, b, h) do { _Pragma("unroll") for (int m = 0; m < 4; ++m) _Pragma("unroll") for (int k = 0; k < 2; ++k) dst[m][k] = *(const PG8_LAS bf16x8*)(lds + PG8_SA(b, h) + aoff + m * 2048 + k * KFS); } while (0)
#define PG8_LDB(dst, b, h) do { _Pragma("unroll") for (int n = 0; n < 2; ++n) _Pragma("unroll") for (int k = 0; k < 2; ++k) dst[n][k] = *(const PG8_LAS bf16x8*)(lds + PG8_SB(b, h) + boff + n * 2048 + k * KFS); } while (0)
#define PG8_MMA(ai, bj, At, Bt) do { __builtin_amdgcn_s_setprio(1); \
        if constexpr (FP8) { const unsigned sb_ = (unsigned)bsc[bj]; _Pragma("unroll") for (int m = 0; m < 4; ++m) _Pragma("unroll") for (int n = 0; n < 2; ++n) { \
            const i32x8 bw_ = __builtin_shufflevector(__builtin_bit_cast(i32x4, Bt[n][0]), __builtin_bit_cast(i32x4, Bt[n][1]), 0, 1, 2, 3, 4, 5, 6, 7), aw_ = __builtin_shufflevector(__builtin_bit_cast(i32x4, At[m][0]), __builtin_bit_cast(i32x4, At[m][1]), 0, 1, 2, 3, 4, 5, 6, 7); \
            asm volatile("v_mfma_scale_f32_16x16x128_f8f6f4 %0, %1, %2, %0, %3, %4 op_sel_hi:[0,0,0]" : "+v"(acc[ai][bj][m][n]) : "v"(bw_), "v"(aw_), "v"(sb_), "v"(g.ascale)); } } \
        else { _Pragma("unroll") for (int m = 0; m < 4; ++m) _Pragma("unroll") for (int n = 0; n < 2; ++n) { _Pragma("unroll") for (int k = 0; k < 2; ++k) acc[ai][bj][m][n] = __builtin_amdgcn_mfma_f32_16x16x32_bf16(Bt[n][k], At[m][k], acc[ai][bj][m][n], 0, 0, 0); } } \
        __builtin_amdgcn_s_setprio(0); } while (0)
#define PG8_SCSHIFT() do { if constexpr (FP8) { bsc[0] >>= 8; bsc[1] >>= 8; } } while (0)
#define PG8_WAIT_V(n) asm volatile("s_waitcnt vmcnt(" #n ")" ::: "memory")
#define PG8_WAIT_L(n) asm volatile("s_waitcnt lgkmcnt(" #n ")" ::: "memory")
#define PG8_BAR __builtin_amdgcn_s_barrier()
#define PG8_SCHED __builtin_amdgcn_sched_barrier(0)
    Unit cur, nxt; int ui = 0;
    if (!S.next(0, cur)) return;
    f32x4 acc[2][2][4][2];
#pragma unroll
    for (int a = 0; a < 2; ++a)
#pragma unroll
        for (int b = 0; b < 2; ++b)
#pragma unroll
            for (int m = 0; m < 4; ++m)
#pragma unroll
                for (int n = 0; n < 2; ++n) acc[a][b][m][n] = (f32x4){0.f, 0.f, 0.f, 0.f};
    bf16x8 At[4][2], B0[2][2], B1[2][2];
    unsigned long long bsc[2] = {0ull, 0ull};
#define PG8_SCLOAD(u) do { if constexpr (FP8) { _Pragma("unroll") for (int bj_ = 0; bj_ < (HALFN ? 1 : 2); ++bj_) { const int grp_ = ((u).pn * (HALFN ? HALF : BM) + bj_ * HALF) / 32 + wc; \
        const unsigned long long v_ = *(const unsigned long long*)(g.Bs + (size_t)grp_ * 8); bsc[bj_] = ((unsigned long long)(unsigned)__builtin_amdgcn_readfirstlane((int)(v_ >> 32)) << 32) | (unsigned)__builtin_amdgcn_readfirstlane((int)v_); } } } while (0)
    const char* cA = Sched::GATHER ? (const char*)g.A : (const char*)g.A + (size_t)cur.pm * tstep; const char* cB = (const char*)g.Bt + (size_t)cur.pn * (HALFN ? hstep : tstep);
    PG8_AOFF(voffA, cur);
    PG8_SCLOAD(cur);
    S.a_ready(cur);
    if constexpr (SP2) {
        PG8_STAGE(PG8_SB(0, 0), cB, voffB); if constexpr (!HALFN) { PG8_STAGE(PG8_SB(0, 1), cB + hstep, voffB); } PG8_STAGE(PG8_SA(0, 0), cA, voffA[0]); PG8_STAGE(PG8_SA(0, 1), cA, voffA[1]);
        if (wr == 1) PG8_BAR;
        PG8_WAIT_V(2); PG8_BAR;
        PG8_STAGE(PG8_SB(1, 0), cB + kstep, voffB); PG8_STAGE(PG8_SA(1, 0), cA + kstep, voffA[0]); if constexpr (!HALFN) { PG8_STAGE(PG8_SB(1, 1), cB + hstep + kstep, voffB); }
        if constexpr (HALFN) { PG8_WAIT_V(4); } else { PG8_WAIT_V(6); } PG8_BAR;
    } else {
        PG8_STAGE(PG8_SB(0, 0), cB, voffB); PG8_STAGE(PG8_SA(0, 0), cA, voffA[0]); PG8_STAGE(PG8_SB(0, 1), cB + hstep, voffB); PG8_STAGE(PG8_SA(0, 1), cA, voffA[1]);
        if (wr == 1) PG8_BAR;
        PG8_WAIT_V(4); PG8_BAR;
        PG8_STAGE(PG8_SB(1, 0), cB + kstep, voffB); PG8_STAGE(PG8_SA(1, 0), cA + kstep, voffA[0]); PG8_STAGE(PG8_SB(1, 1), cB + hstep + kstep, voffB);
        PG8_WAIT_V(6); PG8_BAR;
    }
    for (;;) {
        const bool has_next = S.next(ui + 1, nxt);
        const char* nA = (has_next && !Sched::GATHER) ? (const char*)g.A + (size_t)nxt.pm * tstep : cA; const char* nB = has_next ? (const char*)g.Bt + (size_t)nxt.pn * (HALFN ? hstep : tstep) : cB;
        if (has_next) { PG8_AOFF(voffN, nxt); }
#pragma unroll 1
        for (int t = 0; t < nt; t += 2) {
            const bool last = (t == nt - 2);
            unsigned va2[2][2];
#pragma unroll
            for (int h_ = 0; h_ < 2; ++h_)
#pragma unroll
                for (int i_ = 0; i_ < 2; ++i_) va2[h_][i_] = (Sched::GATHER && last) ? voffN[h_][i_] : voffA[h_][i_];
            const char* a1 = cA + (size_t)(t + 1) * kstep;
            const char* a2 = last ? nA : cA + (size_t)(t + 2) * kstep; const char* b2 = last ? nB : cB + (size_t)(t + 2) * kstep;
            const char* a3 = a2 + kstep; const char* b3 = b2 + kstep;
            if (last && has_next) S.a_ready(nxt);
            if constexpr (SP2) {
            PG8_LDB(B0, 0, 0); if constexpr (!HALFN) { PG8_LDB(B1, 0, 1); } PG8_SCHED; PG8_LDA(At, 0, 0); PG8_STAGE(PG8_SA(1, 1), a1, voffA[1]);
            if constexpr (HALFN) { PG8_WAIT_V(6); } else { PG8_WAIT_V(8); } PG8_WAIT_L(0); PG8_BAR; PG8_MMA(0, 0, At, B0); if constexpr (!HALFN) { PG8_MMA(0, 1, At, B1); } PG8_BAR; PG8_SCHED;
            PG8_LDA(At, 0, 1); PG8_STAGE(PG8_SB(0, 0), b2, voffB); if constexpr (!HALFN) { PG8_STAGE(PG8_SB(0, 1), b2 + hstep, voffB); } PG8_STAGE(PG8_SA(0, 0), a2, va2[0]);
            if constexpr (HALFN) { PG8_WAIT_V(6); } else { PG8_WAIT_V(8); } PG8_WAIT_L(0); PG8_BAR; PG8_MMA(1, 0, At, B0); if constexpr (!HALFN) { PG8_MMA(1, 1, At, B1); } PG8_SCSHIFT(); PG8_BAR; PG8_SCHED;
            PG8_LDB(B0, 1, 0); if constexpr (!HALFN) { PG8_LDB(B1, 1, 1); } PG8_SCHED; PG8_LDA(At, 1, 0); PG8_STAGE(PG8_SA(0, 1), a2, va2[1]);
            if constexpr (HALFN) { PG8_WAIT_V(6); } else { PG8_WAIT_V(8); } PG8_WAIT_L(0); PG8_BAR; PG8_MMA(0, 0, At, B0); if constexpr (!HALFN) { PG8_MMA(0, 1, At, B1); } PG8_BAR; PG8_SCHED;
            PG8_LDA(At, 1, 1); PG8_STAGE(PG8_SB(1, 0), b3, voffB); if constexpr (!HALFN) { PG8_STAGE(PG8_SB(1, 1), b3 + hstep, voffB); } PG8_STAGE(PG8_SA(1, 0), a3, va2[0]);
            if constexpr (HALFN) { PG8_WAIT_V(6); } else { PG8_WAIT_V(8); } PG8_WAIT_L(0); PG8_BAR; PG8_MMA(1, 0, At, B0); if constexpr (!HALFN) { PG8_MMA(1, 1, At, B1); } PG8_SCSHIFT(); PG8_BAR; PG8_SCHED;
            } else {
            PG8_LDB(B0, 0, 0); PG8_SCHED; PG8_LDA(At, 0, 0); PG8_STAGE(PG8_SA(1, 1), a1, voffA[1]);
            PG8_WAIT_L(8); PG8_BAR; PG8_WAIT_L(0); PG8_MMA(0, 0, At, B0); PG8_BAR; PG8_SCHED;
            PG8_LDB(B1, 0, 1); PG8_STAGE(PG8_SB(0, 0), b2, voffB);
            PG8_BAR; PG8_WAIT_L(0); PG8_MMA(0, 1, At, B1); PG8_BAR;
            PG8_LDA(At, 0, 1); PG8_STAGE(PG8_SA(0, 0), a2, va2[0]);
            PG8_BAR; PG8_WAIT_L(0); PG8_MMA(1, 0, At, B0); PG8_BAR; PG8_SCHED;
            PG8_STAGE(PG8_SB(0, 1), b2 + hstep, voffB);
            PG8_WAIT_V(6); PG8_BAR; PG8_MMA(1, 1, At, B1); PG8_BAR;
            PG8_LDB(B0, 1, 0); PG8_SCHED; PG8_LDA(At, 1, 0); PG8_STAGE(PG8_SA(0, 1), a2, va2[1]);
            PG8_WAIT_L(8); PG8_BAR; PG8_WAIT_L(0); PG8_MMA(0, 0, At, B0); PG8_BAR; PG8_SCHED;
            PG8_LDB(B1, 1, 1); PG8_STAGE(PG8_SB(1, 0), b3, voffB);
            PG8_BAR; PG8_WAIT_L(0); PG8_MMA(0, 1, At, B1); PG8_BAR;
            PG8_LDA(At, 1, 1); PG8_STAGE(PG8_SA(1, 0), a3, va2[0]);
            PG8_BAR; PG8_WAIT_L(0); PG8_MMA(1, 0, At, B0); PG8_BAR; PG8_SCHED;
            PG8_STAGE(PG8_SB(1, 1), b3 + hstep, voffB);
            PG8_WAIT_V(6); PG8_BAR; PG8_MMA(1, 1, At, B1); PG8_BAR;
            }
        }
        if constexpr (ALIGN_EPI) { if (wr == 0) PG8_BAR; }
        if constexpr (FP8) {
#define PG8_ACC8(a, b, m0) "+v"(acc[a][b][m0][0]), "+v"(acc[a][b][m0][1]), "+v"(acc[a][b][m0 + 1][0]), "+v"(acc[a][b][m0 + 1][1])
            asm volatile("s_nop 7\n\ts_nop 7\n\ts_nop 7" : PG8_ACC8(0, 0, 0), PG8_ACC8(0, 0, 2), PG8_ACC8(0, 1, 0), PG8_ACC8(0, 1, 2));
            asm volatile("" : PG8_ACC8(1, 0, 0), PG8_ACC8(1, 0, 2), PG8_ACC8(1, 1, 0), PG8_ACC8(1, 1, 2));
#undef PG8_ACC8
        }
        bool keep = false;
        if constexpr (Epi::CHAIN) keep = E.keep(cur);
        const int lane_e = (int)__builtin_amdgcn_mbcnt_hi(~0u, __builtin_amdgcn_mbcnt_lo(~0u, 0u)); int fr_e = lane_e & 15, fq_e = lane_e >> 4; asm volatile("" : "+v"(fr_e), "+v"(fq_e));
        if constexpr (Epi::CHAIN) { if (keep) E.mid(acc, cur, wr, wc, fr_e, fq_e); }
        if constexpr (!Epi::AFTER_DRAIN) { if (!keep) E(acc, cur, wr, wc, fr_e, fq_e); S.done(cur); }
        if (!has_next) break;
        if (!keep)
#pragma unroll
        for (int a = 0; a < 2; ++a)
#pragma unroll
            for (int b = 0; b < 2; ++b)
#pragma unroll
                for (int m = 0; m < 4; ++m)
#pragma unroll
                    for (int n = 0; n < 2; ++n) acc[a][b][m][n] = (f32x4){0.f, 0.f, 0.f, 0.f};
        cur = nxt; cA = nA; cB = nB; ++ui;
        PG8_SCLOAD(cur);
        if constexpr (Sched::GATHER) { _Pragma("unroll") for (int h_ = 0; h_ < 2; ++h_) _Pragma("unroll") for (int i_ = 0; i_ < 2; ++i_) voffA[h_][i_] = voffN[h_][i_]; }
        if constexpr (ALIGN_EPI) { if (wr == 1) PG8_BAR; }
    }
    PG8_WAIT_V(0);
    if constexpr (!ALIGN_EPI) { if (wr == 0) PG8_BAR; }
    PG8_BAR;
    if constexpr (Epi::AFTER_DRAIN) { E.fused(acc, cur, wr, wc, fr, fq, lds, wid, lane); S.done(cur); }
#undef PG8_AOFF
#undef PG8_SA
#undef PG8_SB
#undef PG8_STAGE
#undef PG8_LDA
#undef PG8_LDB
#undef PG8_MMA
#undef PG8_SCSHIFT
#undef PG8_SCLOAD
#undef PG8_WAIT_V
#undef PG8_WAIT_L
#undef PG8_BAR
#undef PG8_SCHED
}
}

__device__ __forceinline__ void phase_inproj(Frame& F) {
    pg8::Gemm g{(const bf16_t*)(F.ws + WS_XB), (const bf16_t*)(F.ws + WS_WIN), NTOK, NVC, 1024};
    pg8::StaticOrder S; S.init(NTOK, NVC, F.G, F.bid);
    pg8::EpiInProj E{F.ws};
    pg8::gemm_phase<pg8::EpiInProj, pg8::StaticOrder, true, true>(F.lds, g, S, E);
    pg8::Gemm g8{(const bf16_t*)(F.ws + WS_XB8), (const bf16_t*)(F.ws + WS_WG8), NTOK, NVG, 512, (const unsigned char*)(F.ws + WS_SCG), 0x7b7b7b7bu};
    pg8::StaticOrder S8; S8.init(NTOK, NVG, F.G, F.bid);
    pg8::EpiGate E8{F.ws};
    pg8::gemm_phase<pg8::EpiGate, pg8::StaticOrder, true, true, true, false>(F.lds, g8, S8, E8);
}

__device__ __forceinline__ float gelu_tanh(float x) { const float u = 0.7978845608028654f * (x + 0.044715f * x * x * x); return 0.5f * x * (1.0f + tanhf(u)); }
__device__ __forceinline__ void cmp1_unit(Frame& F, int u) {
    unsigned char* ws = F.ws;
    const int wr = F.wave >> 2, wc = F.wave & 3, fr = F.lane & 15, fq = F.lane >> 4;
    {
        const int which = u >> 4, bg = (u >> 2) & 3, rt = u & 3;
        const bf16_t* src = kv_tensor(ws, which) + (size_t)bg * SEQ * 64;
        const bf16_t* a = src + (size_t)(rt * 128 + (F.tid >> 2)) * 1024 + (F.tid & 3) * 8;
        const bf16_t* b0 = (const bf16_t*)(ws + (which ? WS_W1VT : WS_W1KT)) + (size_t)(F.tid >> 2) * 2048 + (F.tid & 3) * 8;
        const float* c1p = (const float*)(ws + WS_C1P) + (size_t)which * 32 * 128;
        bf16_t* HID = (bf16_t*)(ws + (which ? WS_HIDV : WS_HIDK)) + (size_t)bg * 512 * 128;
        f32x4 acc[4][2][2]; acc_zero(acc);
        gemm_kloop<false>(F.lds, a, b0, b0, 2048, acc, F.wave, F.lane);
#pragma unroll
        for (int m = 0; m < 4; ++m) { const int row = rt * 128 + wr * 64 + m * 16 + fr;
#pragma unroll
            for (int n = 0; n < 2; ++n) { const int col = wc * 32 + n * 16 + 4 * fq; f32x4 bv = {0.f, 0.f, 0.f, 0.f};
#pragma unroll 8
                for (int p2 = 0; p2 < 32; ++p2) bv += *(const f32x4*)(c1p + p2 * 128 + col);
                const f32x4 v = acc[m][0][n] + bv;
                u32x2 w; w.x = pk2(gelu_tanh(v.x), gelu_tanh(v.y)); w.y = pk2(gelu_tanh(v.z), gelu_tanh(v.w)); *(u32x2*)(HID + (size_t)row * 128 + col) = w; } }
    }
}
__device__ __forceinline__ void cmp2_unit(Frame& F, int u) {
    unsigned char* ws = F.ws;
    const int wr = F.wave >> 2, wc = F.wave & 3, fr = F.lane & 15, fq = F.lane >> 4;
    {
        const int which = u >> 4, bg = (u >> 2) & 3, rt = u & 3;
        const bf16_t* HID = (const bf16_t*)(ws + (which ? WS_HIDV : WS_HIDK)) + (size_t)bg * 512 * 128;
        const bf16_t* a = HID + (size_t)(rt * 128 + (F.tid >> 2)) * 128 + (F.tid & 3) * 8;
        const bf16_t* b0 = (const bf16_t*)(ws + (which ? WS_W2VT : WS_W2KT)) + (size_t)(F.tid >> 2) * 128 + (F.tid & 3) * 8;
        bf16_t* OUT = (bf16_t*)(ws + (which ? WS_VCMP : WS_KCMP)) + (size_t)bg * 512 * 64;
        f32x4 acc[4][2][2]; acc_zero(acc);
        gemm_kloop<false>(F.lds, a, b0, b0, 128, acc, F.wave, F.lane);
        if (wc < 2) {
#pragma unroll
            for (int m = 0; m < 4; ++m) { const int row = rt * 128 + wr * 64 + m * 16 + fr;
#pragma unroll
                for (int n = 0; n < 2; ++n) { const int col = wc * 32 + n * 16 + 4 * fq; const f32x4 v = acc[m][0][n];
                    u32x2 w; w.x = pk2(v.x, v.y); w.y = pk2(v.z, v.w); *(u32x2*)(OUT + (size_t)row * 64 + col) = w; } }
        }
    }
}

namespace att {
typedef short s16x4 __attribute__((ext_vector_type(4)));
typedef float f32x16 __attribute__((ext_vector_type(16)));
typedef float f32x2_t __attribute__((ext_vector_type(2))); typedef __bf16 bf16x2_t __attribute__((ext_vector_type(2)));
constexpr int NW = 8, QBLK = 32, QB = 256, KVBLK = 64, KP = 64, QP = 512;
constexpr int NSLOT = 3, SLOTB = 8192;
constexpr int LDS_K = 0, LDS_V = NSLOT * SLOTB, LDS_WS = 2 * NSLOT * SLOTB, LDS_OST = LDS_WS + NW * 256, LDS_Q = LDS_OST + NW * 4096, LDS_SW = LDS_Q + NW * 4096, LDS_BYTES = LDS_SW + NW * 1024;
enum { M_SEL = 0, M_WIN = 1, M_SWA = 2 };
__device__ __forceinline__ int crow(int r, int hi) { return (r & 3) + 8 * (r >> 2) + 4 * hi; }
#define SBAR() __builtin_amdgcn_sched_barrier(0)
__device__ __forceinline__ void cmask(f32x16& p0, f32x16& p1, int jb, int qrel, int hi) {
    const float NEG = -__builtin_inff(); const int kb = 64 * jb + 4 * hi;
#pragma unroll
    for (int r = 0; r < 16; ++r) { const int kv = kb + (r & 3) + 8 * (r >> 2); if (kv > qrel) p0[r] = NEG; if (kv + 32 > qrel) p1[r] = NEG; }
}
__device__ __forceinline__ void lmask(f32x16& p0, f32x16& p1, int t, int qrel, int hi) {
    const float NEG = -__builtin_inff(); const int kb = 64 * t + 4 * hi;
#pragma unroll
    for (int r = 0; r < 16; ++r) { const int kv = kb + (r & 3) + 8 * (r >> 2); if (kv <= qrel) p0[r] = NEG; if (kv + 32 <= qrel) p1[r] = NEG; }
}
__device__ __forceinline__ void glds16(const void* gsrc, unsigned lds_dst) { unsigned keep;
    asm volatile("s_mov_b32 %0, m0\n\ts_mov_b32 m0, %2\n\ts_nop 0\n\tglobal_load_lds_dwordx4 %1, off\n\ts_mov_b32 m0, %0" : "=&s"(keep) : "v"(gsrc), "s"(lds_dst) : "memory"); }
__device__ __forceinline__ float max3f(float a, float b, float c) { float r; asm("v_max3_f32 %0, %1, %2, %3" : "=v"(r) : "v"(a), "v"(b), "v"(c)); return r; }
__device__ __forceinline__ float max2f(float a, float b) { float r; asm("v_max_f32_e32 %0, %1, %2" : "=v"(r) : "v"(a), "v"(b)); return r; }
__device__ __forceinline__ float fadd_s(float a, float b) { float r; asm("v_add_f32_e32 %0, %1, %2" : "=v"(r) : "v"(a), "v"(b)); return r; }
__device__ __forceinline__ float fsub_s(float a, float b) { float r; asm("v_sub_f32_e32 %0, %1, %2" : "=v"(r) : "v"(a), "v"(b)); return r; }
__device__ __forceinline__ unsigned cvtpk_s(float lo, float hi) { f32x2_t v = {lo, hi}; bf16x2_t b = __builtin_convertvector(v, bf16x2_t); return __builtin_bit_cast(unsigned, b); }
#define WAIT_BAR(N) asm volatile("s_waitcnt vmcnt(" #N ") lgkmcnt(0)\n\ts_barrier" ::: "memory")
__device__ __forceinline__ void qkt(f32x16& p0, f32x16& p1, const char* Kslot, const bf16x8* qr, const f32x16& negm, int r32, int hi) {
    const char* kb = Kslot + hi * 1024 + r32 * 16;
#pragma unroll
    for (int d0 = 0; d0 < 4; ++d0) {
        const bf16x8 b0 = *reinterpret_cast<const bf16x8*>(kb + d0 * 2048);
        const bf16x8 b1 = *reinterpret_cast<const bf16x8*>(kb + d0 * 2048 + 512);
        if (d0 == 0) { p0 = __builtin_amdgcn_mfma_f32_32x32x16_bf16(b0, qr[0], negm, 0, 0, 0); p1 = __builtin_amdgcn_mfma_f32_32x32x16_bf16(b1, qr[0], negm, 0, 0, 0); }
        else { p0 = __builtin_amdgcn_mfma_f32_32x32x16_bf16(b0, qr[d0], p0, 0, 0, 0); p1 = __builtin_amdgcn_mfma_f32_32x32x16_bf16(b1, qr[d0], p1, 0, 0, 0); } }
}
typedef __attribute__((address_space(3))) const char* lds_cptr;
typedef short v4i16_t __attribute__((ext_vector_type(4)));
__device__ __forceinline__ void kload8(bf16x8* kf, lds_cptr kp) {
    kf[0] = *(const LAS bf16x8*)(kp);        kf[1] = *(const LAS bf16x8*)(kp + 512);
    kf[2] = *(const LAS bf16x8*)(kp + 2048); kf[3] = *(const LAS bf16x8*)(kp + 2560);
    kf[4] = *(const LAS bf16x8*)(kp + 4096); kf[5] = *(const LAS bf16x8*)(kp + 4608);
    kf[6] = *(const LAS bf16x8*)(kp + 6144); kf[7] = *(const LAS bf16x8*)(kp + 6656);
}
__device__ __forceinline__ void kload2(bf16x8* kf, lds_cptr kp, int j) { kf[2 * j] = *(const LAS bf16x8*)(kp + j * 2048); kf[2 * j + 1] = *(const LAS bf16x8*)(kp + j * 2048 + 512); }
__device__ __forceinline__ s16x4 vtr(lds_cptr p) { return __builtin_bit_cast(s16x4, __builtin_amdgcn_ds_read_tr16_b64_v4i16((LAS v4i16_t*)p)); }
__device__ __forceinline__ float rowmax(const f32x16& p0, const f32x16& p1) {
    float a = max3f(p0[0], p0[1], p1[0]), b = max3f(p0[2], p0[3], p1[1]); a = max3f(a, p1[2], p1[3]);
#pragma unroll
    for (int r = 4; r < 16; r += 4) { a = max3f(a, p0[r], p0[r + 1]); b = max3f(b, p0[r + 2], p0[r + 3]); a = max3f(a, p1[r], p1[r + 1]); b = max3f(b, p1[r + 2], p1[r + 3]); }
    const float m = max2f(a, b);
    auto rr = __builtin_amdgcn_permlane32_swap(__float_as_uint(m), __float_as_uint(m), false, false);
    return max2f(__uint_as_float(rr[0]), __uint_as_float(rr[1]));
}
__device__ __forceinline__ void pv(f32x16* o, int vb, bf16x8 pa0, bf16x8 pa1, bf16x8 pa2, bf16x8 pa3) {
#pragma unroll
    for (int d0 = 0; d0 < 2; ++d0) { s16x4 lo[4], hi[4];
#pragma unroll
        for (int ks = 0; ks < 4; ++ks) {
            asm volatile("ds_read_b64_tr_b16 %0,%1 offset:%c2" : "=&v"(lo[ks]) : "v"(vb), "i"(d0 * 4096 + ks * 1024) : "memory");
            asm volatile("ds_read_b64_tr_b16 %0,%1 offset:%c2" : "=&v"(hi[ks]) : "v"(vb), "i"(d0 * 4096 + ks * 1024 + 512) : "memory"); }
        asm volatile("s_waitcnt lgkmcnt(0)" ::: "memory"); SBAR();
#define PK(k) (bf16x8){lo[k][0], lo[k][1], lo[k][2], lo[k][3], hi[k][0], hi[k][1], hi[k][2], hi[k][3]}
        o[d0] = __builtin_amdgcn_mfma_f32_32x32x16_bf16(pa0, PK(0), o[d0], 0, 0, 0);
        o[d0] = __builtin_amdgcn_mfma_f32_32x32x16_bf16(pa1, PK(1), o[d0], 0, 0, 0);
        o[d0] = __builtin_amdgcn_mfma_f32_32x32x16_bf16(pa2, PK(2), o[d0], 0, 0, 0);
        o[d0] = __builtin_amdgcn_mfma_f32_32x32x16_bf16(pa3, PK(3), o[d0], 0, 0, 0);
#undef PK
    }
}
struct Tens { const bf16_t* Q; const bf16_t* K; const bf16_t* V; const unsigned* SEL; const float* GN; bf16_t* OB; const float* sinks; };
constexpr int S_K = 0, S_V = 16384, S_WS = 32768, S_OST = S_WS + NW * 256, S_BYTES = S_OST + NW * 4096;
template <int MODE, int THRL> __device__ __forceinline__ void attn_unit(int b, int h, int qb, const Tens& T, char* shm) {
    const int tid = threadIdx.x, lane = tid & 63, r32 = lane & 31, hi = lane >> 5; const int wid = __builtin_amdgcn_readfirstlane(tid >> 6);
    const int bg = b * 2 + (h >> 2); const long rowbase = (long)b * SEQ; const int q0 = qb * QB;
    constexpr int W = (MODE == M_WIN) ? 512 : 128;
    const bool lower = (MODE != M_SEL) && (q0 + QB - 1 >= W);
    const int t0 = (MODE != M_SEL && q0 >= W) ? (q0 - W) / KVBLK : 0;
    const int NT = (q0 + QB) / KVBLK - t0;
    const int loff = q0 - W - t0 * KVBLK;
    const bf16_t* Qw = T.Q + (rowbase + q0 + wid * QBLK) * QP + h * 64;
    const bf16_t* Kh = T.K + ((long)bg * SEQ + (long)t0 * KVBLK) * KP; const bf16_t* Vh = T.V + ((long)bg * SEQ + (long)t0 * KVBLK) * KP;
    const unsigned lds0 = (unsigned)(uintptr_t)shm;
    float* wsf = (float*)(shm + S_WS) + wid * 64;
    const bf16_t* ksrc = Kh + (long)lane * KP + wid * 8;
    const bf16_t* vsrc = Vh + (long)(16 * (wid & 3) + (lane >> 2)) * KP + (wid >> 2) * 32 + (lane & 3) * 8;
    const unsigned kdst = lds0 + S_K + wid * 1024, vdst = lds0 + S_V + wid * 1024;
#define DMA_K(t, slot) glds16(ksrc + (long)(t) * KVBLK * KP, (unsigned)__builtin_amdgcn_readfirstlane(kdst + (slot)))
#define DMA_V(t, slot) glds16(vsrc + (long)(t) * KVBLK * KP, (unsigned)__builtin_amdgcn_readfirstlane(vdst + (slot)))
    const int vb0 = (int)(lds0 + S_V) + ((lane >> 4) & 1) * 32 + (lane & 3) * 8 + (4 * hi + ((lane & 15) >> 2)) * 64;
    const char* Kbase = shm + S_K;
    DMA_K(0, 0); DMA_V(0, 0);
    bf16x8 qr[4];
#pragma unroll
    for (int d0 = 0; d0 < 4; ++d0) qr[d0] = *reinterpret_cast<const bf16x8*>(&Qw[(long)r32 * QP + d0 * 16 + hi * 8]);
    const int qrel = wid * QBLK + r32;
    u32x4 sw = (u32x4){0u, 0u, 0u, 0u};
    if (MODE == M_SEL) sw = *(const u32x4*)(T.SEL + ((size_t)bg * SEQ + q0 + qrel) * 4);
    float mhat = 0.f, l_reg = 0.f; bool seen = false; f32x16 o[2]; o[0] = f32x16{}; o[1] = f32x16{}; f32x16 negm = f32x16{};
    const float NINF = -__builtin_inff();
#pragma unroll 1
    for (int t = 0; t < NT; ++t) {
        const int slot = (t & 1) * 8192;
        if (t + 1 < NT) { DMA_K(t + 1, slot ^ 8192); DMA_V(t + 1, slot ^ 8192); WAIT_BAR(2); } else { WAIT_BAR(0); }
        f32x16 p0, p1;
        qkt(p0, p1, Kbase + slot, qr, negm, r32, hi);
        { const int jb_ = t - (NT - 4); if (jb_ >= 0) cmask(p0, p1, jb_, qrel, hi); }
        if (MODE != M_SEL) { if (lower && t < 4) lmask(p0, p1, t, qrel + loff, hi); }
        unsigned onm = 0xffffffffu;
        if (MODE == M_SEL) { const unsigned wsel = t < 32 ? sw.x : t < 64 ? sw.y : t < 96 ? sw.z : sw.w; onm = 0u - ((wsel >> (t & 31)) & 1u); }
        float rm;
        { float a = __builtin_fmaxf(__builtin_fmaxf(p0[0], p0[1]), p1[0]), c = __builtin_fmaxf(__builtin_fmaxf(p0[2], p0[3]), p1[1]); a = __builtin_fmaxf(__builtin_fmaxf(a, p1[2]), p1[3]);
#pragma unroll
          for (int r = 4; r < 16; r += 4) { a = __builtin_fmaxf(__builtin_fmaxf(a, p0[r]), p0[r + 1]); c = __builtin_fmaxf(__builtin_fmaxf(c, p0[r + 2]), p0[r + 3]); a = __builtin_fmaxf(__builtin_fmaxf(a, p1[r]), p1[r + 1]); c = __builtin_fmaxf(__builtin_fmaxf(c, p1[r + 2]), p1[r + 3]); }
          rm = __builtin_fmaxf(a, c); auto rr = __builtin_amdgcn_permlane32_swap(__float_as_uint(rm), __float_as_uint(rm), false, false); rm = __builtin_fmaxf(__uint_as_float(rr[0]), __uint_as_float(rr[1])); }
        if (MODE == M_SEL) rm = onm ? rm : NINF;
        const bool live = rm > NINF; const bool need = live && (!seen || rm > (float)THRL);
        if (__any(need)) {
            const float dl = need ? rm : 0.f; mhat += dl;
#pragma unroll
            for (int r = 0; r < 16; ++r) { p0[r] -= dl; p1[r] -= dl; }
#pragma unroll
            for (int r = 0; r < 16; ++r) negm[r] = -mhat;
            const float f = (need && seen) ? __builtin_amdgcn_exp2f(-dl) : 1.0f; l_reg *= f;
            if (hi == 0) wsf[r32] = f;
            asm volatile("s_waitcnt lgkmcnt(0)" ::: "memory");
#pragma unroll
            for (int d_ = 0; d_ < 2; ++d_)
#pragma unroll
                for (int r = 0; r < 16; ++r) o[d_][r] *= wsf[crow(r, hi)];
        }
        seen = seen || live;
        float sacc = 0.f;
#pragma unroll
        for (int r = 0; r < 16; ++r) { p0[r] = __builtin_amdgcn_exp2f(p0[r]); p1[r] = __builtin_amdgcn_exp2f(p1[r]); sacc += p0[r] + p1[r]; }
        l_reg += __uint_as_float(__float_as_uint(sacc) & onm);
        u32x4 pw0, pw1, pw2, pw3;
        pw0 = (u32x4){cvtpk_s(p0[0], p0[1]), cvtpk_s(p0[2], p0[3]), cvtpk_s(p0[4], p0[5]), cvtpk_s(p0[6], p0[7])};
        pw1 = (u32x4){cvtpk_s(p0[8], p0[9]), cvtpk_s(p0[10], p0[11]), cvtpk_s(p0[12], p0[13]), cvtpk_s(p0[14], p0[15])};
        pw2 = (u32x4){cvtpk_s(p1[0], p1[1]), cvtpk_s(p1[2], p1[3]), cvtpk_s(p1[4], p1[5]), cvtpk_s(p1[6], p1[7])};
        pw3 = (u32x4){cvtpk_s(p1[8], p1[9]), cvtpk_s(p1[10], p1[11]), cvtpk_s(p1[12], p1[13]), cvtpk_s(p1[14], p1[15])};
        if (MODE == M_SEL) { pw0 &= onm; pw1 &= onm; pw2 &= onm; pw3 &= onm; }
        SBAR();
        pv(o, vb0 + slot, __builtin_bit_cast(bf16x8, pw0), __builtin_bit_cast(bf16x8, pw1), __builtin_bit_cast(bf16x8, pw2), __builtin_bit_cast(bf16x8, pw3));
        asm volatile("s_waitcnt lgkmcnt(0)\n\ts_barrier" ::: "memory");
    }
    { auto rr = __builtin_amdgcn_permlane32_swap(__float_as_uint(l_reg), __float_as_uint(l_reg), false, false); l_reg = __uint_as_float(rr[0]) + __uint_as_float(rr[1]); }
    if (MODE == M_SWA) l_reg += exp2f(T.sinks[h] * LOG2E - mhat);
    if (hi == 0) { float gate = 1.0f; if (MODE != M_SWA) gate = T.GN[(size_t)(rowbase + q0 + qrel) * 24 + h * 3 + (MODE == M_SEL ? 1 : 2)]; wsf[32 + r32] = l_reg / gate; }
    asm volatile("s_waitcnt lgkmcnt(0)" ::: "memory");
    float rli[16];
#pragma unroll
    for (int r = 0; r < 16; ++r) rli[r] = __builtin_amdgcn_rcpf(wsf[32 + crow(r, hi)]);
    { bf16_t* Ow = T.OB + (rowbase + q0 + wid * QBLK) * 512 + h * 64; bf16_t* stg = (bf16_t*)(shm + S_OST) + wid * 2048;
#pragma unroll
      for (int r = 0; r < 16; ++r) { const int orow = crow(r, hi);
#pragma unroll
          for (int d0 = 0; d0 < 2; ++d0) stg[orow * 64 + d0 * 32 + r32] = (bf16_t)f2bf(o[d0][r] * rli[r]); }
      asm volatile("s_waitcnt lgkmcnt(0)" ::: "memory");
#pragma unroll
      for (int i = 0; i < 4; ++i) { const int row = i * 8 + (lane >> 3), ch = lane & 7; const u32x4 v = *(const u32x4*)(stg + row * 64 + ch * 8); *(u32x4*)(Ow + (long)row * 512 + ch * 8) = v; } }
    asm volatile("s_waitcnt vmcnt(0) lgkmcnt(0)\n\ts_barrier" ::: "memory");
#undef DMA_K
#undef DMA_V
}
constexpr int P_K = 0, P_V = 32768, P_WS = 65536, P_OST = P_WS + NW * 256, P_BYTES = P_OST + NW * 4096;
template <int MODE, int THRL> __device__ __forceinline__ void attn_unit_p(int b, int h, int qb, const Tens& T, char* shm) {
    const int tid = threadIdx.x, lane = tid & 63, r32 = lane & 31, hi = lane >> 5; const int wid = __builtin_amdgcn_readfirstlane(tid >> 6);
    const int bg = b * 2 + (h >> 2); const long rowbase = (long)b * SEQ; const int q0 = qb * QB;
    constexpr int W = (MODE == M_WIN) ? 512 : 128;
    const bool lower = (MODE != M_SEL) && (q0 + QB - 1 >= W);
    const int t0 = (MODE != M_SEL && q0 >= W) ? (q0 - W) / KVBLK : 0;
    const int NT = (q0 + QB) / KVBLK - t0;
    const int loff = q0 - W - t0 * KVBLK;
    const bf16_t* Qw = T.Q + (rowbase + q0 + wid * QBLK) * QP + h * 64;
    const bf16_t* Kh = T.K + ((long)bg * SEQ + (long)t0 * KVBLK) * KP; const bf16_t* Vh = T.V + ((long)bg * SEQ + (long)t0 * KVBLK) * KP;
    const unsigned lds0 = (unsigned)(uintptr_t)shm; const lds_cptr shm3 = (lds_cptr)shm;
    float* wsf = (float*)(shm + P_WS) + wid * 64;
    const bf16_t* ksrc = Kh + (long)lane * KP + wid * 8;
    const bf16_t* vsrc = Vh + (long)(16 * (wid & 3) + (lane >> 2)) * KP + (wid >> 2) * 32 + (lane & 3) * 8;
    const unsigned kdst = lds0 + P_K + wid * 1024, vdst = lds0 + P_V + wid * 1024;
#define DMA_KV(t, slot) do { glds16(ksrc + (long)(t) * KVBLK * KP, (unsigned)__builtin_amdgcn_readfirstlane(kdst + (slot))); glds16(vsrc + (long)(t) * KVBLK * KP, (unsigned)__builtin_amdgcn_readfirstlane(vdst + (slot))); } while (0)
    const lds_cptr kp0 = shm3 + P_K + hi * 1024 + r32 * 16;
    const lds_cptr vp0 = shm3 + P_V + ((lane >> 4) & 1) * 32 + (lane & 3) * 8 + (4 * hi + ((lane & 15) >> 2)) * 64;
    DMA_KV(0, 0); DMA_KV(1, 8192); DMA_KV(2, 16384);
    bf16x8 qr[4];
#pragma unroll
    for (int d0 = 0; d0 < 4; ++d0) qr[d0] = *reinterpret_cast<const bf16x8*>(&Qw[(long)r32 * QP + d0 * 16 + hi * 8]);
    const int qrel = wid * QBLK + r32;
    u32x4 sw = (u32x4){0u, 0u, 0u, 0u};
    if (MODE == M_SEL) sw = *(const u32x4*)(T.SEL + ((size_t)bg * SEQ + q0 + qrel) * 4);
#define SELM(t) ((MODE == M_SEL) ? (0u - ((((t) < 32 ? sw.x : (t) < 64 ? sw.y : (t) < 96 ? sw.z : sw.w) >> ((t) & 31)) & 1u)) : 0xffffffffu)
    float mhat = 0.f, l_reg = 0.f; bool seen = false; f32x16 o[2]; o[0] = f32x16{}; o[1] = f32x16{}; f32x16 negm = f32x16{}; asm volatile("" : "+v"(negm));
    const float NINF = -__builtin_inff();
#define KFR(slot, k) (*(const LAS bf16x8*)(kp0 + (slot) + ((k) >> 1) * 2048 + ((k) & 1) * 512))
#define MASKS(C0, C1, tt) do { const int jb_ = (tt) - (NT - 4); if (jb_ >= 0) cmask(C0, C1, jb_, qrel, hi); if (MODE != M_SEL) { if (lower && (tt) < 4) lmask(C0, C1, (tt), qrel + loff, hi); } } while (0)
#define REFUPD(C0, C1, rm) do { const bool live_ = (rm) > NINF; const bool need_ = live_ && (!seen || (rm) > (float)THRL); \
        if (__any(need_)) { const float dl_ = need_ ? (rm) : 0.f; mhat += dl_; \
            _Pragma("unroll") for (int r = 0; r < 16; ++r) { C0[r] -= dl_; C1[r] -= dl_; } \
            _Pragma("unroll") for (int r = 0; r < 16; ++r) negm[r] = -mhat; asm volatile("" : "+v"(negm)); \
            const float f_ = (need_ && seen) ? __builtin_amdgcn_exp2f(-dl_) : 1.0f; l_reg *= f_; if (hi == 0) wsf[r32] = f_; \
            asm volatile("s_waitcnt lgkmcnt(0)" ::: "memory"); \
            _Pragma("unroll") for (int d_ = 0; d_ < 2; ++d_) _Pragma("unroll") for (int r = 0; r < 16; ++r) o[d_][r] *= wsf[crow(r, hi)]; } \
        seen = seen || live_; } while (0)
#define ROWMAX(C0, C1, rm) do { float a_ = __builtin_fmaxf(__builtin_fmaxf(C0[0], C0[1]), C1[0]), c_ = __builtin_fmaxf(__builtin_fmaxf(C0[2], C0[3]), C1[1]); a_ = __builtin_fmaxf(__builtin_fmaxf(a_, C1[2]), C1[3]); \
        _Pragma("unroll") for (int r = 4; r < 16; r += 4) { a_ = __builtin_fmaxf(__builtin_fmaxf(a_, C0[r]), C0[r + 1]); c_ = __builtin_fmaxf(__builtin_fmaxf(c_, C0[r + 2]), C0[r + 3]); a_ = __builtin_fmaxf(__builtin_fmaxf(a_, C1[r]), C1[r + 1]); c_ = __builtin_fmaxf(__builtin_fmaxf(c_, C1[r + 2]), C1[r + 3]); } \
        rm = __builtin_fmaxf(a_, c_); auto rr_ = __builtin_amdgcn_permlane32_swap(__float_as_uint(rm), __float_as_uint(rm), false, false); rm = __builtin_fmaxf(__uint_as_float(rr_[0]), __uint_as_float(rr_[1])); } while (0)
    f32x16 pA0, pA1, pB0, pB1;
    asm volatile("s_waitcnt vmcnt(4) lgkmcnt(0)\n\ts_barrier" ::: "memory");
    qkt(pA0, pA1, shm + P_K, qr, negm, r32, hi);
    MASKS(pA0, pA1, 0);
    unsigned onm = SELM(0);
    { float rm; ROWMAX(pA0, pA1, rm); if (MODE == M_SEL) rm = onm ? rm : NINF; REFUPD(pA0, pA1, rm); }
    int sk_next = 8192, sv_cur = 0, s_n2 = 16384, s_free = 24576;
    u32x4 pw0, pw1, pw2, pw3;
#define PINV(x) asm volatile("" : "+v"(x))
#define EX4(P, B) do { P[B] = __builtin_amdgcn_exp2f(P[B]); P[B + 1] = __builtin_amdgcn_exp2f(P[B + 1]); P[B + 2] = __builtin_amdgcn_exp2f(P[B + 2]); P[B + 3] = __builtin_amdgcn_exp2f(P[B + 3]); sacc += (P[B] + P[B + 1]) + (P[B + 2] + P[B + 3]); } while (0)
#define PKW2(P, B, PW, I) do { PW[I] = cvtpk_s(P[B], P[B + 1]) & onm; PW[I + 1] = cvtpk_s(P[B + 2], P[B + 3]) & onm; } while (0)
#define VFRAG(i, sv) __builtin_bit_cast(s16x4, __builtin_amdgcn_ds_read_tr16_b64_v4i16((LAS v4i16_t*)(vp0 + (sv) + (((i) >> 2) * 4096 + ((i) & 3) * 1024))))
#define VFRAGH(i, sv) __builtin_bit_cast(s16x4, __builtin_amdgcn_ds_read_tr16_b64_v4i16((LAS v4i16_t*)(vp0 + (sv) + (((i) >> 2) * 4096 + ((i) & 3) * 1024 + 512))))
#define VF8(lo, hi_) (bf16x8){lo[0], lo[1], lo[2], lo[3], hi_[0], hi_[1], hi_[2], hi_[3]}
#define PSTEP(C0, C1, P0, P1, t, HN) do { \
        if ((t) > 0) { if ((t) + 2 < NT) asm volatile("s_waitcnt vmcnt(2) lgkmcnt(0)\n\ts_barrier" ::: "memory"); else asm volatile("s_waitcnt vmcnt(0) lgkmcnt(0)\n\ts_barrier" ::: "memory"); }     \
        if ((t) + 3 < NT) DMA_KV((t) + 3, s_free); \
        float sacc = 0.f; bf16x8 kf_; \
          \
        if (HN) { kf_ = KFR(sk_next, 0); C0 = __builtin_amdgcn_mfma_f32_32x32x16_bf16(kf_, qr[0], negm, 0, 0, 0); } EX4(P0, 0);  PKW2(P0, 0, pw0, 0);  PINV(sacc); PINV(pw0); SBAR(); \
        if (HN) { kf_ = KFR(sk_next, 1); C1 = __builtin_amdgcn_mfma_f32_32x32x16_bf16(kf_, qr[0], negm, 0, 0, 0); } EX4(P0, 4);  PKW2(P0, 4, pw0, 2);  PINV(sacc); PINV(pw0); SBAR(); \
        if (HN) { kf_ = KFR(sk_next, 2); C0 = __builtin_amdgcn_mfma_f32_32x32x16_bf16(kf_, qr[1], C0, 0, 0, 0); }   EX4(P0, 8);  PKW2(P0, 8, pw1, 0);  PINV(sacc); PINV(pw1); SBAR(); \
        if (HN) { kf_ = KFR(sk_next, 3); C1 = __builtin_amdgcn_mfma_f32_32x32x16_bf16(kf_, qr[1], C1, 0, 0, 0); }   EX4(P0, 12); PKW2(P0, 12, pw1, 2); PINV(sacc); PINV(pw1); SBAR(); \
        if (HN) { kf_ = KFR(sk_next, 4); C0 = __builtin_amdgcn_mfma_f32_32x32x16_bf16(kf_, qr[2], C0, 0, 0, 0); }   EX4(P1, 0);  PKW2(P1, 0, pw2, 0);  PINV(sacc); PINV(pw2); SBAR(); \
        if (HN) { kf_ = KFR(sk_next, 5); C1 = __builtin_amdgcn_mfma_f32_32x32x16_bf16(kf_, qr[2], C1, 0, 0, 0); }   EX4(P1, 4);  PKW2(P1, 4, pw2, 2);  PINV(sacc); PINV(pw2); SBAR(); \
        if (HN) { kf_ = KFR(sk_next, 6); C0 = __builtin_amdgcn_mfma_f32_32x32x16_bf16(kf_, qr[3], C0, 0, 0, 0); }   EX4(P1, 8);  PKW2(P1, 8, pw3, 0);  PINV(sacc); PINV(pw3); SBAR(); \
        if (HN) { kf_ = KFR(sk_next, 7); C1 = __builtin_amdgcn_mfma_f32_32x32x16_bf16(kf_, qr[3], C1, 0, 0, 0); }   EX4(P1, 12); PKW2(P1, 12, pw3, 2); PINV(sacc); PINV(pw3); SBAR(); \
        l_reg += __uint_as_float(__float_as_uint(sacc) & onm); \
        unsigned onn_ = 0xffffffffu; float rm_ = NINF; \
        if (HN) { MASKS(C0, C1, (t) + 1); onn_ = SELM((t) + 1); } \
          \
        { s16x4 vl_, vh_; \
          vl_ = VFRAG(0, sv_cur); vh_ = VFRAGH(0, sv_cur); o[0] = __builtin_amdgcn_mfma_f32_32x32x16_bf16(__builtin_bit_cast(bf16x8, pw0), VF8(vl_, vh_), o[0], 0, 0, 0); SBAR(); \
          vl_ = VFRAG(4, sv_cur); vh_ = VFRAGH(4, sv_cur); o[1] = __builtin_amdgcn_mfma_f32_32x32x16_bf16(__builtin_bit_cast(bf16x8, pw0), VF8(vl_, vh_), o[1], 0, 0, 0); SBAR(); \
          vl_ = VFRAG(1, sv_cur); vh_ = VFRAGH(1, sv_cur); o[0] = __builtin_amdgcn_mfma_f32_32x32x16_bf16(__builtin_bit_cast(bf16x8, pw1), VF8(vl_, vh_), o[0], 0, 0, 0); SBAR(); \
          vl_ = VFRAG(5, sv_cur); vh_ = VFRAGH(5, sv_cur); o[1] = __builtin_amdgcn_mfma_f32_32x32x16_bf16(__builtin_bit_cast(bf16x8, pw1), VF8(vl_, vh_), o[1], 0, 0, 0); SBAR(); \
          if (HN) { ROWMAX(C0, C1, rm_); } \
          vl_ = VFRAG(2, sv_cur); vh_ = VFRAGH(2, sv_cur); o[0] = __builtin_amdgcn_mfma_f32_32x32x16_bf16(__builtin_bit_cast(bf16x8, pw2), VF8(vl_, vh_), o[0], 0, 0, 0); SBAR(); \
          vl_ = VFRAG(6, sv_cur); vh_ = VFRAGH(6, sv_cur); o[1] = __builtin_amdgcn_mfma_f32_32x32x16_bf16(__builtin_bit_cast(bf16x8, pw2), VF8(vl_, vh_), o[1], 0, 0, 0); SBAR(); \
          vl_ = VFRAG(3, sv_cur); vh_ = VFRAGH(3, sv_cur); o[0] = __builtin_amdgcn_mfma_f32_32x32x16_bf16(__builtin_bit_cast(bf16x8, pw3), VF8(vl_, vh_), o[0], 0, 0, 0); SBAR(); \
          vl_ = VFRAG(7, sv_cur); vh_ = VFRAGH(7, sv_cur); o[1] = __builtin_amdgcn_mfma_f32_32x32x16_bf16(__builtin_bit_cast(bf16x8, pw3), VF8(vl_, vh_), o[1], 0, 0, 0); SBAR(); } \
        if (HN) { if (MODE == M_SEL) rm_ = onn_ ? rm_ : NINF; REFUPD(C0, C1, rm_); } \
        onm = onn_; { const int f_ = sv_cur; sv_cur = sk_next; sk_next = s_n2; s_n2 = s_free; s_free = f_; } \
    } while (0)
    int t = 0;
#pragma unroll 1
    for (; t + 2 < NT; t += 2) { PSTEP(pB0, pB1, pA0, pA1, t, true); PSTEP(pA0, pA1, pB0, pB1, t + 1, true); }
    PSTEP(pB0, pB1, pA0, pA1, t, true); PSTEP(pA0, pA1, pB0, pB1, t + 1, false);
#undef PSTEP
#undef VF8
#undef VFRAG
#undef VFRAGH
#undef PKW2
#undef EX4
#undef PINV
#undef ROWMAX
#undef REFUPD
#undef MASKS
#undef KFR
#undef SELM
    int lane_e = (int)__builtin_amdgcn_mbcnt_hi(~0u, __builtin_amdgcn_mbcnt_lo(~0u, 0u)); asm volatile("" : "+v"(lane_e));
    const int r32e = lane_e & 31, hie = lane_e >> 5, qrele = wid * QBLK + r32e;
    { auto rr = __builtin_amdgcn_permlane32_swap(__float_as_uint(l_reg), __float_as_uint(l_reg), false, false); l_reg = __uint_as_float(rr[0]) + __uint_as_float(rr[1]); }
    if (MODE == M_SWA) l_reg += exp2f(T.sinks[h] * LOG2E - mhat);
    if (hie == 0) { float gate = 1.0f; if (MODE != M_SWA) gate = T.GN[(size_t)(rowbase + q0 + qrele) * 24 + h * 3 + (MODE == M_SEL ? 1 : 2)]; wsf[32 + r32e] = l_reg / gate; }
    asm volatile("s_waitcnt lgkmcnt(0)" ::: "memory");
    float rli[16];
#pragma unroll
    for (int r = 0; r < 16; ++r) rli[r] = __builtin_amdgcn_rcpf(wsf[32 + crow(r, hie)]);
    { bf16_t* Ow = T.OB + (rowbase + q0 + wid * QBLK) * 512 + h * 64; bf16_t* stg = (bf16_t*)(shm + P_OST) + wid * 2048;
#pragma unroll
      for (int r = 0; r < 16; ++r) { const int orow = crow(r, hie);
#pragma unroll
          for (int d0 = 0; d0 < 2; ++d0) stg[orow * 64 + d0 * 32 + r32e] = (bf16_t)f2bf(o[d0][r] * rli[r]); }
      asm volatile("s_waitcnt lgkmcnt(0)" ::: "memory");
#pragma unroll
      for (int i = 0; i < 4; ++i) { const int row = i * 8 + (lane_e >> 3), ch = lane_e & 7; const u32x4 v = *(const u32x4*)(stg + row * 64 + ch * 8); *(u32x4*)(Ow + (long)row * 512 + ch * 8) = v; } }
    asm volatile("s_waitcnt vmcnt(0) lgkmcnt(0)\n\ts_barrier" ::: "memory");
#undef DMA_KV
}
#undef SBAR
#undef WAIT_BAR
}

__device__ __forceinline__ void phase_attn_fast(Frame& F, char* lds_generic) {
    unsigned char* ws = F.ws;
    const int vcu = (F.G % 8 == 0) ? (F.bid % 8) * (F.G / 8) + F.bid / 8 : F.bid;
    att::Tens Ts{(const bf16_t*)(ws + WS_QR), kv_tensor(ws, 2), kv_tensor(ws, 3), (const unsigned*)(ws + WS_SEL), (const float*)(ws + WS_GN), (bf16_t*)(ws + WS_OSEL), F.in[I_SINK]};
    att::Tens Tw = Ts; Tw.K = kv_tensor(ws, 4); Tw.V = kv_tensor(ws, 5); Tw.OB = (bf16_t*)(ws + WS_OWIN);
    const int cls = (F.bid >> 3) & 3;
    for (int v = vcu; v < 256; v += F.G) {
        const int bh = v >> 4, s = v & 15, b = bh >> 3, h = bh & 7;
#pragma unroll 1
        for (int step = 0; step < 4; ++step) { const int qb = step < 2 ? 31 - s : s;
            if ((step & 1) == 0) att::attn_unit_p<att::M_SEL, 8>(b, h, qb, Ts, lds_generic);
            else { att::attn_unit<att::M_WIN, 8>(b, h, qb, Tw, lds_generic);
            { const float* OC = (const float*)(ws + WS_OF32); const bf16_t* OS = (const bf16_t*)(ws + WS_OSEL); const bf16_t* OW = (const bf16_t*)(ws + WS_OWIN); bf16_t* ON = (bf16_t*)(ws + WS_ONSA);
              for (int e = F.tid; e < 256 * 16; e += NTHREADS) { const size_t idx = ((size_t)b * SEQ + qb * 256 + (e >> 4)) * 512 + h * 64 + (e & 15) * 4;
                  const f32x4 c = *(const f32x4*)(OC + idx); const u32x2 a = *(const u32x2*)(OS + idx), w = *(const u32x2*)(OW + idx);
                  u32x2 r; r.x = pk2(c.x + __uint_as_float(a.x << 16) + __uint_as_float(w.x << 16), c.y + __uint_as_float(a.x & 0xffff0000u) + __uint_as_float(w.x & 0xffff0000u));
                  r.y = pk2(c.z + __uint_as_float(a.y << 16) + __uint_as_float(w.y << 16), c.w + __uint_as_float(a.y & 0xffff0000u) + __uint_as_float(w.y & 0xffff0000u));
                  *(u32x2*)(ON + idx) = r; } } }
            if (cls == step) { __syncthreads(); phase_prologue<1>(F); phase_prologue<2>(F); __syncthreads(); }
        }
    }
}

namespace cmpa {
using att::f32x16; using att::crow;
constexpr int C_K = 0, C_V = 65536, C_IMP = C_V + 16384, C_BYTES = C_IMP + 8 * 4096;
__device__ __forceinline__ u32x4 load_k(const bf16_t* Kg, int tau, int wid, int lane) { return *(const u32x4*)(Kg + (size_t)(64 * tau + lane) * 64 + wid * 8); }
__device__ __forceinline__ u32x4 load_v(const bf16_t* Vg, int tau, int wid, int lane) { return *(const u32x4*)(Vg + (size_t)(64 * tau + 16 * (wid & 3) + (lane >> 2)) * 64 + (wid >> 2) * 32 + (lane & 3) * 8); }
__device__ __forceinline__ float qx1(float v) { return __builtin_bit_cast(float, __builtin_amdgcn_mov_dpp(__builtin_bit_cast(int, v), 0xB1, 0xF, 0xF, true)); }
__device__ __forceinline__ float qx2(float v) { return __builtin_bit_cast(float, __builtin_amdgcn_mov_dpp(__builtin_bit_cast(int, v), 0x4E, 0xF, 0xF, true)); }
__device__ __forceinline__ void cmp_unit(int bg, int qb, unsigned char* ws, char* shm) {
    const int tid = threadIdx.x, lane = tid & 63, r32 = lane & 31, hi = lane >> 5; const int wid = __builtin_amdgcn_readfirstlane(tid >> 6);
    const int b = bg >> 1, g = bg & 1, ql = r32 >> 2, hh = r32 & 3;
    const int s = qb * 64 + wid * 8 + ql; const size_t tok = (size_t)b * SEQ + s;
    const int cmax = s < 31 ? -1 : (s - 31) >> 4;
    const int ntile = (4 * qb + 2) / 64 + 1;
    const bf16_t* Kg = (const bf16_t*)(ws + WS_KCMP) + (size_t)bg * 512 * 64; const bf16_t* Vg = (const bf16_t*)(ws + WS_VCMP) + (size_t)bg * 512 * 64;
    const unsigned lds0 = (unsigned)(uintptr_t)shm;
    float* IMPW = (float*)(shm + C_IMP) + wid * 1024;
    const float NINF = -__builtin_inff();
    __syncthreads();
    { u32x4 kt[8];
#pragma unroll
      for (int tau = 0; tau < 8; ++tau) if (tau < ntile) kt[tau] = load_k(Kg, tau, wid, lane);
#pragma unroll
      for (int tau = 0; tau < 8; ++tau) if (tau < ntile) *(u32x4*)(shm + C_K + tau * 8192 + wid * 1024 + lane * 16) = kt[tau]; }
    u32x4 vnext = load_v(Vg, 0, wid, lane);
    bf16x8 qr[4];
    { const bf16_t* qp = (const bf16_t*)(ws + WS_QC) + tok * 512 + (4 * g + hh) * 64 + hi * 8;
#pragma unroll
      for (int d0 = 0; d0 < 4; ++d0) qr[d0] = *(const bf16x8*)(qp + d0 * 16); }
#pragma unroll
    for (int i = 0; i < 16; ++i) IMPW[i * 64 + lane] = 0.f;
    f32x16 zero16 = f32x16{};
    __syncthreads();
    float m = NINF, l = 0.f;
#pragma unroll 1
    for (int tau = 0; tau < ntile; ++tau) {
        f32x16 p0, p1; att::qkt(p0, p1, shm + C_K + tau * 8192, qr, zero16, r32, hi);
        const int kb = 64 * tau + 4 * hi; float rm = NINF;
#pragma unroll
        for (int r = 0; r < 16; ++r) { const int c = kb + (r & 3) + 8 * (r >> 2); p0[r] = (c <= cmax) ? p0[r] : NINF; p1[r] = (c + 32 <= cmax) ? p1[r] : NINF; rm = fmaxf(rm, fmaxf(p0[r], p1[r])); }
        { auto rr = __builtin_amdgcn_permlane32_swap(__float_as_uint(rm), __float_as_uint(rm), false, false); rm = fmaxf(__uint_as_float(rr[0]), __uint_as_float(rr[1])); }
        const float mn = fmaxf(m, rm);
        if (mn > NINF) { float sacc = 0.f;
#pragma unroll
            for (int r = 0; r < 16; ++r) sacc += __builtin_amdgcn_exp2f(p0[r] - mn) + __builtin_amdgcn_exp2f(p1[r] - mn);
            l = l * __builtin_amdgcn_exp2f(m - mn) + sacc; m = mn; }
    }
    { auto rr = __builtin_amdgcn_permlane32_swap(__float_as_uint(l), __float_as_uint(l), false, false); l = __uint_as_float(rr[0]) + __uint_as_float(rr[1]); }
    const float rl = l > 0.f ? 1.0f / l : 0.f; const float mf = m > NINF ? m : 0.f;
    f32x16 o[2]; o[0] = f32x16{}; o[1] = f32x16{};
    const int vb0 = (int)(lds0 + C_V) + ((lane >> 4) & 1) * 32 + (lane & 3) * 8 + (4 * hi + ((lane & 15) >> 2)) * 64;
#pragma unroll 1
    for (int tau = 0; tau < ntile; ++tau) {
        const int vslot = (tau & 1) * 8192;
        *(u32x4*)(shm + C_V + vslot + wid * 1024 + lane * 16) = vnext;
        if (tau + 1 < ntile) vnext = load_v(Vg, tau + 1, wid, lane);
        __syncthreads();
        f32x16 p0, p1; att::qkt(p0, p1, shm + C_K + tau * 8192, qr, zero16, r32, hi);
        const int kb = 64 * tau + 4 * hi;
#pragma unroll
        for (int r = 0; r < 16; ++r) { const int c = kb + (r & 3) + 8 * (r >> 2); p0[r] = (c <= cmax) ? __builtin_amdgcn_exp2f(p0[r] - mf) * rl : 0.f; p1[r] = (c + 32 <= cmax) ? __builtin_amdgcn_exp2f(p1[r] - mf) * rl : 0.f; }
        float G[8], L[8];
#pragma unroll
        for (int k = 0; k < 4; ++k) { G[k] = (p0[4 * k] + p0[4 * k + 1]) + (p0[4 * k + 2] + p0[4 * k + 3]); L[k] = p0[4 * k + 3]; G[4 + k] = (p1[4 * k] + p1[4 * k + 1]) + (p1[4 * k + 2] + p1[4 * k + 3]); L[4 + k] = p1[4 * k + 3]; }
#pragma unroll
        for (int k = 0; k < 8; ++k) { G[k] += qx1(G[k]); G[k] += qx2(G[k]); L[k] += qx1(L[k]); L[k] += qx2(L[k]); }
        if (hh == 0) {
#pragma unroll
            for (int k = 0; k < 8; ++k) { const int j = 16 * tau + (k < 4 ? 2 * k + hi : 8 + 2 * (k - 4) + hi); IMPW[ql * 128 + j] += G[k]; } }
        WSYNC();
        if (hh == 0) {
#pragma unroll
            for (int k = 0; k < 8; ++k) { const int j = 16 * tau + (k < 4 ? 2 * k + hi : 8 + 2 * (k - 4) + hi) + 1; if (j < NSEL) IMPW[ql * 128 + j] += L[k]; } }
        WSYNC();
        u32x4 pw0, pw1, pw2, pw3;
        pw0 = (u32x4){att::cvtpk_s(p0[0], p0[1]), att::cvtpk_s(p0[2], p0[3]), att::cvtpk_s(p0[4], p0[5]), att::cvtpk_s(p0[6], p0[7])};
        pw1 = (u32x4){att::cvtpk_s(p0[8], p0[9]), att::cvtpk_s(p0[10], p0[11]), att::cvtpk_s(p0[12], p0[13]), att::cvtpk_s(p0[14], p0[15])};
        pw2 = (u32x4){att::cvtpk_s(p1[0], p1[1]), att::cvtpk_s(p1[2], p1[3]), att::cvtpk_s(p1[4], p1[5]), att::cvtpk_s(p1[6], p1[7])};
        pw3 = (u32x4){att::cvtpk_s(p1[8], p1[9]), att::cvtpk_s(p1[10], p1[11]), att::cvtpk_s(p1[12], p1[13]), att::cvtpk_s(p1[14], p1[15])};
        __builtin_amdgcn_sched_barrier(0);
        att::pv(o, vb0 + vslot, __builtin_bit_cast(bf16x8, pw0), __builtin_bit_cast(bf16x8, pw1), __builtin_bit_cast(bf16x8, pw2), __builtin_bit_cast(bf16x8, pw3));
    }
    { const float* GN = (const float*)(ws + WS_GN); float* OF = (float*)(ws + WS_OF32);
#pragma unroll
      for (int r = 0; r < 16; ++r) { const int row = crow(r, hi), q2 = row >> 2, h2 = row & 3; const size_t t2 = (size_t)b * SEQ + qb * 64 + wid * 8 + q2;
          const float g0 = GN[t2 * 24 + (4 * g + h2) * 3];
          OF[t2 * 512 + (4 * g + h2) * 64 + r32] = o[0][r] * g0; OF[t2 * 512 + (4 * g + h2) * 64 + 32 + r32] = o[1][r] * g0; } }
    WSYNC();
    const int cur = qb; const unsigned long long lt = (lane == 0) ? 0ull : (~0ull >> (64 - lane));
    unsigned k0[8], k1[8], T[8];
#pragma unroll
    for (int q = 0; q < 8; ++q) {
        float v0 = IMPW[q * 128 + lane], v1 = IMPW[q * 128 + 64 + lane];
        { const int j0 = lane, j1 = lane + 64;
          if (j0 > cur) v0 = -1.0f; else if (j0 == 0 || j0 == cur || j0 == cur - 1) v0 = 1e6f;
          if (j1 > cur) v1 = -1.0f; else if (j1 == cur || j1 == cur - 1) v1 = 1e6f; }
        const unsigned u0 = __float_as_uint(v0), u1 = __float_as_uint(v1);
        k0[q] = (u0 & 0x80000000u) ? ~u0 : (u0 | 0x80000000u); k1[q] = (u1 & 0x80000000u) ? ~u1 : (u1 | 0x80000000u); T[q] = 0u;
    }
#pragma unroll 1
    for (int bit = 31; bit >= 0; --bit) {
#pragma unroll
        for (int q = 0; q < 8; ++q) { const unsigned cand = T[q] | (1u << bit); const int cnt = __popcll(__ballot(k0[q] >= cand)) + __popcll(__ballot(k1[q] >= cand)); T[q] = (cnt >= 16) ? cand : T[q]; }
    }
#pragma unroll
    for (int q = 0; q < 8; ++q) {
        const bool gt0 = k0[q] > T[q], gt1 = k1[q] > T[q], eq0 = k0[q] == T[q], eq1 = k1[q] == T[q];
        const int need = 16 - (__popcll(__ballot(gt0)) + __popcll(__ballot(gt1)));
        const unsigned long long be0 = __ballot(eq0), be1 = __ballot(eq1);
        const bool s0 = (gt0 || (eq0 && __popcll(be0 & lt) < need)) && (lane <= cur);
        const bool s1 = (gt1 || (eq1 && (__popcll(be0) + __popcll(be1 & lt)) < need)) && (lane + 64 <= cur);
        const unsigned long long m0 = __ballot(s0), m1 = __ballot(s1);
        if (lane == 0) { u32x4 w; w.x = (unsigned)m0; w.y = (unsigned)(m0 >> 32); w.z = (unsigned)m1; w.w = (unsigned)(m1 >> 32); *(u32x4*)(ws + WS_SEL + ((size_t)bg * SEQ + qb * 64 + wid * 8 + q) * 16) = w; }
    }
    WSYNC();
}
}
__device__ __forceinline__ void phase_cmp_attn(Frame& F, char* lds_generic) {
    const int vcu = (F.G % 8 == 0) ? (F.bid % 8) * (F.G / 8) + F.bid / 8 : F.bid;
    for (int v = vcu; v < 256; v += F.G) { const int bg = v >> 6, sidx = v & 63;
        cmpa::cmp_unit(bg, 127 - sidx, F.ws, lds_generic);
        cmpa::cmp_unit(bg, sidx, F.ws, lds_generic); }
}

__device__ __forceinline__ void phase_cmp_swa(Frame& F, char* lds_generic) {
    unsigned char* ws = F.ws;
    att::Tens Ta{(const bf16_t*)(ws + WS_QS), kv_tensor(ws, 6), kv_tensor(ws, 7), (const unsigned*)(ws + WS_SEL), (const float*)(ws + WS_GN), (bf16_t*)(ws + WS_OSWA), F.in[I_SINK]};
    const int ncmp = F.G >= 64 ? 32 : 0;
    if (F.bid < ncmp || ncmp == 0) {
        for (int u = F.bid; u < 32; u += (ncmp ? ncmp : F.G)) {
            cmp1_unit(F, u);
            VM_WAIT(); __syncthreads();
            if (F.tid == 0) { __builtin_amdgcn_fence(__ATOMIC_ACQUIRE, "agent"); VM_WAIT(); }
            __syncthreads();
            cmp2_unit(F, u);
        }
    }
    if (F.bid >= ncmp) {
        const int nw = F.G - ncmp;
        for (int v = F.bid - ncmp; v < 512; v += nw) { const int bh = v >> 5, qb = v & 31; att::attn_unit<att::M_SWA, 8>(bh >> 3, bh & 7, qb, Ta, lds_generic); }
    }
}

__device__ __forceinline__ void phase_branch(Frame& F) {
    static_assert(WS_OSWA - WS_ONSA == (size_t)NTOK * 512 * 2 && WS_WBRS - WS_WBRN == (size_t)1024 * 512 * 2, "SWA operands stacked right behind the NSA ones");
    pg8::Gemm g{(const bf16_t*)(F.ws + WS_ONSA), (const bf16_t*)(F.ws + WS_WBRN), 2 * NTOK, 2 * 1024, 512};
    pg8::BranchOrder S; S.so.init(NTOK, 1024, F.G, F.bid);
    pg8::EpiBranch E{(const bf16_t*)(F.ws + WS_GM), (bf16_t*)(F.ws + WS_MIXED)};
    pg8::gemm_phase<pg8::EpiBranch, pg8::BranchOrder, true, true>(F.lds, g, S, E);
}

__device__ __forceinline__ void phase_wout(Frame& F) {
    pg8::Gemm g{(const bf16_t*)(F.ws + WS_MIXED), (const bf16_t*)(F.ws + WS_WOUT), NTOK, 1024, 1024};
    pg8::StaticOrder S; S.init(NTOK, 1024, F.G, F.bid);
    pg8::EpiResid E{F.in[I_X], (bf16_t*)(F.ws + WS_ZB)};
    pg8::gemm_phase<pg8::EpiResid, pg8::StaticOrder, true, true>(F.lds, g, S, E);
}

constexpr int WRP_LD = 33;
__device__ __forceinline__ void phase_ln_route(Frame& F) {
    bf16_t* const HB16 = (bf16_t*)(F.ws + WS_HB16); bf16_t* const HBOUT = (bf16_t*)(F.ws + WS_HB);
    unsigned char* ws = F.ws;
    LAS float* WRP = (LAS float*)F.lds;
    LAS float* LG = (LAS float*)(F.lds + 1024 * WRP_LD * 4);
    const int lane = F.lane;
    const float* G1 = F.in[I_LN1G]; const float* B1 = F.in[I_LN1B]; const float* BR = F.in[I_BR];
    LAS float* STAT = (LAS float*)(F.lds + 143872);
    { const float* src = F.in[I_WR]; const int e = F.tid & 31, part = F.tid >> 5; float a1 = 0.f, a2 = 0.f;
#pragma unroll 8
      for (int j = 0; j < 64; ++j) { const int k = part + 16 * j; const float w = src[k * 32 + e], gw = w * G1[k]; WRP[k * WRP_LD + e] = gw; a1 += gw; a2 += w * B1[k]; }
      LG[part * 32 + e] = a1; LG[512 + part * 32 + e] = a2; }
    __syncthreads();
    if (F.tid < 64) { const int e = F.tid & 31, wh = F.tid >> 5; float sacc = 0.f;
#pragma unroll
        for (int p2 = 0; p2 < 16; ++p2) sacc += LG[wh * 512 + p2 * 32 + e];
        STAT[128 + wh * 32 + e] = sacc; }
    __syncthreads();
    gu32* ctl = (gu32*)(ws + WS_CTL);
    int* TOPE = (int*)(ws + WS_TOPE); float* TOPG = (float*)(ws + WS_TOPG); int* TOPP = (int*)(ws + WS_TOPP); int* TOK = (int*)(ws + WS_TOK);
    for (int tb = F.bid; tb < NTOK / 64; tb += F.G) {
        for (int i = 0; i < 8; ++i) {
            const int t = tb * 64 + F.wave * 8 + i;
            const bf16_t* zr = (const bf16_t*)(ws + WS_ZB) + (size_t)t * 1024;
            f32x4 v[4]; float s = 0.f;
#pragma unroll
            for (int j2 = 0; j2 < 2; ++j2) { const u32x4 w = *(const u32x4*)(zr + 8 * (lane + 64 * j2));
                v[2 * j2] = (f32x4){__uint_as_float(w.x << 16), __uint_as_float(w.x & 0xffff0000u), __uint_as_float(w.y << 16), __uint_as_float(w.y & 0xffff0000u)};
                v[2 * j2 + 1] = (f32x4){__uint_as_float(w.z << 16), __uint_as_float(w.z & 0xffff0000u), __uint_as_float(w.w << 16), __uint_as_float(w.w & 0xffff0000u)}; }
#pragma unroll
            for (int j = 0; j < 4; ++j) s += (v[j].x + v[j].y) + (v[j].z + v[j].w);
            const float mean = wave_sum(s) * (1.0f / 1024.0f); float s2 = 0.f;
#pragma unroll
            for (int j = 0; j < 4; ++j) { v[j] = v[j] - mean; s2 += (v[j].x * v[j].x + v[j].y * v[j].y) + (v[j].z * v[j].z + v[j].w * v[j].w); }
            const float rstd = 1.0f / sqrtf(wave_sum(s2) * (1.0f / 1024.0f) + LN_EPS);
            if (lane == 0) { STAT[F.wave * 8 + i] = mean; STAT[64 + F.wave * 8 + i] = rstd; }
#pragma unroll
            for (int j2 = 0; j2 < 2; ++j2) { const int c0 = 8 * (lane + 64 * j2); f32x4 h[2];
#pragma unroll
                for (int q = 0; q < 2; ++q) { const f32x4 gg = *(const f32x4*)(G1 + c0 + 4 * q), bb = *(const f32x4*)(B1 + c0 + 4 * q); h[q] = v[2 * j2 + q] * rstd * gg + bb; }
                *(u32x4*)(HB16 + (size_t)t * 1024 + c0) = pg8::pack8(h[0], h[1]);
                u32x2 w8;
                w8.x = f4_to_fp8(fminf(fmaxf(h[0].x, -448.f), 448.f), fminf(fmaxf(h[0].y, -448.f), 448.f), fminf(fmaxf(h[0].z, -448.f), 448.f), fminf(fmaxf(h[0].w, -448.f), 448.f));
                w8.y = f4_to_fp8(fminf(fmaxf(h[1].x, -448.f), 448.f), fminf(fmaxf(h[1].y, -448.f), 448.f), fminf(fmaxf(h[1].z, -448.f), 448.f), fminf(fmaxf(h[1].w, -448.f), 448.f));
                *(u32x2*)((unsigned char*)HBOUT + (size_t)t * 1024 + c0) = w8; }
        }
        __syncthreads();
        { const int tg = F.wave >> 1, eh = F.wave & 1, kk = lane >> 4, n = lane & 15;
          const bf16_t* zrow = (const bf16_t*)(ws + WS_ZB) + (size_t)(tb * 64 + tg * 16 + n) * 1024 + 4 * kk;
          const LAS float* wcol = WRP + (4 * kk) * WRP_LD + eh * 16 + n;
          f32x4 acc = (f32x4){0.f, 0.f, 0.f, 0.f};
#pragma unroll 4
          for (int s4 = 0; s4 < 64; ++s4) { const u32x2 zw = *(const u32x2*)(zrow + 16 * s4); const f32x4 a = {__uint_as_float(zw.x << 16), __uint_as_float(zw.x & 0xffff0000u), __uint_as_float(zw.y << 16), __uint_as_float(zw.y & 0xffff0000u)}; const LAS float* wp = wcol + 16 * s4 * WRP_LD;
              acc = __builtin_amdgcn_mfma_f32_16x16x4f32(a.x, wp[0], acc, 0, 0, 0);
              acc = __builtin_amdgcn_mfma_f32_16x16x4f32(a.y, wp[WRP_LD], acc, 0, 0, 0);
              acc = __builtin_amdgcn_mfma_f32_16x16x4f32(a.z, wp[2 * WRP_LD], acc, 0, 0, 0);
              acc = __builtin_amdgcn_mfma_f32_16x16x4f32(a.w, wp[3 * WRP_LD], acc, 0, 0, 0); }
          const int ee = eh * 16 + n; const float br = BR[ee] + STAT[160 + ee], c1 = STAT[128 + ee];
#pragma unroll
          for (int r = 0; r < 4; ++r) { const int tt = tg * 16 + 4 * kk + r; LG[tt * WRP_LD + ee] = STAT[64 + tt] * (acc[r] - STAT[tt] * c1) + br; } }
        __syncthreads();
        LAS int* lcnt = (LAS int*)(LG + 64 * WRP_LD); LAS int* lbase = lcnt + 32;
        if (F.tid < 32) lcnt[F.tid] = 0;
        __syncthreads();
        int be[4], lpos[4]; float gk[4];
        if (F.tid < 64) {
            float lg[32];
#pragma unroll
            for (int e = 0; e < 32; ++e) lg[e] = LG[F.tid * WRP_LD + e];
            float bv[4];
#pragma unroll
            for (int k = 0; k < 4; ++k) { float best = -__builtin_inff(); int bi = 0;
#pragma unroll
                for (int e = 0; e < 32; ++e) if (lg[e] > best) { best = lg[e]; bi = e; }
                be[k] = bi; bv[k] = best;
#pragma unroll
                for (int e = 0; e < 32; ++e) if (e == bi) lg[e] = -__builtin_inff(); }
            const float e1 = __expf(bv[1] - bv[0]), e2 = __expf(bv[2] - bv[0]), e3 = __expf(bv[3] - bv[0]); const float rs = 1.0f / (1.0f + e1 + e2 + e3);
            gk[0] = rs; gk[1] = e1 * rs; gk[2] = e2 * rs; gk[3] = e3 * rs;
#pragma unroll
            for (int k = 0; k < 4; ++k) lpos[k] = __hip_atomic_fetch_add(lcnt + be[k], 1, __ATOMIC_RELAXED, __HIP_MEMORY_SCOPE_WORKGROUP);
        }
        __syncthreads();
        if (F.tid < 32) { const int c = lcnt[F.tid]; lbase[F.tid] = (c > 0) ? (int)__hip_atomic_fetch_add(ctl + CW_CNT + 64 * F.tid, (unsigned)c, RLX_AGENT) : 0; }
        __syncthreads();
        if (F.tid < 64) { const int t = tb * 64 + F.tid;
#pragma unroll
            for (int k = 0; k < 4; ++k) { const int pos = lbase[be[k]] + lpos[k];
                TOK[be[k] * NTOK + pos] = t; TOPE[t * 4 + k] = be[k]; TOPP[t * 4 + k] = pos; TOPG[t * 4 + k] = gk[k]; } }
        __syncthreads();
    }
}

constexpr int EMAP_OFF = 131072;
__device__ __forceinline__ void load_expert_map(Frame& F, LAS int* cnt_s, LAS int* base_s) {
    if (F.tid < NEXP) cnt_s[F.tid] = (int)__hip_atomic_load((gu32*)(F.ws + WS_CTL) + CW_CNT + 64 * F.tid, RLX_AGENT);
    __syncthreads();
    if (F.tid == 0) { int acc = 0; for (int e = 0; e < NEXP; ++e) { base_s[e] = acc; acc += (cnt_s[e] + MOE_RT - 1) / MOE_RT; } base_s[NEXP] = acc; }
    __syncthreads();
    if (F.tid < base_s[NEXP]) { int e = 0;
#pragma unroll 1
        for (int k = 1; k < NEXP; ++k) if (base_s[k] <= F.tid) e = k;
        base_s[64 + F.tid] = e; }
    __syncthreads();
}
__device__ __forceinline__ void phase_expert_up(Frame& F) {
    LAS int* cnt_s = (LAS int*)(F.lds + EMAP_OFF); LAS int* base_s = cnt_s + 64;
    load_expert_map(F, cnt_s, base_s);
    const int ntiles = base_s[NEXP];
    pg8::Gemm g{(const bf16_t*)(F.ws + WS_HB), (const bf16_t*)(F.ws + WS_WEIN), ntiles * 256, NEXP * 2048, 512, (const unsigned char*)(F.ws + WS_SC1)};
    pg8::ExpertOrder<true> S{base_s, ntiles, 8, F.G, F.bid, cnt_s, (const int*)(F.ws + WS_TOK)};
    pg8::EpiSwiGLU E{F.in[I_BEIN], (unsigned char*)(F.ws + WS_ACT)};
    pg8::gemm_phase<pg8::EpiSwiGLU, pg8::ExpertOrder<true>, true, true, true, false>(F.lds, g, S, E);
}
__device__ __forceinline__ void phase_expert_down(Frame& F) {
    LAS int* cnt_s = (LAS int*)(F.lds + EMAP_OFF); LAS int* base_s = cnt_s + 64;
    load_expert_map(F, cnt_s, base_s);
    const int ntiles = base_s[NEXP];
    pg8::Gemm g{(const bf16_t*)(F.ws + WS_ACT), (const bf16_t*)(F.ws + WS_WEOUT), ntiles * 256, NEXP * 1024, 512, (const unsigned char*)(F.ws + WS_SC2)};
    pg8::ExpertOrder<false> S{base_s, ntiles, 4, F.G, F.bid, cnt_s, nullptr};
    pg8::EpiDown E{F.in[I_BEOUT], (bf16_t*)(F.ws + WS_YS)};
    pg8::gemm_phase<pg8::EpiDown, pg8::ExpertOrder<false>, true, true, true, false>(F.lds, g, S, E);
}

__device__ __forceinline__ void phase_final(Frame& F) {
    float* const OUTP = F.out;
    unsigned char* ws = F.ws;
    LAS int* cnt_s = (LAS int*)(F.lds + EMAP_OFF); LAS int* base_s = cnt_s + 64;
    load_expert_map(F, cnt_s, base_s);
    const int lane = F.lane, gw = F.bid * NWAVES + F.wave, NGW = F.G * NWAVES;
    const int* TOPE = (const int*)(ws + WS_TOPE); const float* TOPG = (const float*)(ws + WS_TOPG); const int* TOPP = (const int*)(ws + WS_TOPP);
    const bf16_t* YS = (const bf16_t*)(ws + WS_YS); const float* G2 = F.in[I_LN2G]; const float* B2 = F.in[I_LN2B];
    const unsigned char* YS8 = (const unsigned char*)YS;
    for (int t = gw; t < NTOK; t += NGW) {
        const bf16_t* hr = (const bf16_t*)(ws + WS_HB16) + (size_t)t * 1024;
        f32x4 v[4];
#pragma unroll
        for (int j = 0; j < 4; ++j) { const u32x2 hw = *(const u32x2*)(hr + 4 * (lane + 64 * j)); v[j] = (f32x4){__uint_as_float(hw.x << 16), __uint_as_float(hw.x & 0xffff0000u), __uint_as_float(hw.y << 16), __uint_as_float(hw.y & 0xffff0000u)} * DN_ALPHA; }
#pragma unroll
        for (int k = 0; k < 4; ++k) { const int e = TOPE[t * 4 + k]; const float g = TOPG[t * 4 + k] * 0.0625f; const size_t row = (size_t)base_s[e] * MOE_RT + TOPP[t * 4 + k];
#pragma unroll
            for (int j = 0; j < 4; ++j) { const int w = (int)*(const unsigned*)(YS8 + row * 1024 + 4 * (lane + 64 * j));
                v[j].x += g * __builtin_amdgcn_cvt_f32_fp8(w, 0); v[j].y += g * __builtin_amdgcn_cvt_f32_fp8(w, 1); v[j].z += g * __builtin_amdgcn_cvt_f32_fp8(w, 2); v[j].w += g * __builtin_amdgcn_cvt_f32_fp8(w, 3); } }
        float s = 0.f;
#pragma unroll
        for (int j = 0; j < 4; ++j) s += (v[j].x + v[j].y) + (v[j].z + v[j].w);
        const float mean = wave_sum(s) * (1.0f / 1024.0f); float s2 = 0.f;
#pragma unroll
        for (int j = 0; j < 4; ++j) { v[j] = v[j] - mean; s2 += (v[j].x * v[j].x + v[j].y * v[j].y) + (v[j].z * v[j].z + v[j].w * v[j].w); }
        const float rstd = 1.0f / sqrtf(wave_sum(s2) * (1.0f / 1024.0f) + LN_EPS);
#pragma unroll
        for (int j = 0; j < 4; ++j) { const int c0 = 4 * (lane + 64 * j); const f32x4 gg = *(const f32x4*)(G2 + c0), bb = *(const f32x4*)(B2 + c0); *(f32x4*)(OUTP + (size_t)t * 1024 + c0) = v[j] * rstd * gg + bb; }
    }
}

constexpr int N_PHASES = 11;
__global__ void __launch_bounds__(NTHREADS, 2) mk_fwd(Args args) {
    extern __shared__ __attribute__((aligned(16))) unsigned char lds_raw[];
    Frame F;
    F.lds = (LAS unsigned char*)lds_raw; F.ws = args.ws; F.in = args.in; F.out = args.out;
    F.tid = threadIdx.x; F.lane = F.tid & 63; F.wave = __builtin_amdgcn_readfirstlane(F.tid >> 6); F.G = gridDim.x; F.bid = blockIdx.x;
    volatile LAS unsigned* MISC = (volatile LAS unsigned*)(F.lds + MISC_OFF);
    if (F.tid < 64) MISC[F.tid] = 0u;
    __syncthreads();
    const int lo = args.ph_lo, hi = args.ph_hi;
    XcdBarrier bar; bar.bar = (unsigned*)(args.ws + WS_CTL) + CW_BAR; bar.x = 0; bar.st = nullptr;
    if (hi - lo > 1) bar = xcd_barrier_post((unsigned*)(args.ws + WS_CTL) + CW_BAR, MISC + 8);
#define IN(k) (lo <= (k) && (k) < hi)
#define SEAM(k) do { if (IN(k) && IN((k) + 1)) xcd_barrier(bar); } while (0)
    if (IN(0)) { phase_prologue<0>(F); SEAM(0); }
    if (IN(1)) { phase_inproj(F); SEAM(1); }
    if (IN(2)) { phase_cmp_swa(F, (char*)lds_raw); SEAM(2); }
    if (IN(3)) { phase_cmp_attn(F, (char*)lds_raw); SEAM(3); }
    if (IN(4)) { phase_attn_fast(F, (char*)lds_raw); SEAM(4); }
    if (IN(5)) { phase_branch(F); SEAM(5); }
    if (IN(6)) { phase_wout(F); SEAM(6); }
    if (IN(7)) { phase_ln_route(F); SEAM(7); }
    if (IN(8)) { phase_expert_up(F); SEAM(8); }
    if (IN(9)) { phase_expert_down(F); SEAM(9); }
    if (IN(10)) { phase_final(F); }
#undef IN
#undef SEAM
}

extern "C" void kernel_launch(void* const* d_in, const int* in_sizes, int n_in, void* d_out, int out_size, void* d_ws, size_t ws_size, hipStream_t stream) {
    static int grid = 0;
    if (grid == 0) {
        if (n_in != N_IN || out_size != NTOK * DM || ws_size < WS_END) { fprintf(stderr, "kernel_launch: unexpected shapes (n_in %d, out %d, ws %zu)\n", n_in, out_size, ws_size); grid = -1; return; }
        int dev = 0, cus = 0;
        if (hipGetDevice(&dev) != hipSuccess || hipDeviceGetAttribute(&cus, hipDeviceAttributeMultiprocessorCount, dev) != hipSuccess) { grid = -1; return; }
        if (hipFuncSetAttribute((const void*)mk_fwd, hipFuncAttributeMaxDynamicSharedMemorySize, LDS_BYTES) != hipSuccess) { fprintf(stderr, "kernel_launch: hipFuncSetAttribute failed\n"); grid = -1; return; }
        int per_cu = 0;
        if (hipOccupancyMaxActiveBlocksPerMultiprocessor(&per_cu, (const void*)mk_fwd, NTHREADS, LDS_BYTES) != hipSuccess || per_cu < 1) { fprintf(stderr, "kernel_launch: occupancy query says %d\n", per_cu); }
        (void)hipGetLastError();
        grid = cus;
    }
    if (grid < 0) return;
    (void)hipMemsetAsync((char*)d_ws + WS_CTL, 0, CTL_ZERO_BYTES, stream);
    Args a{};
    for (int i = 0; i < N_IN; ++i) a.in[i] = (const float*)d_in[i];
    a.out = (float*)d_out; a.ws = (unsigned char*)d_ws;
#if MK_ONE_LAUNCH
    a.ph_lo = 0; a.ph_hi = N_PHASES;
    hipLaunchKernelGGL(mk_fwd, dim3(grid), dim3(NTHREADS), LDS_BYTES, stream, a);
#else
    for (int p = 0; p < N_PHASES; ++p) { a.ph_lo = p; a.ph_hi = p + 1; hipLaunchKernelGGL(mk_fwd, dim3(grid), dim3(NTHREADS), LDS_BYTES, stream, a); }
#endif
}
```

```cpp
#include <hip/hip_runtime.h>
#include <cstdio>
#include <cstdint>

#ifndef MK_ONE_LAUNCH
#define MK_ONE_LAUNCH 1
#endif

#define LAS __attribute__((address_space(3)))
#define GAS __attribute__((address_space(1)))
typedef unsigned short bf16_t;
typedef short bf16x8 __attribute__((ext_vector_type(8)));
typedef float f32x4 __attribute__((ext_vector_type(4)));
typedef unsigned u32x4 __attribute__((ext_vector_type(4)));
typedef unsigned u32x2 __attribute__((ext_vector_type(2)));
typedef GAS unsigned gu32;
#define RLX_AGENT __ATOMIC_RELAXED, __HIP_MEMORY_SCOPE_AGENT
#define WSYNC() asm volatile("s_waitcnt lgkmcnt(0)" ::: "memory")
#define VM_WAIT() asm volatile("s_waitcnt vmcnt(0)" ::: "memory")

constexpr int NB = 2, SEQ = 8192, DM = 1024, NTOK = NB * SEQ, HD = 64;
constexpr int NVG = 2048;
constexpr int NVC = 2048;
constexpr int IN_COLS = 4120;
constexpr int NEXP = 32, DFF = 1024;
constexpr int NCMP = 511, NCMP_PAD = 512, NSEL = 128;
constexpr float C2 = 0.125f * 1.4426950408889634f;
constexpr float LOG2E = 1.4426950408889634f;
constexpr float DN_ALPHA = 1.189207115002721f;
constexpr float LN_EPS = 1e-5f;
constexpr int NWAVES = 8, NTHREADS = 512;
constexpr int MOE_RT = 256;

enum { I_X = 0, I_WIN, I_KPE, I_KW1, I_KW2, I_VPE, I_VW1, I_VW2, I_SINK, I_WBRN, I_WBRS, I_WOUT, I_LN1G, I_LN1B, I_WR, I_BR, I_WEIN, I_BEIN, I_WEOUT, I_BEOUT, I_LN2G, I_LN2B, N_IN };

constexpr size_t MiB = 1u << 20;
constexpr size_t WS_CTL = 0, CTL_ZERO_BYTES = 1 * MiB;
constexpr size_t WS_COS = 1 * MiB, WS_SIN = 2 * MiB;
constexpr size_t WS_C1P = 3 * MiB + 8192;
constexpr size_t WS_C1K = 3 * MiB, WS_C1V = 3 * MiB + 4096;
constexpr size_t WS_W1KT = 3 * MiB + 65536, WS_W1VT = WS_W1KT + 524288;
constexpr size_t WS_W2KT = WS_W1VT + 524288, WS_W2VT = WS_W2KT + 32768;
constexpr size_t WS_WBRN = 5 * MiB, WS_WBRS = 6 * MiB;
constexpr size_t WS_WOUT = 7 * MiB;
constexpr size_t WS_WIN = 9 * MiB;
constexpr size_t WS_KV = 18 * MiB, KV_BYTES = 4 * MiB;
constexpr size_t WS_CMP = 50 * MiB;
constexpr size_t WS_KCMP = WS_CMP, WS_VCMP = WS_CMP + 262144, WS_HIDK = WS_CMP + 524288, WS_HIDV = WS_CMP + 1048576;
constexpr size_t WS_QC = 52 * MiB, WS_QR = 68 * MiB, WS_QS = 84 * MiB;
constexpr size_t WS_GN = 100 * MiB;
constexpr size_t WS_SEL = 102 * MiB;
constexpr size_t WS_TOPE = 103 * MiB, WS_TOPG = WS_TOPE + 262144, WS_TOPP = WS_TOPG + 262144, WS_TOK = 104 * MiB;
constexpr size_t WS_XB = 108 * MiB;
constexpr size_t WS_ZB = 108 * MiB;
constexpr size_t WS_GM = 140 * MiB;
constexpr size_t WS_OF32 = 204 * MiB;
constexpr size_t WS_ONSA = 236 * MiB, WS_OSWA = 252 * MiB;
constexpr size_t WS_OSEL = 812 * MiB, WS_OWIN = 828 * MiB;
constexpr size_t WS_HB16 = 268 * MiB;
constexpr size_t WS_MIXED = 268 * MiB;
constexpr size_t WS_HB = 300 * MiB;
constexpr size_t WS_WEIN = 332 * MiB;
constexpr size_t WS_WEOUT = 460 * MiB;
constexpr size_t WS_ACT = 524 * MiB;
constexpr size_t WS_YS = 668 * MiB;
constexpr size_t WS_XB8 = 316 * MiB;
constexpr size_t WS_WG8 = 13 * MiB, WS_SCG = 15 * MiB;
constexpr size_t WS_SC1 = 844 * MiB, WS_SC2 = 846 * MiB;
constexpr size_t WS_END = 848 * MiB;
constexpr int CW_BAR = 4096;
constexpr int CW_CNT = 16384;

constexpr int LDS_BYTES = 147456;
constexpr int MISC_OFF = 145408;

__device__ __forceinline__ float bf2f(bf16_t v) { return __uint_as_float(((unsigned)v) << 16); }
__device__ __forceinline__ unsigned f2bf(float f) { unsigned u = __float_as_uint(f); return (u + 0x7fffu + ((u >> 16) & 1u)) >> 16; }
__device__ __forceinline__ unsigned pk2(float lo, float hi) { return f2bf(lo) | (f2bf(hi) << 16); }
__device__ __forceinline__ unsigned f4_to_fp8(float a, float b, float c, float d) { int p = __builtin_amdgcn_cvt_pk_fp8_f32(a, b, 0, false); p = __builtin_amdgcn_cvt_pk_fp8_f32(c, d, p, true); return (unsigned)p; }
__device__ __forceinline__ float frcp(float x) { return __builtin_amdgcn_rcpf(x); }
__device__ __forceinline__ float sigmoidf_(float x) { return frcp(1.0f + __expf(-x)); }
__device__ __forceinline__ float dppf(float v, int ctrl_sel) {
    const int x = __builtin_bit_cast(int, v);
    int r = ctrl_sel == 0 ? __builtin_amdgcn_mov_dpp(x, 0xB1, 0xF, 0xF, true) : ctrl_sel == 1 ? __builtin_amdgcn_mov_dpp(x, 0x4E, 0xF, 0xF, true) : ctrl_sel == 2 ? __builtin_amdgcn_mov_dpp(x, 0x141, 0xF, 0xF, true) : __builtin_amdgcn_mov_dpp(x, 0x140, 0xF, 0xF, true);
    return __builtin_bit_cast(float, r);
}
__device__ __forceinline__ float wave_sum(float v) {
    v += dppf(v, 0); v += dppf(v, 1); v += dppf(v, 2); v += dppf(v, 3);
    { auto r = __builtin_amdgcn_permlane16_swap(__float_as_uint(v), __float_as_uint(v), false, false); v = __uint_as_float(r[0]) + __uint_as_float(r[1]); }
    { auto r = __builtin_amdgcn_permlane32_swap(__float_as_uint(v), __float_as_uint(v), false, false); v = __uint_as_float(r[0]) + __uint_as_float(r[1]); }
    return v;
}
__device__ __forceinline__ float wave_max(float v) {
    v = fmaxf(v, dppf(v, 0)); v = fmaxf(v, dppf(v, 1)); v = fmaxf(v, dppf(v, 2)); v = fmaxf(v, dppf(v, 3));
    { auto r = __builtin_amdgcn_permlane16_swap(__float_as_uint(v), __float_as_uint(v), false, false); v = fmaxf(__uint_as_float(r[0]), __uint_as_float(r[1])); }
    { auto r = __builtin_amdgcn_permlane32_swap(__float_as_uint(v), __float_as_uint(v), false, false); v = fmaxf(__uint_as_float(r[0]), __uint_as_float(r[1])); }
    return v;
}
#define XB_TMO      128
#define XB_XCNT(j)  (256  + 64 * (j))
#define XB_XSUB(j)  (1280 + 64 * (j))
#define XB_XGEN(j)  (2304 + 64 * (j))
#define XB_TOP      3328
#define XB_TOPGEN   3392
#define XCD_BAR_WORDS 3456
#define XB_SPIN_CAP (1u << 22)
__device__ __forceinline__ unsigned xb_ld(unsigned* p)              { return __hip_atomic_load(p, __ATOMIC_RELAXED, __HIP_MEMORY_SCOPE_AGENT); }
__device__ __forceinline__ unsigned xb_add(unsigned* p, unsigned v) { return __hip_atomic_fetch_add(p, v, __ATOMIC_RELAXED, __HIP_MEMORY_SCOPE_AGENT); }
__device__ __forceinline__ unsigned xb_xcc_id() { return (unsigned)__builtin_amdgcn_s_getreg((3 << 11) | 20) & 0xFu; }
#define XB_SPIN(cond, bar) do { unsigned _sp = 0; while (cond) { __builtin_amdgcn_s_sleep(1); \
    if ((++_sp & 255u) == 0u) { if (xb_ld(&(bar)[XB_TMO])) break; if (_sp > XB_SPIN_CAP) { atomicAdd(&(bar)[XB_TMO], 1u); break; } } } } while (0)
struct XcdBarrier { unsigned* bar; unsigned x; volatile LAS unsigned* st; };
__device__ __forceinline__ XcdBarrier xcd_barrier_post(unsigned* bar, volatile LAS unsigned* st) {
    XcdBarrier b; b.bar = bar; b.x = xb_xcc_id(); b.st = st;
    if (threadIdx.x == 0) (void)xb_add(&bar[XB_XCNT(b.x)], 1u);
    return b;
}
__device__ __forceinline__ void xcd_barrier_complete(unsigned* bar, unsigned x, unsigned& nloc, unsigned& nx) {
    const unsigned G = gridDim.x * gridDim.y * gridDim.z;
    unsigned sum, cnt, mine, sp = 0u;
    for (;;) {
        sum = 0u; cnt = 0u; mine = 0u;
#pragma unroll
        for (unsigned j = 0; j < 16; ++j) { const unsigned c = xb_ld(&bar[XB_XCNT(j)]); sum += c; cnt += (c > 0u) ? 1u : 0u; mine = (j == x) ? c : mine; }
        if (sum == G) break;
        __builtin_amdgcn_s_sleep(1);
        if ((++sp & 255u) == 0u) { if (xb_ld(&bar[XB_TMO])) break; if (sp > XB_SPIN_CAP) { atomicAdd(&bar[XB_TMO], 1u); break; } }
    }
    nloc = mine > 0u ? mine : 1u; nx = cnt > 0u ? cnt : 1u;
}
__device__ __forceinline__ void xcd_barrier(const XcdBarrier& b) {
    asm volatile("s_waitcnt vmcnt(0)" ::: "memory");
    __syncthreads();
    if (threadIdx.x == 0) {
        unsigned* bar = b.bar;
        __builtin_amdgcn_s_waitcnt(0);
        unsigned nloc = b.st[0], nx = b.st[1];
        if (nloc == 0u) { xcd_barrier_complete(bar, b.x, nloc, nx); b.st[0] = nloc; b.st[1] = nx; }
        const unsigned old = xb_add(&bar[XB_XSUB(b.x)], 1u);
        const unsigned gen = old / nloc;
        if (old + 1u == (gen + 1u) * nloc) {
            __builtin_amdgcn_fence(__ATOMIC_RELEASE, "agent");
            asm volatile("s_waitcnt vmcnt(0)" ::: "memory");
            const unsigned og = xb_add(&bar[XB_TOP], 1u);
            const unsigned tg = og / nx;
            if (og + 1u == (tg + 1u) * nx) xb_add(&bar[XB_TOPGEN], 1u);
            else XB_SPIN(xb_ld(&bar[XB_TOPGEN]) == tg, bar);
            __builtin_amdgcn_fence(__ATOMIC_ACQUIRE, "agent");
            xb_add(&bar[XB_XGEN(b.x)], 1u);
            asm volatile("s_waitcnt vmcnt(0)" ::: "memory");
        } else {
            XB_SPIN(xb_ld(&bar[XB_XGEN(b.x)]) == gen, bar);
            __builtin_amdgcn_fence(__ATOMIC_ACQUIRE, "agent");
            asm volatile("s_waitcnt vmcnt(0)" ::: "memory");
        }
    }
    __syncthreads();
}

struct Args { const float* in[N_IN]; float* out; unsigned char* ws; int ph_lo, ph_hi; };
struct Frame {
    LAS unsigned char* lds;
    unsigned char* ws;
    const float* const* in;
    float* out;
    int tid, lane, wave, G, bid;
};

template <bool HAS_B1>
__device__ __forceinline__ void gemm_kloop(LAS unsigned char* lds, const bf16_t* a, const bf16_t* b0, const bf16_t* b1, int K, f32x4 (&acc)[4][2][2], int wid, int lane) {
    const int wr = wid >> 2, wc = wid & 3, fr = lane & 15, fq = lane >> 4;
    const unsigned ldsw = (unsigned)wid * 1024u;
    constexpr int SB = 24576;
    const int nsteps = K / 32;
#define KL_STAGE(s) do { LAS unsigned char* d_ = lds + ((s) & 3) * SB + ldsw; \
        __builtin_amdgcn_global_load_lds((const unsigned*)(a + (s) * 32), (LAS unsigned*)(d_), 16, 0, 0); \
        __builtin_amdgcn_global_load_lds((const unsigned*)(b0 + (s) * 32), (LAS unsigned*)(d_ + 8192), 16, 0, 0); \
        if (HAS_B1) __builtin_amdgcn_global_load_lds((const unsigned*)(b1 + (s) * 32), (LAS unsigned*)(d_ + 16384), 16, 0, 0); } while (0)
    for (int s = 0; s < 3 && s < nsteps; ++s) KL_STAGE(s);
    for (int k = 0; k < nsteps; ++k) {
        const int rem = nsteps - 1 - k;
        if (rem >= 2) { if (HAS_B1) asm volatile("s_waitcnt vmcnt(6)" ::: "memory"); else asm volatile("s_waitcnt vmcnt(4)" ::: "memory"); }
        else if (rem == 1) { if (HAS_B1) asm volatile("s_waitcnt vmcnt(3)" ::: "memory"); else asm volatile("s_waitcnt vmcnt(2)" ::: "memory"); }
        else asm volatile("s_waitcnt vmcnt(0)" ::: "memory");
        asm volatile("s_waitcnt lgkmcnt(0)" ::: "memory"); __builtin_amdgcn_s_barrier(); asm volatile("" ::: "memory");
        if (k + 3 < nsteps) KL_STAGE(k + 3);
        const LAS unsigned char* bufp = lds + (k & 3) * SB;
        bf16x8 af[4], bfr[2][2];
#pragma unroll
        for (int m = 0; m < 4; ++m) af[m] = *(const LAS bf16x8*)(bufp + (wr * 64 + m * 16 + fr) * 64 + fq * 16);
#pragma unroll
        for (int bj = 0; bj < (HAS_B1 ? 2 : 1); ++bj)
#pragma unroll
            for (int n = 0; n < 2; ++n) bfr[bj][n] = *(const LAS bf16x8*)(bufp + 8192 + bj * 8192 + (wc * 32 + n * 16 + fr) * 64 + fq * 16);
#pragma unroll
        for (int m = 0; m < 4; ++m)
#pragma unroll
            for (int bj = 0; bj < (HAS_B1 ? 2 : 1); ++bj)
#pragma unroll
                for (int n = 0; n < 2; ++n) acc[m][bj][n] = __builtin_amdgcn_mfma_f32_16x16x32_bf16(bfr[bj][n], af[m], acc[m][bj][n], 0, 0, 0);
    }
    asm volatile("s_waitcnt vmcnt(0) lgkmcnt(0)" ::: "memory"); __builtin_amdgcn_s_barrier(); asm volatile("" ::: "memory");
#undef KL_STAGE
}
__device__ __forceinline__ void acc_zero(f32x4 (&acc)[4][2][2]) {
#pragma unroll
    for (int m = 0; m < 4; ++m)
#pragma unroll
        for (int bj = 0; bj < 2; ++bj)
#pragma unroll
            for (int n = 0; n < 2; ++n) acc[m][bj][n] = (f32x4){0.f, 0.f, 0.f, 0.f};
}

__device__ __forceinline__ int win_src_col(int v, int& nvalid) {
    const int pn = v >> 8, bj = (v >> 7) & 1, hd = (v >> 5) & 3;
    nvalid = 32;
    if (pn < 2) return (4 * pn + hd) * 64 + 32 * bj;
    if (pn == 2) return (hd < 2 ? 512 + hd * 64 : 640 + (hd - 2) * 64) + 32 * bj;
    if (pn == 3) return (hd < 2 ? 768 + hd * 64 : 896 + (hd - 2) * 64) + 32 * bj;
    if (pn == 4) return (hd < 2 ? 1024 + hd * 64 : 1152 + (hd - 2) * 64) + 32 * bj;
    if (pn < 7) return 1304 + (4 * (pn - 5) + hd) * 64 + 32 * bj;
    if (pn == 7) return (hd < 2 ? 1816 + hd * 64 : 1944 + (hd - 2) * 64) + 32 * bj;
    return 2072 + (v - 2048);
}
struct TrItem { const float* W; bf16_t* WT; int ldw, srccol0, nvalid, K, k0; };
__device__ __forceinline__ void tr_load(const TrItem& it, float (&r)[32], int lane) {
    const int n = lane & 31; const float* p = it.W + (size_t)(it.k0 + (lane >> 5)) * it.ldw + it.srccol0 + n; const bool ok = n < it.nvalid;
#pragma unroll
    for (int i = 0; i < 32; ++i) r[i] = ok ? p[(size_t)(2 * i) * it.ldw] : 0.f;
}
__device__ __forceinline__ void tr_finish(const TrItem& it, const float (&r)[32], LAS float* scr, int lane) {
#pragma unroll
    for (int i = 0; i < 32; ++i) scr[(2 * i + (lane >> 5)) * 33 + (lane & 31)] = r[i];
    WSYNC();
    const int c = lane & 7;
#pragma unroll
    for (int j = 0; j < 4; ++j) { const int n = (lane >> 3) + 8 * j; const LAS float* s = scr + (8 * c) * 33 + n;
        u32x4 o; o.x = pk2(s[0 * 33], s[1 * 33]); o.y = pk2(s[2 * 33], s[3 * 33]); o.z = pk2(s[4 * 33], s[5 * 33]); o.w = pk2(s[6 * 33], s[7 * 33]);
        *(u32x4*)(it.WT + (size_t)n * it.K + it.k0 + 8 * c) = o; }
    WSYNC();
}
__device__ __forceinline__ void tr_item64(const float* W, int ldw, int sc0, int K, bf16_t* WT, int k0, LAS float* scr, int lane, int sc1 = -1, int nv0 = 32, int nv1 = 32) {
    const int kr = lane >> 4, nq = lane & 15;
    f32x4 r[16];
    { const int sc = (sc1 < 0) ? sc0 + 4 * nq : ((nq < 8 ? sc0 : sc1) + 4 * (nq & 7)); const bool ok = 4 * (nq & 7) + 3 < (nq < 8 ? nv0 : nv1);
      const float* p = W + (size_t)(k0 + kr) * ldw + sc;
#pragma unroll
      for (int i = 0; i < 16; ++i) r[i] = ok ? *(const f32x4*)(p + (size_t)(4 * i) * ldw) : (f32x4){0.f, 0.f, 0.f, 0.f}; }
#pragma unroll
    for (int i = 0; i < 16; ++i) { LAS float* d = scr + (4 * i + kr) * 65 + 4 * nq; d[0] = r[i].x; d[1] = r[i].y; d[2] = r[i].z; d[3] = r[i].w; }
    WSYNC();
    const int c = lane & 7;
#pragma unroll
    for (int j = 0; j < 8; ++j) { const int n = (lane >> 3) + 8 * j; const LAS float* s = scr + (8 * c) * 65 + n;
        u32x4 o; o.x = pk2(s[0 * 65], s[1 * 65]); o.y = pk2(s[2 * 65], s[3 * 65]); o.z = pk2(s[4 * 65], s[5 * 65]); o.w = pk2(s[6 * 65], s[7 * 65]);
        *(u32x4*)(WT + (size_t)n * K + k0 + 8 * c) = o; }
    WSYNC();
}
__device__ __forceinline__ void tr_item8(const float* W, int ldw, int sc_lo, int sc_hi, int k0, unsigned char* W8, unsigned char* SB, LAS float* scr, int lane) {
    const int kr = lane >> 3, nq = lane & 7;
    f32x4 r[16]; float amax = 0.f;
    { const float* p = W + (size_t)(k0 + kr) * ldw + (nq < 4 ? sc_lo + 4 * nq : sc_hi + 4 * (nq - 4));
#pragma unroll
      for (int i = 0; i < 16; ++i) r[i] = *(const f32x4*)(p + (size_t)(8 * i) * ldw); }
#pragma unroll
    for (int i = 0; i < 16; ++i) { LAS float* d = scr + (8 * i + kr) * 33 + 4 * nq; d[0] = r[i].x; d[1] = r[i].y; d[2] = r[i].z; d[3] = r[i].w;
        amax = fmaxf(amax, fmaxf(fmaxf(fabsf(r[i].x), fabsf(r[i].y)), fmaxf(fabsf(r[i].z), fabsf(r[i].w)))); }
    amax = wave_max(amax);
    int e = (int)((__float_as_uint(amax) >> 23) & 0xffu) - 127 - 8; e = e < -127 ? -127 : e;
    const float inv = __uint_as_float((unsigned)(127 - e) << 23);
    WSYNC();
    const int c = lane & 7;
#pragma unroll
    for (int j = 0; j < 4; ++j) { const int n = (lane >> 3) + 8 * j; const LAS float* s = scr + (16 * c) * 33 + n; float v[16];
#pragma unroll
        for (int q = 0; q < 16; ++q) v[q] = fminf(fmaxf(s[q * 33] * inv, -448.0f), 448.0f);
        u32x4 o; o.x = f4_to_fp8(v[0], v[1], v[2], v[3]); o.y = f4_to_fp8(v[4], v[5], v[6], v[7]); o.z = f4_to_fp8(v[8], v[9], v[10], v[11]); o.w = f4_to_fp8(v[12], v[13], v[14], v[15]);
        *(u32x4*)(W8 + (size_t)n * 1024 + k0 + 16 * c) = o; }
    if (lane == 0) SB[k0 >> 7] = (unsigned char)(e + 127);
    WSYNC();
}
template <int PART>
__device__ __forceinline__ void phase_prologue(Frame& F) {
    const int gw = F.bid * NWAVES + F.wave, NGW = F.G * NWAVES;
    const int gt = F.bid * NTHREADS + F.tid, NGT = F.G * NTHREADS;
    LAS float* scr = (LAS float*)(F.lds + F.wave * 17408);
    unsigned char* ws = F.ws;
    if (PART == 0) {
        constexpr int WGS = 1024 + 16;
        LAS bf16_t* wg = (LAS bf16_t*)F.lds;
        for (int r = F.tid; r < 1024; r += NTHREADS) { const float* p = F.in[I_WIN] + (size_t)r * IN_COLS + 1280;
#pragma unroll
            for (int j = 0; j < 6; ++j) { const f32x4 v = *(const f32x4*)(p + 4 * j); wg[(4 * j) * WGS + r] = (bf16_t)f2bf(v.x); wg[(4 * j + 1) * WGS + r] = (bf16_t)f2bf(v.y); wg[(4 * j + 2) * WGS + r] = (bf16_t)f2bf(v.z); wg[(4 * j + 3) * WGS + r] = (bf16_t)f2bf(v.w); }
#pragma unroll
            for (int j = 24; j < 32; ++j) wg[j * WGS + r] = 0; }
        __syncthreads();
        const int fr = F.lane & 15, fq = F.lane >> 4, kh = F.wave >> 2, wq = F.wave & 3;
        LAS float* part = (LAS float*)(F.lds + 69632) + (wq * 64 + F.lane) * 8;
        for (int base = 0; base < NTOK / 16; base += 4 * F.G) {
            const int grp = base + wq * F.G + F.bid; const bool act = grp < NTOK / 16;
            f32x4 a0 = {0.f, 0.f, 0.f, 0.f}, a1 = {0.f, 0.f, 0.f, 0.f};
            if (act) {
                const size_t o = (size_t)(grp * 16 + fr) * 1024 + 8 * fq + 512 * kh;
                const float* xr = F.in[I_X] + o; bf16_t* xb = (bf16_t*)(ws + WS_XB) + o; unsigned char* xb8 = ws + WS_XB8 + o;
                const LAS bf16_t* w0 = wg + fr * WGS + 8 * fq + 512 * kh; const LAS bf16_t* w1 = wg + (16 + fr) * WGS + 8 * fq + 512 * kh;
#pragma unroll 8
                for (int st = 0; st < 16; ++st) { const f32x4 v0 = *(const f32x4*)(xr + st * 32), v1 = *(const f32x4*)(xr + st * 32 + 4);
                    u32x4 w; w.x = pk2(v0.x, v0.y); w.y = pk2(v0.z, v0.w); w.z = pk2(v1.x, v1.y); w.w = pk2(v1.z, v1.w); *(u32x4*)(xb + st * 32) = w;
                    { const f32x4 lo4 = {-448.f, -448.f, -448.f, -448.f}, hi4 = {448.f, 448.f, 448.f, 448.f}; const f32x4 c0 = __builtin_elementwise_min(__builtin_elementwise_max(v0 * 16.0f, lo4), hi4), c1 = __builtin_elementwise_min(__builtin_elementwise_max(v1 * 16.0f, lo4), hi4);
                      u32x2 w8; w8.x = f4_to_fp8(c0.x, c0.y, c0.z, c0.w); w8.y = f4_to_fp8(c1.x, c1.y, c1.z, c1.w); *(u32x2*)(xb8 + st * 32) = w8; }
                    const bf16x8 xa = __builtin_bit_cast(bf16x8, w);
                    a0 = __builtin_amdgcn_mfma_f32_16x16x32_bf16(*(const LAS bf16x8*)(w0 + st * 32), xa, a0, 0, 0, 0);
                    a1 = __builtin_amdgcn_mfma_f32_16x16x32_bf16(*(const LAS bf16x8*)(w1 + st * 32), xa, a1, 0, 0, 0); }
            }
            if (kh == 1) { *(LAS f32x4*)part = a0; *(LAS f32x4*)(part + 4) = a1; }
            __syncthreads();
            if (kh == 0 && act) { a0 += *(const LAS f32x4*)part; a1 += *(const LAS f32x4*)(part + 4);
                float* gn = (float*)(ws + WS_GN) + (size_t)(grp * 16 + fr) * 24 + 4 * fq;
                f32x4 s0, s1;
#pragma unroll
                for (int i = 0; i < 4; ++i) { s0[i] = sigmoidf_(a0[i]); s1[i] = sigmoidf_(a1[i]); }
                *(f32x4*)gn = s0; if (fq < 2) *(f32x4*)(gn + 16) = s1; }
            __syncthreads();
        }
    }
    if (PART == 0) { float* cs = (float*)(ws + WS_COS); float* sn = (float*)(ws + WS_SIN);
      for (int i = gt; i < SEQ * 32; i += NGT) { const int pos = i >> 5, j = i & 31;
          const float inv = powf(10000.0f, -(float)j / 32.0f); const float ang = (float)pos * inv;
          double t = (double)ang * 0.15915494309189535; t -= floor(t); const float tf = (float)t;
          cs[i] = __builtin_amdgcn_cosf(tf); sn[i] = __builtin_amdgcn_sinf(tf); } }
    if (PART == 0) { for (int o = F.wave * F.G + F.bid; o < 64; o += NWAVES * F.G) { const int which = o >> 5, ch = o & 31; const float* pe = F.in[which ? I_VPE : I_KPE] + ch * 64; const float* w1 = F.in[which ? I_VW1 : I_KW1] + (size_t)ch * 64 * 128;
          float s0 = 0.f, s1 = 0.f;
#pragma unroll 16
          for (int i = 0; i < 64; ++i) { const float p = pe[i]; s0 += p * w1[(size_t)i * 128 + F.lane]; s1 += p * w1[(size_t)i * 128 + 64 + F.lane]; }
          float* dst = (float*)(ws + WS_C1P) + (size_t)o * 128; dst[F.lane] = s0; dst[64 + F.lane] = s1; } }
    constexpr int IT_WIN = 16 * (NVC / 32), IT_BR = 8 * 32, IT_WOUT = 16 * 32, IT_W1 = 32 * 4, IT_W2 = 2 * 2, IT_EIN = 16 * 64, IT_EOUT = 16 * 32;
    constexpr int O_WIN = 0, O_BRN = O_WIN + IT_WIN, O_BRS = O_BRN + IT_BR, O_WOUT = O_BRS + IT_BR, O_W1K = O_WOUT + IT_WOUT, O_W1V = O_W1K + IT_W1, O_W2K = O_W1V + IT_W1, O_W2V = O_W2K + IT_W2,
                  O_EIN = O_W2V + IT_W2, O_EOUT = O_EIN + NEXP * IT_EIN, O_END = O_EOUT + NEXP * IT_EOUT;
    auto decode = [&](int it, TrItem& T) {
        if (it < O_BRN) { const int r = it - O_WIN, nblk = NVC / 32, kb = r / nblk, nb = r % nblk; int nv; const int sc = win_src_col(nb * 32, nv);
            T = TrItem{F.in[I_WIN], (bf16_t*)(ws + WS_WIN) + (size_t)nb * 32 * 1024, IN_COLS, sc, nv, 1024, kb * 64}; }
        else if (it < O_WOUT) { const bool s = it >= O_BRS; const int r = it - (s ? O_BRS : O_BRN), kb = r / 32, nb = r % 32;
            T = TrItem{F.in[s ? I_WBRS : I_WBRN], (bf16_t*)(ws + (s ? WS_WBRS : WS_WBRN)) + (size_t)nb * 32 * 512, 1024, nb * 32, 32, 512, kb * 64}; }
        else if (it < O_W1K) { const int r = it - O_WOUT, kb = r / 32, nb = r % 32;
            T = TrItem{F.in[I_WOUT], (bf16_t*)(ws + WS_WOUT) + (size_t)nb * 32 * 1024, 1024, nb * 32, 32, 1024, kb * 64}; }
        else if (it < O_W2K) { const bool s = it >= O_W1V; const int r = it - (s ? O_W1V : O_W1K), kb = r / 4, nb = r % 4;
            T = TrItem{F.in[s ? I_VW1 : I_KW1], (bf16_t*)(ws + (s ? WS_W1VT : WS_W1KT)) + (size_t)nb * 32 * 2048, 128, nb * 32, 32, 2048, kb * 64}; }
        else if (it < O_EIN) { const bool s = it >= O_W2V; const int r = it - (s ? O_W2V : O_W2K), kb = r / 2, nb = r % 2;
            T = TrItem{F.in[s ? I_VW2 : I_KW2], (bf16_t*)(ws + (s ? WS_W2VT : WS_W2KT)) + (size_t)nb * 32 * 128, 64, nb * 32, 32, 128, kb * 64}; }
        else if (it < O_EOUT) { const int r0 = it - O_EIN, e = r0 / IT_EIN, r = r0 % IT_EIN, kb = r / 64, nb = r % 64;
            const int sc = ((nb >> 2) & 1) * 1024 + (nb >> 3) * 128 + (nb & 3) * 32;
            T = TrItem{F.in[I_WEIN] + (size_t)e * 1024 * 2048, (bf16_t*)(ws + WS_WEIN) + ((size_t)e * 2048 + nb * 32) * 1024, 2048, sc, 32, 1024, kb * 64}; }
        else { const int r0 = it - O_EOUT, e = r0 / IT_EOUT, r = r0 % IT_EOUT, kb = r / 32, nb = r % 32;
            T = TrItem{F.in[I_WEOUT] + (size_t)e * 1024 * 1024, (bf16_t*)(ws + WS_WEOUT) + ((size_t)e * 1024 + nb * 32) * 1024, 1024, nb * 32, 32, 1024, kb * 64}; }
    };
    LAS float* scr2 = scr + 64 * 33;
    if (PART == 1) {
        for (int it = gw; it < NEXP * 512; it += NGW) { const int e = it >> 9, r = it & 511, kb = r >> 6, nb = r & 63; const size_t row0 = (size_t)e * 2048 + nb * 32;
            const int sc = ((nb >> 2) & 1) * 1024 + (nb >> 3) * 128 + (nb & 3) * 32;
            tr_item8(F.in[I_WEIN] + (size_t)e * 1024 * 2048, 2048, sc, sc + 16, kb * 128, (unsigned char*)(ws + WS_WEIN) + row0 * 1024, (unsigned char*)(ws + WS_SC1) + (row0 >> 5) * 8, scr, F.lane); }
        return;
    }
    if (PART == 2) {
        for (int it = gw; it < NEXP * 256; it += NGW) { const int e = it >> 8, r = it & 255, kb = r >> 5, nb = r & 31; const size_t row0 = (size_t)e * 1024 + nb * 32;
            tr_item8(F.in[I_WEOUT] + (size_t)e * 1024 * 1024, 1024, nb * 32, nb * 32 + 16, kb * 128, (unsigned char*)(ws + WS_WEOUT) + row0 * 1024, (unsigned char*)(ws + WS_SC2) + (row0 >> 5) * 8, scr, F.lane); }
        return;
    }
    for (int it = gw; it < 8 * 64; it += NGW) { const int kb = it >> 6, nb = it & 63;
        tr_item8(F.in[I_WIN], IN_COLS, 2072 + 32 * nb, 2072 + 32 * nb + 16, kb * 128, (unsigned char*)(ws + WS_WG8) + (size_t)nb * 32 * 1024, (unsigned char*)(ws + WS_SCG) + nb * 8, scr, F.lane); }
    for (int it = gw; it < 16 * (NVC / 64); it += NGW) { const int kb = it / (NVC / 64), nb = it % (NVC / 64); int nv0, nv1; const int s0 = win_src_col(nb * 64, nv0), s1 = win_src_col(nb * 64 + 32, nv1);
        tr_item64(F.in[I_WIN], IN_COLS, s0, 1024, (bf16_t*)(ws + WS_WIN) + (size_t)nb * 64 * 1024, kb * 64, scr, F.lane, s1, nv0, nv1); }
    for (int it = O_BRN + gw; it < O_EIN; it += 2 * NGW) {
        TrItem Ta, Tb; float ra[32], rb[32]; const bool two = it + NGW < O_EIN;
        decode(it, Ta); tr_load(Ta, ra, F.lane);
        if (two) { decode(it + NGW, Tb); tr_load(Tb, rb, F.lane); }
        tr_finish(Ta, ra, scr, F.lane);
        if (two) tr_finish(Tb, rb, scr2, F.lane);
    }
}

__device__ __forceinline__ bf16_t* kv_tensor(unsigned char* ws, int idx) { return (bf16_t*)(ws + WS_KV + (size_t)idx * KV_BYTES); }
namespace pg8 {
#define PG8_LAS __attribute__((address_space(3)))
typedef unsigned short bf16_t;
typedef short bf16x8 __attribute__((ext_vector_type(8)));
typedef float f32x4 __attribute__((ext_vector_type(4)));
typedef unsigned u32x4 __attribute__((ext_vector_type(4)));
typedef int i32x4 __attribute__((ext_vector_type(4)));
typedef int i32x8 __attribute__((ext_vector_type(8)));
constexpr int BM = 256, BK = 64, HALF = 128, HTB = HALF * BK * 2  , STAGE_BYTES = 8 * HTB, NXCD = 8, WGM = 8;

__host__ __device__ __forceinline__ int lds_byte(int r, int c) { const int st = (r >> 4) * 2 + (c >> 5), rr = r & 15, cc = c & 31, ob = rr * 64 + cc * 2; return st * 1024 + (ob ^ (((ob >> 9) & 1) << 5)); }
__host__ __device__ __forceinline__ void stage_rc(int b, int& R, int& C) { const int st = b / 1024, sb = b % 1024, swz = sb ^ (((sb >> 9) & 1) << 5); R = (st >> 1) * 16 + swz / 64; C = (st & 1) * 32 + (swz % 64) / 2; }
__host__ __device__ __forceinline__ int perm32(int rho) { const int n = rho >> 4, i = rho & 15; return 8 * (i >> 2) + 4 * n + (i & 3); }

struct Unit { int pm, pn; };
struct Gemm { const bf16_t* A; const bf16_t* Bt; int M, N, K; const unsigned char* Bs = nullptr; unsigned ascale = 0x7f7f7f7fu; };

struct StaticOrder {
    static constexpr bool GATHER = false;
    int nM, nN, nwg, G, c;
    __host__ __device__ void init(int M, int N, int G_, int c_) { nM = M / BM; nN = N / BM; nwg = nM * nN; G = G_; c = c_; }
    __host__ __device__ bool next(int i, Unit& u) const {
        const long L = (long)i * G + c; if (L >= nwg) return false;
        int wgid = (int)L; { const int q = nwg / NXCD, r = nwg % NXCD, xcd = wgid % NXCD, off = wgid / NXCD; wgid = (xcd < r ? xcd * (q + 1) : r * (q + 1) + (xcd - r) * q) + off; }
        const int nig = WGM * nN, gid = wgid / nig, fm = gid * WGM, gsz = (nM - fm) < WGM ? (nM - fm) : WGM;
        u.pm = fm + ((wgid % nig) % gsz); u.pn = (wgid % nig) / gsz; return true;
    }
    __device__ __forceinline__ void a_ready(const Unit&) const {}
    __device__ __forceinline__ void done(const Unit&) const {}
};

__device__ __forceinline__ unsigned cvt_pk_bf16(float lo, float hi) { typedef float f2_ __attribute__((ext_vector_type(2))); typedef __bf16 b2_ __attribute__((ext_vector_type(2))); const f2_ v = {lo, hi}; return __builtin_bit_cast(unsigned, __builtin_convertvector(v, b2_)); }
__device__ __forceinline__ unsigned pk2e(float lo, float hi) { return cvt_pk_bf16(lo, hi); }
__device__ __forceinline__ u32x4 pack8(const f32x4 a, const f32x4 b) { u32x4 w; w.x = pk2e(a[0], a[1]); w.y = pk2e(a[2], a[3]); w.z = pk2e(b[0], b[1]); w.w = pk2e(b[2], b[3]); return w; }
__device__ __forceinline__ f32x4 sig4(const f32x4 v) { f32x4 r; r[0] = frcp(1.0f + __expf(-v[0])); r[1] = frcp(1.0f + __expf(-v[1])); r[2] = frcp(1.0f + __expf(-v[2])); r[3] = frcp(1.0f + __expf(-v[3])); return r; }
struct EpiInProj {
    static constexpr bool CHAIN = false;
    static constexpr bool PERM = true, AFTER_DRAIN = false;
    unsigned char* ws;
    __device__ __forceinline__ void operator()(const f32x4 (&acc)[2][2][4][2], const Unit& u, int wr, int wc, int fr, int fq) const {
        const int pn = u.pn; const float* COS = (const float*)(ws + WS_COS); const float* SIN = (const float*)(ws + WS_SIN);
#pragma unroll
        for (int ai = 0; ai < 2; ++ai)
#pragma unroll
            for (int m = 0; m < 4; ++m) {
                const int row = u.pm * BM + ai * HALF + wr * 64 + m * 16 + fr;
                if (pn < 8) {
                    const int pos = row & (SEQ - 1), bb = row >> 13, dlo = 8 * fq;
                    const f32x4 a0 = acc[ai][0][m][0], a1 = acc[ai][0][m][1], b0 = acc[ai][1][m][0], b1 = acc[ai][1][m][1];
                    const bool isq = (pn < 2) || pn == 5 || pn == 6;
                    const int pair = (pn == 2) ? 0 : (pn == 3) ? 1 : (pn == 4) ? 2 : 3; const bool isv = wc >= 2;
                    const bool rope = isq || (!isv && pair != 0);
                    f32x4 ra0 = a0, ra1 = a1, rb0 = b0, rb1 = b1;
                    if (rope) { const f32x4 c0 = *(const f32x4*)(COS + pos * 32 + dlo), c1 = *(const f32x4*)(COS + pos * 32 + dlo + 4), s0 = *(const f32x4*)(SIN + pos * 32 + dlo), s1 = *(const f32x4*)(SIN + pos * 32 + dlo + 4);
                        ra0 = a0 * c0 - b0 * s0; ra1 = a1 * c1 - b1 * s1; rb0 = b0 * c0 + a0 * s0; rb1 = b1 * c1 + a1 * s1; }
                    if (isq) {
                        const int head = (pn < 2 ? 4 * pn : 4 * (pn - 5)) + wc;
                        bf16_t* qr = (bf16_t*)(ws + (pn < 2 ? WS_QR : WS_QS)) + (size_t)row * 512 + head * 64 + dlo;
                        *(u32x4*)qr = pack8(ra0 * C2, ra1 * C2); *(u32x4*)(qr + 32) = pack8(rb0 * C2, rb1 * C2);
                        if (pn < 2) { bf16_t* qc = (bf16_t*)(ws + WS_QC) + (size_t)row * 512 + head * 64 + dlo; *(u32x4*)qc = pack8(a0 * C2, a1 * C2); *(u32x4*)(qc + 32) = pack8(b0 * C2, b1 * C2); }
                    } else {
                        bf16_t* dst = kv_tensor(ws, pair * 2 + (isv ? 1 : 0)) + ((size_t)(bb * 2 + (wc & 1)) * SEQ + pos) * 64 + dlo;
                        *(u32x4*)dst = pack8(ra0, ra1); *(u32x4*)(dst + 32) = pack8(rb0, rb1);
                    }
                }
            }
    }
};
struct EpiGate {
    static constexpr bool CHAIN = false;
    static constexpr bool PERM = true, AFTER_DRAIN = false;
    unsigned char* ws;
    static __device__ __forceinline__ unsigned q8(float g) { const float q = fminf(fmaxf(g * 255.0f + 0.5f, 1.0f), 255.0f); return (unsigned)q; }
    __device__ __forceinline__ void operator()(const f32x4 (&acc)[2][2][4][2], const Unit& u, int wr, int wc, int fr, int fq) const {
#pragma unroll
        for (int ai = 0; ai < 2; ++ai)
#pragma unroll
            for (int m = 0; m < 4; ++m) { const int row = u.pm * BM + ai * HALF + wr * 64 + m * 16 + fr;
                unsigned char* gm = ws + WS_GM + (size_t)row * 2048 + u.pn * 256 + wc * 32 + 8 * fq;
#pragma unroll
                for (int bj = 0; bj < 2; ++bj) { const f32x4 s0 = sig4(acc[ai][bj][m][0]), s1 = sig4(acc[ai][bj][m][1]); u32x2 w;
                    w.x = q8(s0[0]) | (q8(s0[1]) << 8) | (q8(s0[2]) << 16) | (q8(s0[3]) << 24); w.y = q8(s1[0]) | (q8(s1[1]) << 8) | (q8(s1[2]) << 16) | (q8(s1[3]) << 24);
                    *(u32x2*)(gm + bj * HALF) = w; } }
    }
};
struct EpiResid {
    static constexpr bool CHAIN = false;
    static constexpr bool PERM = true, AFTER_DRAIN = false;
    const float* X; bf16_t* Z;
    __device__ __forceinline__ void operator()(const f32x4 (&acc)[2][2][4][2], const Unit& u, int wr, int wc, int fr, int fq) const {
#pragma unroll
        for (int ai = 0; ai < 2; ++ai)
#pragma unroll
            for (int m = 0; m < 4; ++m) { const size_t off = (size_t)(u.pm * BM + ai * HALF + wr * 64 + m * 16 + fr) * 1024 + u.pn * BM + wc * 32 + 8 * fq;
#pragma unroll
                for (int bj = 0; bj < 2; ++bj) { const size_t o = off + bj * HALF;
                    *(u32x4*)(Z + o) = pack8(*(const f32x4*)(X + o) * DN_ALPHA + acc[ai][bj][m][0], *(const f32x4*)(X + o + 4) * DN_ALPHA + acc[ai][bj][m][1]); } }
    }
};
struct EpiSwiGLU {
    static constexpr bool CHAIN = false;
    static constexpr bool PERM = true, AFTER_DRAIN = false;
    const float* bin; unsigned char* ACT;
    __device__ __forceinline__ void operator()(const f32x4 (&acc)[2][2][4][2], const Unit& u, int wr, int wc, int fr, int fq) const {
        const int e = u.pn >> 3, col0 = (u.pn & 7) * 128 + wc * 32 + 8 * fq; const float* be = bin + (size_t)e * 2048 + col0;
        const f32x4 bg0 = *(const f32x4*)be, bg1 = *(const f32x4*)(be + 4), bu0 = *(const f32x4*)(be + 1024), bu1 = *(const f32x4*)(be + 1028);
#pragma unroll
        for (int ai = 0; ai < 2; ++ai)
#pragma unroll
            for (int m = 0; m < 4; ++m) { const size_t row = (size_t)u.pm * BM + ai * HALF + wr * 64 + m * 16 + fr;
                f32x4 o[2];
#pragma unroll
                for (int n = 0; n < 2; ++n) { const f32x4 hg = acc[ai][0][m][n] + (n ? bg1 : bg0), hu = acc[ai][1][m][n] + (n ? bu1 : bu0);
#pragma unroll
                    for (int i = 0; i < 4; ++i) { const float g = fminf(hg[i], 7.0f), uu = fminf(fmaxf(hu[i], -7.0f), 7.0f); o[n][i] = g * frcp(1.0f + __expf(-1.702f * g)) * (uu + 1.0f); } }
                u32x2 w8; w8.x = f4_to_fp8(o[0][0], o[0][1], o[0][2], o[0][3]); w8.y = f4_to_fp8(o[1][0], o[1][1], o[1][2], o[1][3]); *(u32x2*)(ACT + row * 1024 + col0) = w8; }
    }
};
struct EpiDown {
    static constexpr bool CHAIN = false;
    static constexpr bool PERM = true, AFTER_DRAIN = false;
    const float* bout; bf16_t* YS;
    __device__ __forceinline__ void operator()(const f32x4 (&acc)[2][2][4][2], const Unit& u, int wr, int wc, int fr, int fq) const {
        const int e = u.pn >> 2, col0 = (u.pn & 3) * 256 + wc * 32 + 8 * fq; const float* be = bout + (size_t)e * 1024 + col0;
#pragma unroll
        for (int bj = 0; bj < 2; ++bj) { const f32x4 b0 = *(const f32x4*)(be + bj * HALF), b1 = *(const f32x4*)(be + bj * HALF + 4);
#pragma unroll
            for (int ai = 0; ai < 2; ++ai)
#pragma unroll
                for (int m = 0; m < 4; ++m) { const size_t row = (size_t)u.pm * BM + ai * HALF + wr * 64 + m * 16 + fr;
                    const f32x4 lo4 = {-448.f, -448.f, -448.f, -448.f}, hi4 = {448.f, 448.f, 448.f, 448.f};
                    const f32x4 c0 = __builtin_elementwise_min(__builtin_elementwise_max((acc[ai][bj][m][0] + b0) * 16.0f, lo4), hi4), c1 = __builtin_elementwise_min(__builtin_elementwise_max((acc[ai][bj][m][1] + b1) * 16.0f, lo4), hi4);
                    u32x2 w8; w8.x = f4_to_fp8(c0[0], c0[1], c0[2], c0[3]); w8.y = f4_to_fp8(c1[0], c1[1], c1[2], c1[3]); *(u32x2*)((unsigned char*)YS + row * 1024 + col0 + bj * HALF) = w8; } }
    }
};
struct EpiBranch {
    static constexpr bool CHAIN = true;
    static constexpr bool PERM = true, AFTER_DRAIN = false;
    const unsigned char* GM; bf16_t* MIXED;
    __device__ __forceinline__ bool keep(const Unit& u) const { return u.pm < 64; }
    __device__ __forceinline__ void mid(f32x4 (&acc)[2][2][4][2], const Unit& u, int wr, int wc, int fr, int fq) const {
#pragma unroll
        for (int ai = 0; ai < 2; ++ai)
#pragma unroll
            for (int m = 0; m < 4; ++m) { const size_t row = (size_t)(u.pm & 63) * BM + ai * HALF + wr * 64 + m * 16 + fr;
#pragma unroll
                for (int bj = 0; bj < 2; ++bj) { const int col0 = (u.pn & 3) * BM + bj * HALF + wc * 32 + 8 * fq;
                    const u32x2 g1 = *(const u32x2*)(GM + row * 2048 + col0), g2 = *(const u32x2*)(GM + row * 2048 + 1024 + col0);
#pragma unroll
                    for (int q = 0; q < 8; ++q) { const float a1 = (float)((g1[q >> 2] >> (8 * (q & 3))) & 0xffu), a2 = (float)((g2[q >> 2] >> (8 * (q & 3))) & 0xffu);
                        acc[ai][bj][m][q >> 2][q & 3] *= a1 * frcp(a2); } } }
    }
    __device__ __forceinline__ void operator()(const f32x4 (&acc)[2][2][4][2], const Unit& u, int wr, int wc, int fr, int fq) const {
#pragma unroll
        for (int ai = 0; ai < 2; ++ai)
#pragma unroll
            for (int m = 0; m < 4; ++m) { const size_t row = (size_t)(u.pm & 63) * BM + ai * HALF + wr * 64 + m * 16 + fr;
#pragma unroll
                for (int bj = 0; bj < 2; ++bj) { const int col0 = (u.pn & 3) * BM + bj * HALF + wc * 32 + 8 * fq;
                    const u32x2 g2 = *(const u32x2*)(GM + row * 2048 + 1024 + col0); f32x4 o0, o1;
#pragma unroll
                    for (int q = 0; q < 8; ++q) { const float a2 = (float)((g2[q >> 2] >> (8 * (q & 3))) & 0xffu) * (1.0f / 255.0f); const float v0 = acc[ai][bj][m][q >> 2][q & 3] * a2;
                        if (q < 4) o0[q] = v0; else o1[q - 4] = v0; }
                    *(u32x4*)(MIXED + row * 1024 + col0) = pack8(o0, o1); } }
    }
};
struct BranchOrder {
    static constexpr bool GATHER = false;
    StaticOrder so;
    __device__ __forceinline__ bool next(int i, Unit& u) const { if (!so.next(i >> 1, u)) return false; u.pm += (i & 1) * 64; u.pn += (i & 1) * 4; return true; }
    __device__ __forceinline__ void a_ready(const Unit&) const {}
    __device__ __forceinline__ void done(const Unit&) const {}
    __device__ __forceinline__ int a_row(const Unit&, int) const { return 0; }
};
template <bool GATHER_>
struct ExpertOrder {
    static constexpr bool GATHER = GATHER_;
    const PG8_LAS int* base_s; int ntiles, npn, G, c; const PG8_LAS int* cnt_s; const int* TOK;
    __device__ __forceinline__ bool next(int i, Unit& u) const {
        const int nwg = ntiles * npn; const int L = i * G + c; if (L >= nwg) return false;
        int wgid = L; { const int q = nwg / NXCD, r = nwg % NXCD, xcd = wgid % NXCD, off = wgid / NXCD; wgid = (xcd < r ? xcd * (q + 1) : r * (q + 1) + (xcd - r) * q) + off; }
        const int gt = wgid / npn, pp = wgid % npn; const int e = base_s[64 + gt];
        u.pm = gt; u.pn = e * npn + pp; return true;
    }
    __device__ __forceinline__ int a_row(const Unit& u, int r) const {
        const int e = u.pn / npn; int pos = (u.pm - base_s[e]) * BM + r; const int last = cnt_s[e] - 1; pos = pos < last ? pos : last;
        return TOK[e * NTOK + pos];
    }
    __device__ __forceinline__ void a_ready(const Unit&) const {}
    __device__ __forceinline__ void done(const Unit&) const {}
};
template <class Epi, class Sched, bool ALIGN_EPI = false, bool SP2 = false, bool FP8 = false, bool HALFN = false>
__device__ __forceinline__ void gemm_phase(PG8_LAS unsigned char* lds, const Gemm g, const Sched& S, const Epi& E) {
    const int tid = threadIdx.x, wid = __builtin_amdgcn_readfirstlane(tid >> 6), lane = tid & 63, wr = wid >> 2, wc = wid & 3, fr = lane & 15, fq = lane >> 4;
    static_assert((!FP8 && !HALFN) || SP2, "the FP8 / HALFN paths are written for the SP2 loop");
    const int K = g.K, nt = K / BK;
    unsigned voffA[2][2], voffN[2][2], voffB[2]; int stR[2], stC[2];
#pragma unroll
    for (int i = 0; i < 2; ++i) { int R, C; stage_rc(tid * 16 + i * 8192, R, C); const int Rb = Epi::PERM ? ((R & ~31) + perm32(R & 31)) : R; stR[i] = R; stC[i] = C;
        voffA[0][i] = (unsigned)(R * K + C) * 2u; voffA[1][i] = (unsigned)((R + HALF) * K + C) * 2u; voffB[i] = (unsigned)(Rb * K + C) * 2u;
        voffN[0][i] = voffA[0][i]; voffN[1][i] = voffA[1][i]; }
#define PG8_AOFF(dst, u) do { if constexpr (Sched::GATHER) { _Pragma("unroll") for (int h_ = 0; h_ < 2; ++h_) _Pragma("unroll") for (int i_ = 0; i_ < 2; ++i_) \
        dst[h_][i_] = (unsigned)(S.a_row(u, h_ * HALF + stR[i_]) * K + stC[i_]) * 2u; } } while (0)
    const size_t kstep = (size_t)(BK * 2);
    const size_t hstep = (size_t)HALF * K * 2;
    const size_t tstep = 2 * hstep;
    const unsigned ldsw = (unsigned)wid * 1024u;
    const int aoff = lds_byte(wr * 64 + fr, fq * 8), boff = lds_byte(wc * 32 + fr, fq * 8);
    constexpr int KFS = 1024;
#define PG8_SA(b, h) (((b) * 2 + (h)) * HTB)
#define PG8_SB(b, h) ((4 + (b) * 2 + (h)) * HTB)
#define PG8_STAGE(bufoff, gbase, voff) do { _Pragma("unroll") for (int _i = 0; _i < 2; ++_i) \
        __builtin_amdgcn_global_load_lds((const unsigned*)((const char*)(gbase) + (voff)[_i]), (PG8_LAS unsigned*)(lds + (bufoff) + ldsw + _i * 8192), 16, 0, 0); } while (0)
#define PG8_LDA(dst, b, h) do { _Pragma("unroll") for (int m = 0; m < 4; ++m) _Pragma("unroll") for (int k = 0; k < 2; ++k) dst[m][k] = *(const PG8_LAS bf16x8*)(lds + PG8_SA(b, h) + aoff + m * 2048 + k * KFS); } while (0)
#define PG8_LDB(dst, b, h) do { _Pragma("unroll") for (int n = 0; n < 2; ++n) _Pragma("unroll") for (int k = 0; k < 2; ++k) dst[n][k] = *(const PG8_LAS bf16x8*)(lds + PG8_SB(b, h) + boff + n * 2048 + k * KFS); } while (0)
#define PG8_MMA(ai, bj, At, Bt) do { __builtin_amdgcn_s_setprio(1); \
        if constexpr (FP8) { const unsigned sb_ = (unsigned)bsc[bj]; _Pragma("unroll") for (int m = 0; m < 4; ++m) _Pragma("unroll") for (int n = 0; n < 2; ++n) { \
            const i32x8 bw_ = __builtin_shufflevector(__builtin_bit_cast(i32x4, Bt[n][0]), __builtin_bit_cast(i32x4, Bt[n][1]), 0, 1, 2, 3, 4, 5, 6, 7), aw_ = __builtin_shufflevector(__builtin_bit_cast(i32x4, At[m][0]), __builtin_bit_cast(i32x4, At[m][1]), 0, 1, 2, 3, 4, 5, 6, 7); \
            asm volatile("v_mfma_scale_f32_16x16x128_f8f6f4 %0, %1, %2, %0, %3, %4 op_sel_hi:[0,0,0]" : "+v"(acc[ai][bj][m][n]) : "v"(bw_), "v"(aw_), "v"(sb_), "v"(g.ascale)); } } \
        else { _Pragma("unroll") for (int m = 0; m < 4; ++m) _Pragma("unroll") for (int n = 0; n < 2; ++n) { _Pragma("unroll") for (int k = 0; k < 2; ++k) acc[ai][bj][m][n] = __builtin_amdgcn_mfma_f32_16x16x32_bf16(Bt[n][k], At[m][k], acc[ai][bj][m][n], 0, 0, 0); } } \
        __builtin_amdgcn_s_setprio(0); } while (0)
#define PG8_SCSHIFT() do { if constexpr (FP8) { bsc[0] >>= 8; bsc[1] >>= 8; } } while (0)
#define PG8_WAIT_V(n) asm volatile("s_waitcnt vmcnt(" #n ")" ::: "memory")
#define PG8_WAIT_L(n) asm volatile("s_waitcnt lgkmcnt(" #n ")" ::: "memory")
#define PG8_BAR __builtin_amdgcn_s_barrier()
#define PG8_SCHED __builtin_amdgcn_sched_barrier(0)
    Unit cur, nxt; int ui = 0;
    if (!S.next(0, cur)) return;
    f32x4 acc[2][2][4][2];
#pragma unroll
    for (int a = 0; a < 2; ++a)
#pragma unroll
        for (int b = 0; b < 2; ++b)
#pragma unroll
            for (int m = 0; m < 4; ++m)
#pragma unroll
                for (int n = 0; n < 2; ++n) acc[a][b][m][n] = (f32x4){0.f, 0.f, 0.f, 0.f};
    bf16x8 At[4][2], B0[2][2], B1[2][2];
    unsigned long long bsc[2] = {0ull, 0ull};
#define PG8_SCLOAD(u) do { if constexpr (FP8) { _Pragma("unroll") for (int bj_ = 0; bj_ < (HALFN ? 1 : 2); ++bj_) { const int grp_ = ((u).pn * (HALFN ? HALF : BM) + bj_ * HALF) / 32 + wc; \
        const unsigned long long v_ = *(const unsigned long long*)(g.Bs + (size_t)grp_ * 8); bsc[bj_] = ((unsigned long long)(unsigned)__builtin_amdgcn_readfirstlane((int)(v_ >> 32)) << 32) | (unsigned)__builtin_amdgcn_readfirstlane((int)v_); } } } while (0)
    const char* cA = Sched::GATHER ? (const char*)g.A : (const char*)g.A + (size_t)cur.pm * tstep; const char* cB = (const char*)g.Bt + (size_t)cur.pn * (HALFN ? hstep : tstep);
    PG8_AOFF(voffA, cur);
    PG8_SCLOAD(cur);
    S.a_ready(cur);
    if constexpr (SP2) {
        PG8_STAGE(PG8_SB(0, 0), cB, voffB); if constexpr (!HALFN) { PG8_STAGE(PG8_SB(0, 1), cB + hstep, voffB); } PG8_STAGE(PG8_SA(0, 0), cA, voffA[0]); PG8_STAGE(PG8_SA(0, 1), cA, voffA[1]);
        if (wr == 1) PG8_BAR;
        PG8_WAIT_V(2); PG8_BAR;
        PG8_STAGE(PG8_SB(1, 0), cB + kstep, voffB); PG8_STAGE(PG8_SA(1, 0), cA + kstep, voffA[0]); if constexpr (!HALFN) { PG8_STAGE(PG8_SB(1, 1), cB + hstep + kstep, voffB); }
        if constexpr (HALFN) { PG8_WAIT_V(4); } else { PG8_WAIT_V(6); } PG8_BAR;
    } else {
        PG8_STAGE(PG8_SB(0, 0), cB, voffB); PG8_STAGE(PG8_SA(0, 0), cA, voffA[0]); PG8_STAGE(PG8_SB(0, 1), cB + hstep, voffB); PG8_STAGE(PG8_SA(0, 1), cA, voffA[1]);
        if (wr == 1) PG8_BAR;
        PG8_WAIT_V(4); PG8_BAR;
        PG8_STAGE(PG8_SB(1, 0), cB + kstep, voffB); PG8_STAGE(PG8_SA(1, 0), cA + kstep, voffA[0]); PG8_STAGE(PG8_SB(1, 1), cB + hstep + kstep, voffB);
        PG8_WAIT_V(6); PG8_BAR;
    }
    for (;;) {
        const bool has_next = S.next(ui + 1, nxt);
        const char* nA = (has_next && !Sched::GATHER) ? (const char*)g.A + (size_t)nxt.pm * tstep : cA; const char* nB = has_next ? (const char*)g.Bt + (size_t)nxt.pn * (HALFN ? hstep : tstep) : cB;
        if (has_next) { PG8_AOFF(voffN, nxt); }
#pragma unroll 1
        for (int t = 0; t < nt; t += 2) {
            const bool last = (t == nt - 2);
            unsigned va2[2][2];
#pragma unroll
            for (int h_ = 0; h_ < 2; ++h_)
#pragma unroll
                for (int i_ = 0; i_ < 2; ++i_) va2[h_][i_] = (Sched::GATHER && last) ? voffN[h_][i_] : voffA[h_][i_];
            const char* a1 = cA + (size_t)(t + 1) * kstep;
            const char* a2 = last ? nA : cA + (size_t)(t + 2) * kstep; const char* b2 = last ? nB : cB + (size_t)(t + 2) * kstep;
            const char* a3 = a2 + kstep; const char* b3 = b2 + kstep;
            if (last && has_next) S.a_ready(nxt);
            if constexpr (SP2) {
            PG8_LDB(B0, 0, 0); if constexpr (!HALFN) { PG8_LDB(B1, 0, 1); } PG8_SCHED; PG8_LDA(At, 0, 0); PG8_STAGE(PG8_SA(1, 1), a1, voffA[1]);
            if constexpr (HALFN) { PG8_WAIT_V(6); } else { PG8_WAIT_V(8); } PG8_WAIT_L(0); PG8_BAR; PG8_MMA(0, 0, At, B0); if constexpr (!HALFN) { PG8_MMA(0, 1, At, B1); } PG8_BAR; PG8_SCHED;
            PG8_LDA(At, 0, 1); PG8_STAGE(PG8_SB(0, 0), b2, voffB); if constexpr (!HALFN) { PG8_STAGE(PG8_SB(0, 1), b2 + hstep, voffB); } PG8_STAGE(PG8_SA(0, 0), a2, va2[0]);
            if constexpr (HALFN) { PG8_WAIT_V(6); } else { PG8_WAIT_V(8); } PG8_WAIT_L(0); PG8_BAR; PG8_MMA(1, 0, At, B0); if constexpr (!HALFN) { PG8_MMA(1, 1, At, B1); } PG8_SCSHIFT(); PG8_BAR; PG8_SCHED;
            PG8_LDB(B0, 1, 0); if constexpr (!HALFN) { PG8_LDB(B1, 1, 1); } PG8_SCHED; PG8_LDA(At, 1, 0); PG8_STAGE(PG8_SA(0, 1), a2, va2[1]);
            if constexpr (HALFN) { PG8_WAIT_V(6); } else { PG8_WAIT_V(8); } PG8_WAIT_L(0); PG8_BAR; PG8_MMA(0, 0, At, B0); if constexpr (!HALFN) { PG8_MMA(0, 1, At, B1); } PG8_BAR; PG8_SCHED;
            PG8_LDA(At, 1, 1); PG8_STAGE(PG8_SB(1, 0), b3, voffB); if constexpr (!HALFN) { PG8_STAGE(PG8_SB(1, 1), b3 + hstep, voffB); } PG8_STAGE(PG8_SA(1, 0), a3, va2[0]);
            if constexpr (HALFN) { PG8_WAIT_V(6); } else { PG8_WAIT_V(8); } PG8_WAIT_L(0); PG8_BAR; PG8_MMA(1, 0, At, B0); if constexpr (!HALFN) { PG8_MMA(1, 1, At, B1); } PG8_SCSHIFT(); PG8_BAR; PG8_SCHED;
            } else {
            PG8_LDB(B0, 0, 0); PG8_SCHED; PG8_LDA(At, 0, 0); PG8_STAGE(PG8_SA(1, 1), a1, voffA[1]);
            PG8_WAIT_L(8); PG8_BAR; PG8_WAIT_L(0); PG8_MMA(0, 0, At, B0); PG8_BAR; PG8_SCHED;
            PG8_LDB(B1, 0, 1); PG8_STAGE(PG8_SB(0, 0), b2, voffB);
            PG8_BAR; PG8_WAIT_L(0); PG8_MMA(0, 1, At, B1); PG8_BAR;
            PG8_LDA(At, 0, 1); PG8_STAGE(PG8_SA(0, 0), a2, va2[0]);
            PG8_BAR; PG8_WAIT_L(0); PG8_MMA(1, 0, At, B0); PG8_BAR; PG8_SCHED;
            PG8_STAGE(PG8_SB(0, 1), b2 + hstep, voffB);
            PG8_WAIT_V(6); PG8_BAR; PG8_MMA(1, 1, At, B1); PG8_BAR;
            PG8_LDB(B0, 1, 0); PG8_SCHED; PG8_LDA(At, 1, 0); PG8_STAGE(PG8_SA(0, 1), a2, va2[1]);
            PG8_WAIT_L(8); PG8_BAR; PG8_WAIT_L(0); PG8_MMA(0, 0, At, B0); PG8_BAR; PG8_SCHED;
            PG8_LDB(B1, 1, 1); PG8_STAGE(PG8_SB(1, 0), b3, voffB);
            PG8_BAR; PG8_WAIT_L(0); PG8_MMA(0, 1, At, B1); PG8_BAR;
            PG8_LDA(At, 1, 1); PG8_STAGE(PG8_SA(1, 0), a3, va2[0]);
            PG8_BAR; PG8_WAIT_L(0); PG8_MMA(1, 0, At, B0); PG8_BAR; PG8_SCHED;
            PG8_STAGE(PG8_SB(1, 1), b3 + hstep, voffB);
            PG8_WAIT_V(6); PG8_BAR; PG8_MMA(1, 1, At, B1); PG8_BAR;
            }
        }
        if constexpr (ALIGN_EPI) { if (wr == 0) PG8_BAR; }
        if constexpr (FP8) {
#define PG8_ACC8(a, b, m0) "+v"(acc[a][b][m0][0]), "+v"(acc[a][b][m0][1]), "+v"(acc[a][b][m0 + 1][0]), "+v"(acc[a][b][m0 + 1][1])
            asm volatile("s_nop 7\n\ts_nop 7\n\ts_nop 7" : PG8_ACC8(0, 0, 0), PG8_ACC8(0, 0, 2), PG8_ACC8(0, 1, 0), PG8_ACC8(0, 1, 2));
            asm volatile("" : PG8_ACC8(1, 0, 0), PG8_ACC8(1, 0, 2), PG8_ACC8(1, 1, 0), PG8_ACC8(1, 1, 2));
#undef PG8_ACC8
        }
        bool keep = false;
        if constexpr (Epi::CHAIN) keep = E.keep(cur);
        const int lane_e = (int)__builtin_amdgcn_mbcnt_hi(~0u, __builtin_amdgcn_mbcnt_lo(~0u, 0u)); int fr_e = lane_e & 15, fq_e = lane_e >> 4; asm volatile("" : "+v"(fr_e), "+v"(fq_e));
        if constexpr (Epi::CHAIN) { if (keep) E.mid(acc, cur, wr, wc, fr_e, fq_e); }
        if constexpr (!Epi::AFTER_DRAIN) { if (!keep) E(acc, cur, wr, wc, fr_e, fq_e); S.done(cur); }
        if (!has_next) break;
        if (!keep)
#pragma unroll
        for (int a = 0; a < 2; ++a)
#pragma unroll
            for (int b = 0; b < 2; ++b)
#pragma unroll
                for (int m = 0; m < 4; ++m)
#pragma unroll
                    for (int n = 0; n < 2; ++n) acc[a][b][m][n] = (f32x4){0.f, 0.f, 0.f, 0.f};
        cur = nxt; cA = nA; cB = nB; ++ui;
        PG8_SCLOAD(cur);
        if constexpr (Sched::GATHER) { _Pragma("unroll") for (int h_ = 0; h_ < 2; ++h_) _Pragma("unroll") for (int i_ = 0; i_ < 2; ++i_) voffA[h_][i_] = voffN[h_][i_]; }
        if constexpr (ALIGN_EPI) { if (wr == 1) PG8_BAR; }
    }
    PG8_WAIT_V(0);
    if constexpr (!ALIGN_EPI) { if (wr == 0) PG8_BAR; }
    PG8_BAR;
    if constexpr (Epi::AFTER_DRAIN) { E.fused(acc, cur, wr, wc, fr, fq, lds, wid, lane); S.done(cur); }
#undef PG8_AOFF
#undef PG8_SA
#undef PG8_SB
#undef PG8_STAGE
#undef PG8_LDA
#undef PG8_LDB
#undef PG8_MMA
#undef PG8_SCSHIFT
#undef PG8_SCLOAD
#undef PG8_WAIT_V
#undef PG8_WAIT_L
#undef PG8_BAR
#undef PG8_SCHED
}
}

__device__ __forceinline__ void phase_inproj(Frame& F) {
    pg8::Gemm g{(const bf16_t*)(F.ws + WS_XB), (const bf16_t*)(F.ws + WS_WIN), NTOK, NVC, 1024};
    pg8::StaticOrder S; S.init(NTOK, NVC, F.G, F.bid);
    pg8::EpiInProj E{F.ws};
    pg8::gemm_phase<pg8::EpiInProj, pg8::StaticOrder, true, true>(F.lds, g, S, E);
    pg8::Gemm g8{(const bf16_t*)(F.ws + WS_XB8), (const bf16_t*)(F.ws + WS_WG8), NTOK, NVG, 512, (const unsigned char*)(F.ws + WS_SCG), 0x7b7b7b7bu};
    pg8::StaticOrder S8; S8.init(NTOK, NVG, F.G, F.bid);
    pg8::EpiGate E8{F.ws};
    pg8::gemm_phase<pg8::EpiGate, pg8::StaticOrder, true, true, true, false>(F.lds, g8, S8, E8);
}

__device__ __forceinline__ float gelu_tanh(float x) { const float u = 0.7978845608028654f * (x + 0.044715f * x * x * x); return 0.5f * x * (1.0f + tanhf(u)); }
__device__ __forceinline__ void cmp1_unit(Frame& F, int u) {
    unsigned char* ws = F.ws;
    const int wr = F.wave >> 2, wc = F.wave & 3, fr = F.lane & 15, fq = F.lane >> 4;
    {
        const int which = u >> 4, bg = (u >> 2) & 3, rt = u & 3;
        const bf16_t* src = kv_tensor(ws, which) + (size_t)bg * SEQ * 64;
        const bf16_t* a = src + (size_t)(rt * 128 + (F.tid >> 2)) * 1024 + (F.tid & 3) * 8;
        const bf16_t* b0 = (const bf16_t*)(ws + (which ? WS_W1VT : WS_W1KT)) + (size_t)(F.tid >> 2) * 2048 + (F.tid & 3) * 8;
        const float* c1p = (const float*)(ws + WS_C1P) + (size_t)which * 32 * 128;
        bf16_t* HID = (bf16_t*)(ws + (which ? WS_HIDV : WS_HIDK)) + (size_t)bg * 512 * 128;
        f32x4 acc[4][2][2]; acc_zero(acc);
        gemm_kloop<false>(F.lds, a, b0, b0, 2048, acc, F.wave, F.lane);
#pragma unroll
        for (int m = 0; m < 4; ++m) { const int row = rt * 128 + wr * 64 + m * 16 + fr;
#pragma unroll
            for (int n = 0; n < 2; ++n) { const int col = wc * 32 + n * 16 + 4 * fq; f32x4 bv = {0.f, 0.f, 0.f, 0.f};
#pragma unroll 8
                for (int p2 = 0; p2 < 32; ++p2) bv += *(const f32x4*)(c1p + p2 * 128 + col);
                const f32x4 v = acc[m][0][n] + bv;
                u32x2 w; w.x = pk2(gelu_tanh(v.x), gelu_tanh(v.y)); w.y = pk2(gelu_tanh(v.z), gelu_tanh(v.w)); *(u32x2*)(HID + (size_t)row * 128 + col) = w; } }
    }
}
__device__ __forceinline__ void cmp2_unit(Frame& F, int u) {
    unsigned char* ws = F.ws;
    const int wr = F.wave >> 2, wc = F.wave & 3, fr = F.lane & 15, fq = F.lane >> 4;
    {
        const int which = u >> 4, bg = (u >> 2) & 3, rt = u & 3;
        const bf16_t* HID = (const bf16_t*)(ws + (which ? WS_HIDV : WS_HIDK)) + (size_t)bg * 512 * 128;
        const bf16_t* a = HID + (size_t)(rt * 128 + (F.tid >> 2)) * 128 + (F.tid & 3) * 8;
        const bf16_t* b0 = (const bf16_t*)(ws + (which ? WS_W2VT : WS_W2KT)) + (size_t)(F.tid >> 2) * 128 + (F.tid & 3) * 8;
        bf16_t* OUT = (bf16_t*)(ws + (which ? WS_VCMP : WS_KCMP)) + (size_t)bg * 512 * 64;
        f32x4 acc[4][2][2]; acc_zero(acc);
        gemm_kloop<false>(F.lds, a, b0, b0, 128, acc, F.wave, F.lane);
        if (wc < 2) {
#pragma unroll
            for (int m = 0; m < 4; ++m) { const int row = rt * 128 + wr * 64 + m * 16 + fr;
#pragma unroll
                for (int n = 0; n < 2; ++n) { const int col = wc * 32 + n * 16 + 4 * fq; const f32x4 v = acc[m][0][n];
                    u32x2 w; w.x = pk2(v.x, v.y); w.y = pk2(v.z, v.w); *(u32x2*)(OUT + (size_t)row * 64 + col) = w; } }
        }
    }
}

namespace att {
typedef short s16x4 __attribute__((ext_vector_type(4)));
typedef float f32x16 __attribute__((ext_vector_type(16)));
typedef float f32x2_t __attribute__((ext_vector_type(2))); typedef __bf16 bf16x2_t __attribute__((ext_vector_type(2)));
constexpr int NW = 8, QBLK = 32, QB = 256, KVBLK = 64, KP = 64, QP = 512;
constexpr int NSLOT = 3, SLOTB = 8192;
constexpr int LDS_K = 0, LDS_V = NSLOT * SLOTB, LDS_WS = 2 * NSLOT * SLOTB, LDS_OST = LDS_WS + NW * 256, LDS_Q = LDS_OST + NW * 4096, LDS_SW = LDS_Q + NW * 4096, LDS_BYTES = LDS_SW + NW * 1024;
enum { M_SEL = 0, M_WIN = 1, M_SWA = 2 };
__device__ __forceinline__ int crow(int r, int hi) { return (r & 3) + 8 * (r >> 2) + 4 * hi; }
#define SBAR() __builtin_amdgcn_sched_barrier(0)
__device__ __forceinline__ void cmask(f32x16& p0, f32x16& p1, int jb, int qrel, int hi) {
    const float NEG = -__builtin_inff(); const int kb = 64 * jb + 4 * hi;
#pragma unroll
    for (int r = 0; r < 16; ++r) { const int kv = kb + (r & 3) + 8 * (r >> 2); if (kv > qrel) p0[r] = NEG; if (kv + 32 > qrel) p1[r] = NEG; }
}
__device__ __forceinline__ void lmask(f32x16& p0, f32x16& p1, int t, int qrel, int hi) {
    const float NEG = -__builtin_inff(); const int kb = 64 * t + 4 * hi;
#pragma unroll
    for (int r = 0; r < 16; ++r) { const int kv = kb + (r & 3) + 8 * (r >> 2); if (kv <= qrel) p0[r] = NEG; if (kv + 32 <= qrel) p1[r] = NEG; }
}
__device__ __forceinline__ void glds16(const void* gsrc, unsigned lds_dst) { unsigned keep;
    asm volatile("s_mov_b32 %0, m0\n\ts_mov_b32 m0, %2\n\ts_nop 0\n\tglobal_load_lds_dwordx4 %1, off\n\ts_mov_b32 m0, %0" : "=&s"(keep) : "v"(gsrc), "s"(lds_dst) : "memory"); }
__device__ __forceinline__ float max3f(float a, float b, float c) { float r; asm("v_max3_f32 %0, %1, %2, %3" : "=v"(r) : "v"(a), "v"(b), "v"(c)); return r; }
__device__ __forceinline__ float max2f(float a, float b) { float r; asm("v_max_f32_e32 %0, %1, %2" : "=v"(r) : "v"(a), "v"(b)); return r; }
__device__ __forceinline__ float fadd_s(float a, float b) { float r; asm("v_add_f32_e32 %0, %1, %2" : "=v"(r) : "v"(a), "v"(b)); return r; }
__device__ __forceinline__ float fsub_s(float a, float b) { float r; asm("v_sub_f32_e32 %0, %1, %2" : "=v"(r) : "v"(a), "v"(b)); return r; }
__device__ __forceinline__ unsigned cvtpk_s(float lo, float hi) { f32x2_t v = {lo, hi}; bf16x2_t b = __builtin_convertvector(v, bf16x2_t); return __builtin_bit_cast(unsigned, b); }
#define WAIT_BAR(N) asm volatile("s_waitcnt vmcnt(" #N ") lgkmcnt(0)\n\ts_barrier" ::: "memory")
__device__ __forceinline__ void qkt(f32x16& p0, f32x16& p1, const char* Kslot, const bf16x8* qr, const f32x16& negm, int r32, int hi) {
    const char* kb = Kslot + hi * 1024 + r32 * 16;
#pragma unroll
    for (int d0 = 0; d0 < 4; ++d0) {
        const bf16x8 b0 = *reinterpret_cast<const bf16x8*>(kb + d0 * 2048);
        const bf16x8 b1 = *reinterpret_cast<const bf16x8*>(kb + d0 * 2048 + 512);
        if (d0 == 0) { p0 = __builtin_amdgcn_mfma_f32_32x32x16_bf16(b0, qr[0], negm, 0, 0, 0); p1 = __builtin_amdgcn_mfma_f32_32x32x16_bf16(b1, qr[0], negm, 0, 0, 0); }
        else { p0 = __builtin_amdgcn_mfma_f32_32x32x16_bf16(b0, qr[d0], p0, 0, 0, 0); p1 = __builtin_amdgcn_mfma_f32_32x32x16_bf16(b1, qr[d0], p1, 0, 0, 0); } }
}
typedef __attribute__((address_space(3))) const char* lds_cptr;
typedef short v4i16_t __attribute__((ext_vector_type(4)));
__device__ __forceinline__ void kload8(bf16x8* kf, lds_cptr kp) {
    kf[0] = *(const LAS bf16x8*)(kp);        kf[1] = *(const LAS bf16x8*)(kp + 512);
    kf[2] = *(const LAS bf16x8*)(kp + 2048); kf[3] = *(const LAS bf16x8*)(kp + 2560);
    kf[4] = *(const LAS bf16x8*)(kp + 4096); kf[5] = *(const LAS bf16x8*)(kp + 4608);
    kf[6] = *(const LAS bf16x8*)(kp + 6144); kf[7] = *(const LAS bf16x8*)(kp + 6656);
}
__device__ __forceinline__ void kload2(bf16x8* kf, lds_cptr kp, int j) { kf[2 * j] = *(const LAS bf16x8*)(kp + j * 2048); kf[2 * j + 1] = *(const LAS bf16x8*)(kp + j * 2048 + 512); }
__device__ __forceinline__ s16x4 vtr(lds_cptr p) { return __builtin_bit_cast(s16x4, __builtin_amdgcn_ds_read_tr16_b64_v4i16((LAS v4i16_t*)p)); }
__device__ __forceinline__ float rowmax(const f32x16& p0, const f32x16& p1) {
    float a = max3f(p0[0], p0[1], p1[0]), b = max3f(p0[2], p0[3], p1[1]); a = max3f(a, p1[2], p1[3]);
#pragma unroll
    for (int r = 4; r < 16; r += 4) { a = max3f(a, p0[r], p0[r + 1]); b = max3f(b, p0[r + 2], p0[r + 3]); a = max3f(a, p1[r], p1[r + 1]); b = max3f(b, p1[r + 2], p1[r + 3]); }
    const float m = max2f(a, b);
    auto rr = __builtin_amdgcn_permlane32_swap(__float_as_uint(m), __float_as_uint(m), false, false);
    return max2f(__uint_as_float(rr[0]), __uint_as_float(rr[1]));
}
__device__ __forceinline__ void pv(f32x16* o, int vb, bf16x8 pa0, bf16x8 pa1, bf16x8 pa2, bf16x8 pa3) {
#pragma unroll
    for (int d0 = 0; d0 < 2; ++d0) { s16x4 lo[4], hi[4];
#pragma unroll
        for (int ks = 0; ks < 4; ++ks) {
            asm volatile("ds_read_b64_tr_b16 %0,%1 offset:%c2" : "=&v"(lo[ks]) : "v"(vb), "i"(d0 * 4096 + ks * 1024) : "memory");
            asm volatile("ds_read_b64_tr_b16 %0,%1 offset:%c2" : "=&v"(hi[ks]) : "v"(vb), "i"(d0 * 4096 + ks * 1024 + 512) : "memory"); }
        asm volatile("s_waitcnt lgkmcnt(0)" ::: "memory"); SBAR();
#define PK(k) (bf16x8){lo[k][0], lo[k][1], lo[k][2], lo[k][3], hi[k][0], hi[k][1], hi[k][2], hi[k][3]}
        o[d0] = __builtin_amdgcn_mfma_f32_32x32x16_bf16(pa0, PK(0), o[d0], 0, 0, 0);
        o[d0] = __builtin_amdgcn_mfma_f32_32x32x16_bf16(pa1, PK(1), o[d0], 0, 0, 0);
        o[d0] = __builtin_amdgcn_mfma_f32_32x32x16_bf16(pa2, PK(2), o[d0], 0, 0, 0);
        o[d0] = __builtin_amdgcn_mfma_f32_32x32x16_bf16(pa3, PK(3), o[d0], 0, 0, 0);
#undef PK
    }
}
struct Tens { const bf16_t* Q; const bf16_t* K; const bf16_t* V; const unsigned* SEL; const float* GN; bf16_t* OB; const float* sinks; };
constexpr int S_K = 0, S_V = 16384, S_WS = 32768, S_OST = S_WS + NW * 256, S_BYTES = S_OST + NW * 4096;
template <int MODE, int THRL> __device__ __forceinline__ void attn_unit(int b, int h, int qb, const Tens& T, char* shm) {
    const int tid = threadIdx.x, lane = tid & 63, r32 = lane & 31, hi = lane >> 5; const int wid = __builtin_amdgcn_readfirstlane(tid >> 6);
    const int bg = b * 2 + (h >> 2); const long rowbase = (long)b * SEQ; const int q0 = qb * QB;
    constexpr int W = (MODE == M_WIN) ? 512 : 128;
    const bool lower = (MODE != M_SEL) && (q0 + QB - 1 >= W);
    const int t0 = (MODE != M_SEL && q0 >= W) ? (q0 - W) / KVBLK : 0;
    const int NT = (q0 + QB) / KVBLK - t0;
    const int loff = q0 - W - t0 * KVBLK;
    const bf16_t* Qw = T.Q + (rowbase + q0 + wid * QBLK) * QP + h * 64;
    const bf16_t* Kh = T.K + ((long)bg * SEQ + (long)t0 * KVBLK) * KP; const bf16_t* Vh = T.V + ((long)bg * SEQ + (long)t0 * KVBLK) * KP;
    const unsigned lds0 = (unsigned)(uintptr_t)shm;
    float* wsf = (float*)(shm + S_WS) + wid * 64;
    const bf16_t* ksrc = Kh + (long)lane * KP + wid * 8;
    const bf16_t* vsrc = Vh + (long)(16 * (wid & 3) + (lane >> 2)) * KP + (wid >> 2) * 32 + (lane & 3) * 8;
    const unsigned kdst = lds0 + S_K + wid * 1024, vdst = lds0 + S_V + wid * 1024;
#define DMA_K(t, slot) glds16(ksrc + (long)(t) * KVBLK * KP, (unsigned)__builtin_amdgcn_readfirstlane(kdst + (slot)))
#define DMA_V(t, slot) glds16(vsrc + (long)(t) * KVBLK * KP, (unsigned)__builtin_amdgcn_readfirstlane(vdst + (slot)))
    const int vb0 = (int)(lds0 + S_V) + ((lane >> 4) & 1) * 32 + (lane & 3) * 8 + (4 * hi + ((lane & 15) >> 2)) * 64;
    const char* Kbase = shm + S_K;
    DMA_K(0, 0); DMA_V(0, 0);
    bf16x8 qr[4];
#pragma unroll
    for (int d0 = 0; d0 < 4; ++d0) qr[d0] = *reinterpret_cast<const bf16x8*>(&Qw[(long)r32 * QP + d0 * 16 + hi * 8]);
    const int qrel = wid * QBLK + r32;
    u32x4 sw = (u32x4){0u, 0u, 0u, 0u};
    if (MODE == M_SEL) sw = *(const u32x4*)(T.SEL + ((size_t)bg * SEQ + q0 + qrel) * 4);
    float mhat = 0.f, l_reg = 0.f; bool seen = false; f32x16 o[2]; o[0] = f32x16{}; o[1] = f32x16{}; f32x16 negm = f32x16{};
    const float NINF = -__builtin_inff();
#pragma unroll 1
    for (int t = 0; t < NT; ++t) {
        const int slot = (t & 1) * 8192;
        if (t + 1 < NT) { DMA_K(t + 1, slot ^ 8192); DMA_V(t + 1, slot ^ 8192); WAIT_BAR(2); } else { WAIT_BAR(0); }
        f32x16 p0, p1;
        qkt(p0, p1, Kbase + slot, qr, negm, r32, hi);
        { const int jb_ = t - (NT - 4); if (jb_ >= 0) cmask(p0, p1, jb_, qrel, hi); }
        if (MODE != M_SEL) { if (lower && t < 4) lmask(p0, p1, t, qrel + loff, hi); }
        unsigned onm = 0xffffffffu;
        if (MODE == M_SEL) { const unsigned wsel = t < 32 ? sw.x : t < 64 ? sw.y : t < 96 ? sw.z : sw.w; onm = 0u - ((wsel >> (t & 31)) & 1u); }
        float rm;
        { float a = __builtin_fmaxf(__builtin_fmaxf(p0[0], p0[1]), p1[0]), c = __builtin_fmaxf(__builtin_fmaxf(p0[2], p0[3]), p1[1]); a = __builtin_fmaxf(__builtin_fmaxf(a, p1[2]), p1[3]);
#pragma unroll
          for (int r = 4; r < 16; r += 4) { a = __builtin_fmaxf(__builtin_fmaxf(a, p0[r]), p0[r + 1]); c = __builtin_fmaxf(__builtin_fmaxf(c, p0[r + 2]), p0[r + 3]); a = __builtin_fmaxf(__builtin_fmaxf(a, p1[r]), p1[r + 1]); c = __builtin_fmaxf(__builtin_fmaxf(c, p1[r + 2]), p1[r + 3]); }
          rm = __builtin_fmaxf(a, c); auto rr = __builtin_amdgcn_permlane32_swap(__float_as_uint(rm), __float_as_uint(rm), false, false); rm = __builtin_fmaxf(__uint_as_float(rr[0]), __uint_as_float(rr[1])); }
        if (MODE == M_SEL) rm = onm ? rm : NINF;
        const bool live = rm > NINF; const bool need = live && (!seen || rm > (float)THRL);
        if (__any(need)) {
            const float dl = need ? rm : 0.f; mhat += dl;
#pragma unroll
            for (int r = 0; r < 16; ++r) { p0[r] -= dl; p1[r] -= dl; }
#pragma unroll
            for (int r = 0; r < 16; ++r) negm[r] = -mhat;
            const float f = (need && seen) ? __builtin_amdgcn_exp2f(-dl) : 1.0f; l_reg *= f;
            if (hi == 0) wsf[r32] = f;
            asm volatile("s_waitcnt lgkmcnt(0)" ::: "memory");
#pragma unroll
            for (int d_ = 0; d_ < 2; ++d_)
#pragma unroll
                for (int r = 0; r < 16; ++r) o[d_][r] *= wsf[crow(r, hi)];
        }
        seen = seen || live;
        float sacc = 0.f;
#pragma unroll
        for (int r = 0; r < 16; ++r) { p0[r] = __builtin_amdgcn_exp2f(p0[r]); p1[r] = __builtin_amdgcn_exp2f(p1[r]); sacc += p0[r] + p1[r]; }
        l_reg += __uint_as_float(__float_as_uint(sacc) & onm);
        u32x4 pw0, pw1, pw2, pw3;
        pw0 = (u32x4){cvtpk_s(p0[0], p0[1]), cvtpk_s(p0[2], p0[3]), cvtpk_s(p0[4], p0[5]), cvtpk_s(p0[6], p0[7])};
        pw1 = (u32x4){cvtpk_s(p0[8], p0[9]), cvtpk_s(p0[10], p0[11]), cvtpk_s(p0[12], p0[13]), cvtpk_s(p0[14], p0[15])};
        pw2 = (u32x4){cvtpk_s(p1[0], p1[1]), cvtpk_s(p1[2], p1[3]), cvtpk_s(p1[4], p1[5]), cvtpk_s(p1[6], p1[7])};
        pw3 = (u32x4){cvtpk_s(p1[8], p1[9]), cvtpk_s(p1[10], p1[11]), cvtpk_s(p1[12], p1[13]), cvtpk_s(p1[14], p1[15])};
        if (MODE == M_SEL) { pw0 &= onm; pw1 &= onm; pw2 &= onm; pw3 &= onm; }
        SBAR();
        pv(o, vb0 + slot, __builtin_bit_cast(bf16x8, pw0), __builtin_bit_cast(bf16x8, pw1), __builtin_bit_cast(bf16x8, pw2), __builtin_bit_cast(bf16x8, pw3));
        asm volatile("s_waitcnt lgkmcnt(0)\n\ts_barrier" ::: "memory");
    }
    { auto rr = __builtin_amdgcn_permlane32_swap(__float_as_uint(l_reg), __float_as_uint(l_reg), false, false); l_reg = __uint_as_float(rr[0]) + __uint_as_float(rr[1]); }
    if (MODE == M_SWA) l_reg += exp2f(T.sinks[h] * LOG2E - mhat);
    if (hi == 0) { float gate = 1.0f; if (MODE != M_SWA) gate = T.GN[(size_t)(rowbase + q0 + qrel) * 24 + h * 3 + (MODE == M_SEL ? 1 : 2)]; wsf[32 + r32] = l_reg / gate; }
    asm volatile("s_waitcnt lgkmcnt(0)" ::: "memory");
    float rli[16];
#pragma unroll
    for (int r = 0; r < 16; ++r) rli[r] = __builtin_amdgcn_rcpf(wsf[32 + crow(r, hi)]);
    { bf16_t* Ow = T.OB + (rowbase + q0 + wid * QBLK) * 512 + h * 64; bf16_t* stg = (bf16_t*)(shm + S_OST) + wid * 2048;
#pragma unroll
      for (int r = 0; r < 16; ++r) { const int orow = crow(r, hi);
#pragma unroll
          for (int d0 = 0; d0 < 2; ++d0) stg[orow * 64 + d0 * 32 + r32] = (bf16_t)f2bf(o[d0][r] * rli[r]); }
      asm volatile("s_waitcnt lgkmcnt(0)" ::: "memory");
#pragma unroll
      for (int i = 0; i < 4; ++i) { const int row = i * 8 + (lane >> 3), ch = lane & 7; const u32x4 v = *(const u32x4*)(stg + row * 64 + ch * 8); *(u32x4*)(Ow + (long)row * 512 + ch * 8) = v; } }
    asm volatile("s_waitcnt vmcnt(0) lgkmcnt(0)\n\ts_barrier" ::: "memory");
#undef DMA_K
#undef DMA_V
}
constexpr int P_K = 0, P_V = 32768, P_WS = 65536, P_OST = P_WS + NW * 256, P_BYTES = P_OST + NW * 4096;
template <int MODE, int THRL> __device__ __forceinline__ void attn_unit_p(int b, int h, int qb, const Tens& T, char* shm) {
    const int tid = threadIdx.x, lane = tid & 63, r32 = lane & 31, hi = lane >> 5; const int wid = __builtin_amdgcn_readfirstlane(tid >> 6);
    const int bg = b * 2 + (h >> 2); const long rowbase = (long)b * SEQ; const int q0 = qb * QB;
    constexpr int W = (MODE == M_WIN) ? 512 : 128;
    const bool lower = (MODE != M_SEL) && (q0 + QB - 1 >= W);
    const int t0 = (MODE != M_SEL && q0 >= W) ? (q0 - W) / KVBLK : 0;
    const int NT = (q0 + QB) / KVBLK - t0;
    const int loff = q0 - W - t0 * KVBLK;
    const bf16_t* Qw = T.Q + (rowbase + q0 + wid * QBLK) * QP + h * 64;
    const bf16_t* Kh = T.K + ((long)bg * SEQ + (long)t0 * KVBLK) * KP; const bf16_t* Vh = T.V + ((long)bg * SEQ + (long)t0 * KVBLK) * KP;
    const unsigned lds0 = (unsigned)(uintptr_t)shm; const lds_cptr shm3 = (lds_cptr)shm;
    float* wsf = (float*)(shm + P_WS) + wid * 64;
    const bf16_t* ksrc = Kh + (long)lane * KP + wid * 8;
    const bf16_t* vsrc = Vh + (long)(16 * (wid & 3) + (lane >> 2)) * KP + (wid >> 2) * 32 + (lane & 3) * 8;
    const unsigned kdst = lds0 + P_K + wid * 1024, vdst = lds0 + P_V + wid * 1024;
#define DMA_KV(t, slot) do { glds16(ksrc + (long)(t) * KVBLK * KP, (unsigned)__builtin_amdgcn_readfirstlane(kdst + (slot))); glds16(vsrc + (long)(t) * KVBLK * KP, (unsigned)__builtin_amdgcn_readfirstlane(vdst + (slot))); } while (0)
    const lds_cptr kp0 = shm3 + P_K + hi * 1024 + r32 * 16;
    const lds_cptr vp0 = shm3 + P_V + ((lane >> 4) & 1) * 32 + (lane & 3) * 8 + (4 * hi + ((lane & 15) >> 2)) * 64;
    DMA_KV(0, 0); DMA_KV(1, 8192); DMA_KV(2, 16384);
    bf16x8 qr[4];
#pragma unroll
    for (int d0 = 0; d0 < 4; ++d0) qr[d0] = *reinterpret_cast<const bf16x8*>(&Qw[(long)r32 * QP + d0 * 16 + hi * 8]);
    const int qrel = wid * QBLK + r32;
    u32x4 sw = (u32x4){0u, 0u, 0u, 0u};
    if (MODE == M_SEL) sw = *(const u32x4*)(T.SEL + ((size_t)bg * SEQ + q0 + qrel) * 4);
#define SELM(t) ((MODE == M_SEL) ? (0u - ((((t) < 32 ? sw.x : (t) < 64 ? sw.y : (t) < 96 ? sw.z : sw.w) >> ((t) & 31)) & 1u)) : 0xffffffffu)
    float mhat = 0.f, l_reg = 0.f; bool seen = false; f32x16 o[2]; o[0] = f32x16{}; o[1] = f32x16{}; f32x16 negm = f32x16{}; asm volatile("" : "+v"(negm));
    const float NINF = -__builtin_inff();
#define KFR(slot, k) (*(const LAS bf16x8*)(kp0 + (slot) + ((k) >> 1) * 2048 + ((k) & 1) * 512))
#define MASKS(C0, C1, tt) do { const int jb_ = (tt) - (NT - 4); if (jb_ >= 0) cmask(C0, C1, jb_, qrel, hi); if (MODE != M_SEL) { if (lower && (tt) < 4) lmask(C0, C1, (tt), qrel + loff, hi); } } while (0)
#define REFUPD(C0, C1, rm) do { const bool live_ = (rm) > NINF; const bool need_ = live_ && (!seen || (rm) > (float)THRL); \
        if (__any(need_)) { const float dl_ = need_ ? (rm) : 0.f; mhat += dl_; \
            _Pragma("unroll") for (int r = 0; r < 16; ++r) { C0[r] -= dl_; C1[r] -= dl_; } \
            _Pragma("unroll") for (int r = 0; r < 16; ++r) negm[r] = -mhat; asm volatile("" : "+v"(negm)); \
            const float f_ = (need_ && seen) ? __builtin_amdgcn_exp2f(-dl_) : 1.0f; l_reg *= f_; if (hi == 0) wsf[r32] = f_; \
            asm volatile("s_waitcnt lgkmcnt(0)" ::: "memory"); \
            _Pragma("unroll") for (int d_ = 0; d_ < 2; ++d_) _Pragma("unroll") for (int r = 0; r < 16; ++r) o[d_][r] *= wsf[crow(r, hi)]; } \
        seen = seen || live_; } while (0)
#define ROWMAX(C0, C1, rm) do { float a_ = __builtin_fmaxf(__builtin_fmaxf(C0[0], C0[1]), C1[0]), c_ = __builtin_fmaxf(__builtin_fmaxf(C0[2], C0[3]), C1[1]); a_ = __builtin_fmaxf(__builtin_fmaxf(a_, C1[2]), C1[3]); \
        _Pragma("unroll") for (int r = 4; r < 16; r += 4) { a_ = __builtin_fmaxf(__builtin_fmaxf(a_, C0[r]), C0[r + 1]); c_ = __builtin_fmaxf(__builtin_fmaxf(c_, C0[r + 2]), C0[r + 3]); a_ = __builtin_fmaxf(__builtin_fmaxf(a_, C1[r]), C1[r + 1]); c_ = __builtin_fmaxf(__builtin_fmaxf(c_, C1[r + 2]), C1[r + 3]); } \
        rm = __builtin_fmaxf(a_, c_); auto rr_ = __builtin_amdgcn_permlane32_swap(__float_as_uint(rm), __float_as_uint(rm), false, false); rm = __builtin_fmaxf(__uint_as_float(rr_[0]), __uint_as_float(rr_[1])); } while (0)
    f32x16 pA0, pA1, pB0, pB1;
    asm volatile("s_waitcnt vmcnt(4) lgkmcnt(0)\n\ts_barrier" ::: "memory");
    qkt(pA0, pA1, shm + P_K, qr, negm, r32, hi);
    MASKS(pA0, pA1, 0);
    unsigned onm = SELM(0);
    { float rm; ROWMAX(pA0, pA1, rm); if (MODE == M_SEL) rm = onm ? rm : NINF; REFUPD(pA0, pA1, rm); }
    int sk_next = 8192, sv_cur = 0, s_n2 = 16384, s_free = 24576;
    u32x4 pw0, pw1, pw2, pw3;
#define PINV(x) asm volatile("" : "+v"(x))
#define EX4(P, B) do { P[B] = __builtin_amdgcn_exp2f(P[B]); P[B + 1] = __builtin_amdgcn_exp2f(P[B + 1]); P[B + 2] = __builtin_amdgcn_exp2f(P[B + 2]); P[B + 3] = __builtin_amdgcn_exp2f(P[B + 3]); sacc += (P[B] + P[B + 1]) + (P[B + 2] + P[B + 3]); } while (0)
#define PKW2(P, B, PW, I) do { PW[I] = cvtpk_s(P[B], P[B + 1]) & onm; PW[I + 1] = cvtpk_s(P[B + 2], P[B + 3]) & onm; } while (0)
#define VFRAG(i, sv) __builtin_bit_cast(s16x4, __builtin_amdgcn_ds_read_tr16_b64_v4i16((LAS v4i16_t*)(vp0 + (sv) + (((i) >> 2) * 4096 + ((i) & 3) * 1024))))
#define VFRAGH(i, sv) __builtin_bit_cast(s16x4, __builtin_amdgcn_ds_read_tr16_b64_v4i16((LAS v4i16_t*)(vp0 + (sv) + (((i) >> 2) * 4096 + ((i) & 3) * 1024 + 512))))
#define VF8(lo, hi_) (bf16x8){lo[0], lo[1], lo[2], lo[3], hi_[0], hi_[1], hi_[2], hi_[3]}
#define PSTEP(C0, C1, P0, P1, t, HN) do { \
        if ((t) > 0) { if ((t) + 2 < NT) asm volatile("s_waitcnt vmcnt(2) lgkmcnt(0)\n\ts_barrier" ::: "memory"); else asm volatile("s_waitcnt vmcnt(0) lgkmcnt(0)\n\ts_barrier" ::: "memory"); }     \
        if ((t) + 3 < NT) DMA_KV((t) + 3, s_free); \
        float sacc = 0.f; bf16x8 kf_; \
          \
        if (HN) { kf_ = KFR(sk_next, 0); C0 = __builtin_amdgcn_mfma_f32_32x32x16_bf16(kf_, qr[0], negm, 0, 0, 0); } EX4(P0, 0);  PKW2(P0, 0, pw0, 0);  PINV(sacc); PINV(pw0); SBAR(); \
        if (HN) { kf_ = KFR(sk_next, 1); C1 = __builtin_amdgcn_mfma_f32_32x32x16_bf16(kf_, qr[0], negm, 0, 0, 0); } EX4(P0, 4);  PKW2(P0, 4, pw0, 2);  PINV(sacc); PINV(pw0); SBAR(); \
        if (HN) { kf_ = KFR(sk_next, 2); C0 = __builtin_amdgcn_mfma_f32_32x32x16_bf16(kf_, qr[1], C0, 0, 0, 0); }   EX4(P0, 8);  PKW2(P0, 8, pw1, 0);  PINV(sacc); PINV(pw1); SBAR(); \
        if (HN) { kf_ = KFR(sk_next, 3); C1 = __builtin_amdgcn_mfma_f32_32x32x16_bf16(kf_, qr[1], C1, 0, 0, 0); }   EX4(P0, 12); PKW2(P0, 12, pw1, 2); PINV(sacc); PINV(pw1); SBAR(); \
        if (HN) { kf_ = KFR(sk_next, 4); C0 = __builtin_amdgcn_mfma_f32_32x32x16_bf16(kf_, qr[2], C0, 0, 0, 0); }   EX4(P1, 0);  PKW2(P1, 0, pw2, 0);  PINV(sacc); PINV(pw2); SBAR(); \
        if (HN) { kf_ = KFR(sk_next, 5); C1 = __builtin_amdgcn_mfma_f32_32x32x16_bf16(kf_, qr[2], C1, 0, 0, 0); }   EX4(P1, 4);  PKW2(P1, 4, pw2, 2);  PINV(sacc); PINV(pw2); SBAR(); \
        if (HN) { kf_ = KFR(sk_next, 6); C0 = __builtin_amdgcn_mfma_f32_32x32x16_bf16(kf_, qr[3], C0, 0, 0, 0); }   EX4(P1, 8);  PKW2(P1, 8, pw3, 0);  PINV(sacc); PINV(pw3); SBAR(); \
        if (HN) { kf_ = KFR(sk_next, 7); C1 = __builtin_amdgcn_mfma_f32_32x32x16_bf16(kf_, qr[3], C1, 0, 0, 0); }   EX4(P1, 12); PKW2(P1, 12, pw3, 2); PINV(sacc); PINV(pw3); SBAR(); \
        l_reg += __uint_as_float(__float_as_uint(sacc) & onm); \
        unsigned onn_ = 0xffffffffu; float rm_ = NINF; \
        if (HN) { MASKS(C0, C1, (t) + 1); onn_ = SELM((t) + 1); } \
          \
        { s16x4 vl_, vh_; \
          vl_ = VFRAG(0, sv_cur); vh_ = VFRAGH(0, sv_cur); o[0] = __builtin_amdgcn_mfma_f32_32x32x16_bf16(__builtin_bit_cast(bf16x8, pw0), VF8(vl_, vh_), o[0], 0, 0, 0); SBAR(); \
          vl_ = VFRAG(4, sv_cur); vh_ = VFRAGH(4, sv_cur); o[1] = __builtin_amdgcn_mfma_f32_32x32x16_bf16(__builtin_bit_cast(bf16x8, pw0), VF8(vl_, vh_), o[1], 0, 0, 0); SBAR(); \
          vl_ = VFRAG(1, sv_cur); vh_ = VFRAGH(1, sv_cur); o[0] = __builtin_amdgcn_mfma_f32_32x32x16_bf16(__builtin_bit_cast(bf16x8, pw1), VF8(vl_, vh_), o[0], 0, 0, 0); SBAR(); \
          vl_ = VFRAG(5, sv_cur); vh_ = VFRAGH(5, sv_cur); o[1] = __builtin_amdgcn_mfma_f32_32x32x16_bf16(__builtin_bit_cast(bf16x8, pw1), VF8(vl_, vh_), o[1], 0, 0, 0); SBAR(); \
          if (HN) { ROWMAX(C0, C1, rm_); } \
          vl_ = VFRAG(2, sv_cur); vh_ = VFRAGH(2, sv_cur); o[0] = __builtin_amdgcn_mfma_f32_32x32x16_bf16(__builtin_bit_cast(bf16x8, pw2), VF8(vl_, vh_), o[0], 0, 0, 0); SBAR(); \
          vl_ = VFRAG(6, sv_cur); vh_ = VFRAGH(6, sv_cur); o[1] = __builtin_amdgcn_mfma_f32_32x32x16_bf16(__builtin_bit_cast(bf16x8, pw2), VF8(vl_, vh_), o[1], 0, 0, 0); SBAR(); \
          vl_ = VFRAG(3, sv_cur); vh_ = VFRAGH(3, sv_cur); o[0] = __builtin_amdgcn_mfma_f32_32x32x16_bf16(__builtin_bit_cast(bf16x8, pw3), VF8(vl_, vh_), o[0], 0, 0, 0); SBAR(); \
          vl_ = VFRAG(7, sv_cur); vh_ = VFRAGH(7, sv_cur); o[1] = __builtin_amdgcn_mfma_f32_32x32x16_bf16(__builtin_bit_cast(bf16x8, pw3), VF8(vl_, vh_), o[1], 0, 0, 0); SBAR(); } \
        if (HN) { if (MODE == M_SEL) rm_ = onn_ ? rm_ : NINF; REFUPD(C0, C1, rm_); } \
        onm = onn_; { const int f_ = sv_cur; sv_cur = sk_next; sk_next = s_n2; s_n2 = s_free; s_free = f_; } \
    } while (0)
    int t = 0;
#pragma unroll 1
    for (; t + 2 < NT; t += 2) { PSTEP(pB0, pB1, pA0, pA1, t, true); PSTEP(pA0, pA1, pB0, pB1, t + 1, true); }
    PSTEP(pB0, pB1, pA0, pA1, t, true); PSTEP(pA0, pA1, pB0, pB1, t + 1, false);
#undef PSTEP
#undef VF8
#undef VFRAG
#undef VFRAGH
#undef PKW2
#undef EX4
#undef PINV
#undef ROWMAX
#undef REFUPD
#undef MASKS
#undef KFR
#undef SELM
    int lane_e = (int)__builtin_amdgcn_mbcnt_hi(~0u, __builtin_amdgcn_mbcnt_lo(~0u, 0u)); asm volatile("" : "+v"(lane_e));
    const int r32e = lane_e & 31, hie = lane_e >> 5, qrele = wid * QBLK + r32e;
    { auto rr = __builtin_amdgcn_permlane32_swap(__float_as_uint(l_reg), __float_as_uint(l_reg), false, false); l_reg = __uint_as_float(rr[0]) + __uint_as_float(rr[1]); }
    if (MODE == M_SWA) l_reg += exp2f(T.sinks[h] * LOG2E - mhat);
    if (hie == 0) { float gate = 1.0f; if (MODE != M_SWA) gate = T.GN[(size_t)(rowbase + q0 + qrele) * 24 + h * 3 + (MODE == M_SEL ? 1 : 2)]; wsf[32 + r32e] = l_reg / gate; }
    asm volatile("s_waitcnt lgkmcnt(0)" ::: "memory");
    float rli[16];
#pragma unroll
    for (int r = 0; r < 16; ++r) rli[r] = __builtin_amdgcn_rcpf(wsf[32 + crow(r, hie)]);
    { bf16_t* Ow = T.OB + (rowbase + q0 + wid * QBLK) * 512 + h * 64; bf16_t* stg = (bf16_t*)(shm + P_OST) + wid * 2048;
#pragma unroll
      for (int r = 0; r < 16; ++r) { const int orow = crow(r, hie);
#pragma unroll
          for (int d0 = 0; d0 < 2; ++d0) stg[orow * 64 + d0 * 32 + r32e] = (bf16_t)f2bf(o[d0][r] * rli[r]); }
      asm volatile("s_waitcnt lgkmcnt(0)" ::: "memory");
#pragma unroll
      for (int i = 0; i < 4; ++i) { const int row = i * 8 + (lane_e >> 3), ch = lane_e & 7; const u32x4 v = *(const u32x4*)(stg + row * 64 + ch * 8); *(u32x4*)(Ow + (long)row * 512 + ch * 8) = v; } }
    asm volatile("s_waitcnt vmcnt(0) lgkmcnt(0)\n\ts_barrier" ::: "memory");
#undef DMA_KV
}
#undef SBAR
#undef WAIT_BAR
}

__device__ __forceinline__ void phase_attn_fast(Frame& F, char* lds_generic) {
    unsigned char* ws = F.ws;
    const int vcu = (F.G % 8 == 0) ? (F.bid % 8) * (F.G / 8) + F.bid / 8 : F.bid;
    att::Tens Ts{(const bf16_t*)(ws + WS_QR), kv_tensor(ws, 2), kv_tensor(ws, 3), (const unsigned*)(ws + WS_SEL), (const float*)(ws + WS_GN), (bf16_t*)(ws + WS_OSEL), F.in[I_SINK]};
    att::Tens Tw = Ts; Tw.K = kv_tensor(ws, 4); Tw.V = kv_tensor(ws, 5); Tw.OB = (bf16_t*)(ws + WS_OWIN);
    const int cls = (F.bid >> 3) & 3;
    for (int v = vcu; v < 256; v += F.G) {
        const int bh = v >> 4, s = v & 15, b = bh >> 3, h = bh & 7;
#pragma unroll 1
        for (int step = 0; step < 4; ++step) { const int qb = step < 2 ? 31 - s : s;
            if ((step & 1) == 0) att::attn_unit_p<att::M_SEL, 8>(b, h, qb, Ts, lds_generic);
            else { att::attn_unit<att::M_WIN, 8>(b, h, qb, Tw, lds_generic);
            { const float* OC = (const float*)(ws + WS_OF32); const bf16_t* OS = (const bf16_t*)(ws + WS_OSEL); const bf16_t* OW = (const bf16_t*)(ws + WS_OWIN); bf16_t* ON = (bf16_t*)(ws + WS_ONSA);
              for (int e = F.tid; e < 256 * 16; e += NTHREADS) { const size_t idx = ((size_t)b * SEQ + qb * 256 + (e >> 4)) * 512 + h * 64 + (e & 15) * 4;
                  const f32x4 c = *(const f32x4*)(OC + idx); const u32x2 a = *(const u32x2*)(OS + idx), w = *(const u32x2*)(OW + idx);
                  u32x2 r; r.x = pk2(c.x + __uint_as_float(a.x << 16) + __uint_as_float(w.x << 16), c.y + __uint_as_float(a.x & 0xffff0000u) + __uint_as_float(w.x & 0xffff0000u));
                  r.y = pk2(c.z + __uint_as_float(a.y << 16) + __uint_as_float(w.y << 16), c.w + __uint_as_float(a.y & 0xffff0000u) + __uint_as_float(w.y & 0xffff0000u));
                  *(u32x2*)(ON + idx) = r; } } }
            if (cls == step) { __syncthreads(); phase_prologue<1>(F); phase_prologue<2>(F); __syncthreads(); }
        }
    }
}

namespace cmpa {
using att::f32x16; using att::crow;
constexpr int C_K = 0, C_V = 65536, C_IMP = C_V + 16384, C_BYTES = C_IMP + 8 * 4096;
__device__ __forceinline__ u32x4 load_k(const bf16_t* Kg, int tau, int wid, int lane) { return *(const u32x4*)(Kg + (size_t)(64 * tau + lane) * 64 + wid * 8); }
__device__ __forceinline__ u32x4 load_v(const bf16_t* Vg, int tau, int wid, int lane) { return *(const u32x4*)(Vg + (size_t)(64 * tau + 16 * (wid & 3) + (lane >> 2)) * 64 + (wid >> 2) * 32 + (lane & 3) * 8); }
__device__ __forceinline__ float qx1(float v) { return __builtin_bit_cast(float, __builtin_amdgcn_mov_dpp(__builtin_bit_cast(int, v), 0xB1, 0xF, 0xF, true)); }
__device__ __forceinline__ float qx2(float v) { return __builtin_bit_cast(float, __builtin_amdgcn_mov_dpp(__builtin_bit_cast(int, v), 0x4E, 0xF, 0xF, true)); }
__device__ __forceinline__ void cmp_unit(int bg, int qb, unsigned char* ws, char* shm) {
    const int tid = threadIdx.x, lane = tid & 63, r32 = lane & 31, hi = lane >> 5; const int wid = __builtin_amdgcn_readfirstlane(tid >> 6);
    const int b = bg >> 1, g = bg & 1, ql = r32 >> 2, hh = r32 & 3;
    const int s = qb * 64 + wid * 8 + ql; const size_t tok = (size_t)b * SEQ + s;
    const int cmax = s < 31 ? -1 : (s - 31) >> 4;
    const int ntile = (4 * qb + 2) / 64 + 1;
    const bf16_t* Kg = (const bf16_t*)(ws + WS_KCMP) + (size_t)bg * 512 * 64; const bf16_t* Vg = (const bf16_t*)(ws + WS_VCMP) + (size_t)bg * 512 * 64;
    const unsigned lds0 = (unsigned)(uintptr_t)shm;
    float* IMPW = (float*)(shm + C_IMP) + wid * 1024;
    const float NINF = -__builtin_inff();
    __syncthreads();
    { u32x4 kt[8];
#pragma unroll
      for (int tau = 0; tau < 8; ++tau) if (tau < ntile) kt[tau] = load_k(Kg, tau, wid, lane);
#pragma unroll
      for (int tau = 0; tau < 8; ++tau) if (tau < ntile) *(u32x4*)(shm + C_K + tau * 8192 + wid * 1024 + lane * 16) = kt[tau]; }
    u32x4 vnext = load_v(Vg, 0, wid, lane);
    bf16x8 qr[4];
    { const bf16_t* qp = (const bf16_t*)(ws + WS_QC) + tok * 512 + (4 * g + hh) * 64 + hi * 8;
#pragma unroll
      for (int d0 = 0; d0 < 4; ++d0) qr[d0] = *(const bf16x8*)(qp + d0 * 16); }
#pragma unroll
    for (int i = 0; i < 16; ++i) IMPW[i * 64 + lane] = 0.f;
    f32x16 zero16 = f32x16{};
    __syncthreads();
    float m = NINF, l = 0.f;
#pragma unroll 1
    for (int tau = 0; tau < ntile; ++tau) {
        f32x16 p0, p1; att::qkt(p0, p1, shm + C_K + tau * 8192, qr, zero16, r32, hi);
        const int kb = 64 * tau + 4 * hi; float rm = NINF;
#pragma unroll
        for (int r = 0; r < 16; ++r) { const int c = kb + (r & 3) + 8 * (r >> 2); p0[r] = (c <= cmax) ? p0[r] : NINF; p1[r] = (c + 32 <= cmax) ? p1[r] : NINF; rm = fmaxf(rm, fmaxf(p0[r], p1[r])); }
        { auto rr = __builtin_amdgcn_permlane32_swap(__float_as_uint(rm), __float_as_uint(rm), false, false); rm = fmaxf(__uint_as_float(rr[0]), __uint_as_float(rr[1])); }
        const float mn = fmaxf(m, rm);
        if (mn > NINF) { float sacc = 0.f;
#pragma unroll
            for (int r = 0; r < 16; ++r) sacc += __builtin_amdgcn_exp2f(p0[r] - mn) + __builtin_amdgcn_exp2f(p1[r] - mn);
            l = l * __builtin_amdgcn_exp2f(m - mn) + sacc; m = mn; }
    }
    { auto rr = __builtin_amdgcn_permlane32_swap(__float_as_uint(l), __float_as_uint(l), false, false); l = __uint_as_float(rr[0]) + __uint_as_float(rr[1]); }
    const float rl = l > 0.f ? 1.0f / l : 0.f; const float mf = m > NINF ? m : 0.f;
    f32x16 o[2]; o[0] = f32x16{}; o[1] = f32x16{};
    const int vb0 = (int)(lds0 + C_V) + ((lane >> 4) & 1) * 32 + (lane & 3) * 8 + (4 * hi + ((lane & 15) >> 2)) * 64;
#pragma unroll 1
    for (int tau = 0; tau < ntile; ++tau) {
        const int vslot = (tau & 1) * 8192;
        *(u32x4*)(shm + C_V + vslot + wid * 1024 + lane * 16) = vnext;
        if (tau + 1 < ntile) vnext = load_v(Vg, tau + 1, wid, lane);
        __syncthreads();
        f32x16 p0, p1; att::qkt(p0, p1, shm + C_K + tau * 8192, qr, zero16, r32, hi);
        const int kb = 64 * tau + 4 * hi;
#pragma unroll
        for (int r = 0; r < 16; ++r) { const int c = kb + (r & 3) + 8 * (r >> 2); p0[r] = (c <= cmax) ? __builtin_amdgcn_exp2f(p0[r] - mf) * rl : 0.f; p1[r] = (c + 32 <= cmax) ? __builtin_amdgcn_exp2f(p1[r] - mf) * rl : 0.f; }
        float G[8], L[8];
#pragma unroll
        for (int k = 0; k < 4; ++k) { G[k] = (p0[4 * k] + p0[4 * k + 1]) + (p0[4 * k + 2] + p0[4 * k + 3]); L[k] = p0[4 * k + 3]; G[4 + k] = (p1[4 * k] + p1[4 * k + 1]) + (p1[4 * k + 2] + p1[4 * k + 3]); L[4 + k] = p1[4 * k + 3]; }
#pragma unroll
        for (int k = 0; k < 8; ++k) { G[k] += qx1(G[k]); G[k] += qx2(G[k]); L[k] += qx1(L[k]); L[k] += qx2(L[k]); }
        if (hh == 0) {
#pragma unroll
            for (int k = 0; k < 8; ++k) { const int j = 16 * tau + (k < 4 ? 2 * k + hi : 8 + 2 * (k - 4) + hi); IMPW[ql * 128 + j] += G[k]; } }
        WSYNC();
        if (hh == 0) {
#pragma unroll
            for (int k = 0; k < 8; ++k) { const int j = 16 * tau + (k < 4 ? 2 * k + hi : 8 + 2 * (k - 4) + hi) + 1; if (j < NSEL) IMPW[ql * 128 + j] += L[k]; } }
        WSYNC();
        u32x4 pw0, pw1, pw2, pw3;
        pw0 = (u32x4){att::cvtpk_s(p0[0], p0[1]), att::cvtpk_s(p0[2], p0[3]), att::cvtpk_s(p0[4], p0[5]), att::cvtpk_s(p0[6], p0[7])};
        pw1 = (u32x4){att::cvtpk_s(p0[8], p0[9]), att::cvtpk_s(p0[10], p0[11]), att::cvtpk_s(p0[12], p0[13]), att::cvtpk_s(p0[14], p0[15])};
        pw2 = (u32x4){att::cvtpk_s(p1[0], p1[1]), att::cvtpk_s(p1[2], p1[3]), att::cvtpk_s(p1[4], p1[5]), att::cvtpk_s(p1[6], p1[7])};
        pw3 = (u32x4){att::cvtpk_s(p1[8], p1[9]), att::cvtpk_s(p1[10], p1[11]), att::cvtpk_s(p1[12], p1[13]), att::cvtpk_s(p1[14], p1[15])};
        __builtin_amdgcn_sched_barrier(0);
        att::pv(o, vb0 + vslot, __builtin_bit_cast(bf16x8, pw0), __builtin_bit_cast(bf16x8, pw1), __builtin_bit_cast(bf16x8, pw2), __builtin_bit_cast(bf16x8, pw3));
    }
    { const float* GN = (const float*)(ws + WS_GN); float* OF = (float*)(ws + WS_OF32);
#pragma unroll
      for (int r = 0; r < 16; ++r) { const int row = crow(r, hi), q2 = row >> 2, h2 = row & 3; const size_t t2 = (size_t)b * SEQ + qb * 64 + wid * 8 + q2;
          const float g0 = GN[t2 * 24 + (4 * g + h2) * 3];
          OF[t2 * 512 + (4 * g + h2) * 64 + r32] = o[0][r] * g0; OF[t2 * 512 + (4 * g + h2) * 64 + 32 + r32] = o[1][r] * g0; } }
    WSYNC();
    const int cur = qb; const unsigned long long lt = (lane == 0) ? 0ull : (~0ull >> (64 - lane));
    unsigned k0[8], k1[8], T[8];
#pragma unroll
    for (int q = 0; q < 8; ++q) {
        float v0 = IMPW[q * 128 + lane], v1 = IMPW[q * 128 + 64 + lane];
        { const int j0 = lane, j1 = lane + 64;
          if (j0 > cur) v0 = -1.0f; else if (j0 == 0 || j0 == cur || j0 == cur - 1) v0 = 1e6f;
          if (j1 > cur) v1 = -1.0f; else if (j1 == cur || j1 == cur - 1) v1 = 1e6f; }
        const unsigned u0 = __float_as_uint(v0), u1 = __float_as_uint(v1);
        k0[q] = (u0 & 0x80000000u) ? ~u0 : (u0 | 0x80000000u); k1[q] = (u1 & 0x80000000u) ? ~u1 : (u1 | 0x80000000u); T[q] = 0u;
    }
#pragma unroll 1
    for (int bit = 31; bit >= 0; --bit) {
#pragma unroll
        for (int q = 0; q < 8; ++q) { const unsigned cand = T[q] | (1u << bit); const int cnt = __popcll(__ballot(k0[q] >= cand)) + __popcll(__ballot(k1[q] >= cand)); T[q] = (cnt >= 16) ? cand : T[q]; }
    }
#pragma unroll
    for (int q = 0; q < 8; ++q) {
        const bool gt0 = k0[q] > T[q], gt1 = k1[q] > T[q], eq0 = k0[q] == T[q], eq1 = k1[q] == T[q];
        const int need = 16 - (__popcll(__ballot(gt0)) + __popcll(__ballot(gt1)));
        const unsigned long long be0 = __ballot(eq0), be1 = __ballot(eq1);
        const bool s0 = (gt0 || (eq0 && __popcll(be0 & lt) < need)) && (lane <= cur);
        const bool s1 = (gt1 || (eq1 && (__popcll(be0) + __popcll(be1 & lt)) < need)) && (lane + 64 <= cur);
        const unsigned long long m0 = __ballot(s0), m1 = __ballot(s1);
        if (lane == 0) { u32x4 w; w.x = (unsigned)m0; w.y = (unsigned)(m0 >> 32); w.z = (unsigned)m1; w.w = (unsigned)(m1 >> 32); *(u32x4*)(ws + WS_SEL + ((size_t)bg * SEQ + qb * 64 + wid * 8 + q) * 16) = w; }
    }
    WSYNC();
}
}
__device__ __forceinline__ void phase_cmp_attn(Frame& F, char* lds_generic) {
    const int vcu = (F.G % 8 == 0) ? (F.bid % 8) * (F.G / 8) + F.bid / 8 : F.bid;
    for (int v = vcu; v < 256; v += F.G) { const int bg = v >> 6, sidx = v & 63;
        cmpa::cmp_unit(bg, 127 - sidx, F.ws, lds_generic);
        cmpa::cmp_unit(bg, sidx, F.ws, lds_generic); }
}

__device__ __forceinline__ void phase_cmp_swa(Frame& F, char* lds_generic) {
    unsigned char* ws = F.ws;
    att::Tens Ta{(const bf16_t*)(ws + WS_QS), kv_tensor(ws, 6), kv_tensor(ws, 7), (const unsigned*)(ws + WS_SEL), (const float*)(ws + WS_GN), (bf16_t*)(ws + WS_OSWA), F.in[I_SINK]};
    const int ncmp = F.G >= 64 ? 32 : 0;
    if (F.bid < ncmp || ncmp == 0) {
        for (int u = F.bid; u < 32; u += (ncmp ? ncmp : F.G)) {
            cmp1_unit(F, u);
            VM_WAIT(); __syncthreads();
            if (F.tid == 0) { __builtin_amdgcn_fence(__ATOMIC_ACQUIRE, "agent"); VM_WAIT(); }
            __syncthreads();
            cmp2_unit(F, u);
        }
    }
    if (F.bid >= ncmp) {
        const int nw = F.G - ncmp;
        for (int v = F.bid - ncmp; v < 512; v += nw) { const int bh = v >> 5, qb = v & 31; att::attn_unit<att::M_SWA, 8>(bh >> 3, bh & 7, qb, Ta, lds_generic); }
    }
}

__device__ __forceinline__ void phase_branch(Frame& F) {
    static_assert(WS_OSWA - WS_ONSA == (size_t)NTOK * 512 * 2 && WS_WBRS - WS_WBRN == (size_t)1024 * 512 * 2, "SWA operands stacked right behind the NSA ones");
    pg8::Gemm g{(const bf16_t*)(F.ws + WS_ONSA), (const bf16_t*)(F.ws + WS_WBRN), 2 * NTOK, 2 * 1024, 512};
    pg8::BranchOrder S; S.so.init(NTOK, 1024, F.G, F.bid);
    pg8::EpiBranch E{(const unsigned char*)(F.ws + WS_GM), (bf16_t*)(F.ws + WS_MIXED)};
    pg8::gemm_phase<pg8::EpiBranch, pg8::BranchOrder, true, true>(F.lds, g, S, E);
}

__device__ __forceinline__ void phase_wout(Frame& F) {
    pg8::Gemm g{(const bf16_t*)(F.ws + WS_MIXED), (const bf16_t*)(F.ws + WS_WOUT), NTOK, 1024, 1024};
    pg8::StaticOrder S; S.init(NTOK, 1024, F.G, F.bid);
    pg8::EpiResid E{F.in[I_X], (bf16_t*)(F.ws + WS_ZB)};
    pg8::gemm_phase<pg8::EpiResid, pg8::StaticOrder, true, true>(F.lds, g, S, E);
}

constexpr int WRP_LD = 33;
__device__ __forceinline__ void phase_ln_route(Frame& F) {
    bf16_t* const HB16 = (bf16_t*)(F.ws + WS_HB16); bf16_t* const HBOUT = (bf16_t*)(F.ws + WS_HB);
    unsigned char* ws = F.ws;
    LAS float* WRP = (LAS float*)F.lds;
    LAS float* LG = (LAS float*)(F.lds + 1024 * WRP_LD * 4);
    const int lane = F.lane;
    const float* G1 = F.in[I_LN1G]; const float* B1 = F.in[I_LN1B]; const float* BR = F.in[I_BR];
    LAS float* STAT = (LAS float*)(F.lds + 143872);
    { const float* src = F.in[I_WR]; const int e = F.tid & 31, part = F.tid >> 5; float a1 = 0.f, a2 = 0.f;
#pragma unroll 8
      for (int j = 0; j < 64; ++j) { const int k = part + 16 * j; const float w = src[k * 32 + e], gw = w * G1[k]; WRP[k * WRP_LD + e] = gw; a1 += gw; a2 += w * B1[k]; }
      LG[part * 32 + e] = a1; LG[512 + part * 32 + e] = a2; }
    __syncthreads();
    if (F.tid < 64) { const int e = F.tid & 31, wh = F.tid >> 5; float sacc = 0.f;
#pragma unroll
        for (int p2 = 0; p2 < 16; ++p2) sacc += LG[wh * 512 + p2 * 32 + e];
        STAT[128 + wh * 32 + e] = sacc; }
    __syncthreads();
    gu32* ctl = (gu32*)(ws + WS_CTL);
    int* TOPE = (int*)(ws + WS_TOPE); float* TOPG = (float*)(ws + WS_TOPG); int* TOPP = (int*)(ws + WS_TOPP); int* TOK = (int*)(ws + WS_TOK);
    for (int tb = F.bid; tb < NTOK / 64; tb += F.G) {
        for (int i = 0; i < 8; ++i) {
            const int t = tb * 64 + F.wave * 8 + i;
            const bf16_t* zr = (const bf16_t*)(ws + WS_ZB) + (size_t)t * 1024;
            f32x4 v[4]; float s = 0.f;
#pragma unroll
            for (int j2 = 0; j2 < 2; ++j2) { const u32x4 w = *(const u32x4*)(zr + 8 * (lane + 64 * j2));
                v[2 * j2] = (f32x4){__uint_as_float(w.x << 16), __uint_as_float(w.x & 0xffff0000u), __uint_as_float(w.y << 16), __uint_as_float(w.y & 0xffff0000u)};
                v[2 * j2 + 1] = (f32x4){__uint_as_float(w.z << 16), __uint_as_float(w.z & 0xffff0000u), __uint_as_float(w.w << 16), __uint_as_float(w.w & 0xffff0000u)}; }
#pragma unroll
            for (int j = 0; j < 4; ++j) s += (v[j].x + v[j].y) + (v[j].z + v[j].w);
            const float mean = wave_sum(s) * (1.0f / 1024.0f); float s2 = 0.f;
#pragma unroll
            for (int j = 0; j < 4; ++j) { v[j] = v[j] - mean; s2 += (v[j].x * v[j].x + v[j].y * v[j].y) + (v[j].z * v[j].z + v[j].w * v[j].w); }
            const float rstd = 1.0f / sqrtf(wave_sum(s2) * (1.0f / 1024.0f) + LN_EPS);
            if (lane == 0) { STAT[F.wave * 8 + i] = mean; STAT[64 + F.wave * 8 + i] = rstd; }
#pragma unroll
            for (int j2 = 0; j2 < 2; ++j2) { const int c0 = 8 * (lane + 64 * j2); f32x4 h[2];
#pragma unroll
                for (int q = 0; q < 2; ++q) { const f32x4 gg = *(const f32x4*)(G1 + c0 + 4 * q), bb = *(const f32x4*)(B1 + c0 + 4 * q); h[q] = v[2 * j2 + q] * rstd * gg + bb; }
                *(u32x4*)(HB16 + (size_t)t * 1024 + c0) = pg8::pack8(h[0], h[1]);
                u32x2 w8;
                w8.x = f4_to_fp8(fminf(fmaxf(h[0].x, -448.f), 448.f), fminf(fmaxf(h[0].y, -448.f), 448.f), fminf(fmaxf(h[0].z, -448.f), 448.f), fminf(fmaxf(h[0].w, -448.f), 448.f));
                w8.y = f4_to_fp8(fminf(fmaxf(h[1].x, -448.f), 448.f), fminf(fmaxf(h[1].y, -448.f), 448.f), fminf(fmaxf(h[1].z, -448.f), 448.f), fminf(fmaxf(h[1].w, -448.f), 448.f));
                *(u32x2*)((unsigned char*)HBOUT + (size_t)t * 1024 + c0) = w8; }
        }
        __syncthreads();
        { const int tg = F.wave >> 1, eh = F.wave & 1, kk = lane >> 4, n = lane & 15;
          const bf16_t* zrow = (const bf16_t*)(ws + WS_ZB) + (size_t)(tb * 64 + tg * 16 + n) * 1024 + 4 * kk;
          const LAS float* wcol = WRP + (4 * kk) * WRP_LD + eh * 16 + n;
          f32x4 acc = (f32x4){0.f, 0.f, 0.f, 0.f};
#pragma unroll 4
          for (int s4 = 0; s4 < 64; ++s4) { const u32x2 zw = *(const u32x2*)(zrow + 16 * s4); const f32x4 a = {__uint_as_float(zw.x << 16), __uint_as_float(zw.x & 0xffff0000u), __uint_as_float(zw.y << 16), __uint_as_float(zw.y & 0xffff0000u)}; const LAS float* wp = wcol + 16 * s4 * WRP_LD;
              acc = __builtin_amdgcn_mfma_f32_16x16x4f32(a.x, wp[0], acc, 0, 0, 0);
              acc = __builtin_amdgcn_mfma_f32_16x16x4f32(a.y, wp[WRP_LD], acc, 0, 0, 0);
              acc = __builtin_amdgcn_mfma_f32_16x16x4f32(a.z, wp[2 * WRP_LD], acc, 0, 0, 0);
              acc = __builtin_amdgcn_mfma_f32_16x16x4f32(a.w, wp[3 * WRP_LD], acc, 0, 0, 0); }
          const int ee = eh * 16 + n; const float br = BR[ee] + STAT[160 + ee], c1 = STAT[128 + ee];
#pragma unroll
          for (int r = 0; r < 4; ++r) { const int tt = tg * 16 + 4 * kk + r; LG[tt * WRP_LD + ee] = STAT[64 + tt] * (acc[r] - STAT[tt] * c1) + br; } }
        __syncthreads();
        LAS int* lcnt = (LAS int*)(LG + 64 * WRP_LD); LAS int* lbase = lcnt + 32;
        if (F.tid < 32) lcnt[F.tid] = 0;
        __syncthreads();
        int be[4], lpos[4]; float gk[4];
        if (F.tid < 64) {
            float lg[32];
#pragma unroll
            for (int e = 0; e < 32; ++e) lg[e] = LG[F.tid * WRP_LD + e];
            float bv[4];
#pragma unroll
            for (int k = 0; k < 4; ++k) { float best = -__builtin_inff(); int bi = 0;
#pragma unroll
                for (int e = 0; e < 32; ++e) if (lg[e] > best) { best = lg[e]; bi = e; }
                be[k] = bi; bv[k] = best;
#pragma unroll
                for (int e = 0; e < 32; ++e) if (e == bi) lg[e] = -__builtin_inff(); }
            const float e1 = __expf(bv[1] - bv[0]), e2 = __expf(bv[2] - bv[0]), e3 = __expf(bv[3] - bv[0]); const float rs = 1.0f / (1.0f + e1 + e2 + e3);
            gk[0] = rs; gk[1] = e1 * rs; gk[2] = e2 * rs; gk[3] = e3 * rs;
#pragma unroll
            for (int k = 0; k < 4; ++k) lpos[k] = __hip_atomic_fetch_add(lcnt + be[k], 1, __ATOMIC_RELAXED, __HIP_MEMORY_SCOPE_WORKGROUP);
        }
        __syncthreads();
        if (F.tid < 32) { const int c = lcnt[F.tid]; lbase[F.tid] = (c > 0) ? (int)__hip_atomic_fetch_add(ctl + CW_CNT + 64 * F.tid, (unsigned)c, RLX_AGENT) : 0; }
        __syncthreads();
        if (F.tid < 64) { const int t = tb * 64 + F.tid;
#pragma unroll
            for (int k = 0; k < 4; ++k) { const int pos = lbase[be[k]] + lpos[k];
                TOK[be[k] * NTOK + pos] = t; TOPE[t * 4 + k] = be[k]; TOPP[t * 4 + k] = pos; TOPG[t * 4 + k] = gk[k]; } }
        __syncthreads();
    }
}

constexpr int EMAP_OFF = 131072;
__device__ __forceinline__ void load_expert_map(Frame& F, LAS int* cnt_s, LAS int* base_s) {
    if (F.tid < NEXP) cnt_s[F.tid] = (int)__hip_atomic_load((gu32*)(F.ws + WS_CTL) + CW_CNT + 64 * F.tid, RLX_AGENT);
    __syncthreads();
    if (F.tid == 0) { int acc = 0; for (int e = 0; e < NEXP; ++e) { base_s[e] = acc; acc += (cnt_s[e] + MOE_RT - 1) / MOE_RT; } base_s[NEXP] = acc; }
    __syncthreads();
    if (F.tid < base_s[NEXP]) { int e = 0;
#pragma unroll 1
        for (int k = 1; k < NEXP; ++k) if (base_s[k] <= F.tid) e = k;
        base_s[64 + F.tid] = e; }
    __syncthreads();
}
__device__ __forceinline__ void phase_expert_up(Frame& F) {
    LAS int* cnt_s = (LAS int*)(F.lds + EMAP_OFF); LAS int* base_s = cnt_s + 64;
    load_expert_map(F, cnt_s, base_s);
    const int ntiles = base_s[NEXP];
    pg8::Gemm g{(const bf16_t*)(F.ws + WS_HB), (const bf16_t*)(F.ws + WS_WEIN), ntiles * 256, NEXP * 2048, 512, (const unsigned char*)(F.ws + WS_SC1)};
    pg8::ExpertOrder<true> S{base_s, ntiles, 8, F.G, F.bid, cnt_s, (const int*)(F.ws + WS_TOK)};
    pg8::EpiSwiGLU E{F.in[I_BEIN], (unsigned char*)(F.ws + WS_ACT)};
    pg8::gemm_phase<pg8::EpiSwiGLU, pg8::ExpertOrder<true>, true, true, true, false>(F.lds, g, S, E);
}
__device__ __forceinline__ void phase_expert_down(Frame& F) {
    LAS int* cnt_s = (LAS int*)(F.lds + EMAP_OFF); LAS int* base_s = cnt_s + 64;
    load_expert_map(F, cnt_s, base_s);
    const int ntiles = base_s[NEXP];
    pg8::Gemm g{(const bf16_t*)(F.ws + WS_ACT), (const bf16_t*)(F.ws + WS_WEOUT), ntiles * 256, NEXP * 1024, 512, (const unsigned char*)(F.ws + WS_SC2)};
    pg8::ExpertOrder<false> S{base_s, ntiles, 4, F.G, F.bid, cnt_s, nullptr};
    pg8::EpiDown E{F.in[I_BEOUT], (bf16_t*)(F.ws + WS_YS)};
    pg8::gemm_phase<pg8::EpiDown, pg8::ExpertOrder<false>, true, true, true, false>(F.lds, g, S, E);
}

__device__ __forceinline__ void phase_final(Frame& F) {
    float* const OUTP = F.out;
    unsigned char* ws = F.ws;
    LAS int* cnt_s = (LAS int*)(F.lds + EMAP_OFF); LAS int* base_s = cnt_s + 64;
    load_expert_map(F, cnt_s, base_s);
    const int lane = F.lane, gw = F.bid * NWAVES + F.wave, NGW = F.G * NWAVES;
    const int* TOPE = (const int*)(ws + WS_TOPE); const float* TOPG = (const float*)(ws + WS_TOPG); const int* TOPP = (const int*)(ws + WS_TOPP);
    const bf16_t* YS = (const bf16_t*)(ws + WS_YS); const float* G2 = F.in[I_LN2G]; const float* B2 = F.in[I_LN2B];
    const unsigned char* YS8 = (const unsigned char*)YS;
    for (int t = gw; t < NTOK; t += NGW) {
        const bf16_t* hr = (const bf16_t*)(ws + WS_HB16) + (size_t)t * 1024;
        f32x4 v[4];
#pragma unroll
        for (int j = 0; j < 4; ++j) { const u32x2 hw = *(const u32x2*)(hr + 4 * (lane + 64 * j)); v[j] = (f32x4){__uint_as_float(hw.x << 16), __uint_as_float(hw.x & 0xffff0000u), __uint_as_float(hw.y << 16), __uint_as_float(hw.y & 0xffff0000u)} * DN_ALPHA; }
#pragma unroll
        for (int k = 0; k < 4; ++k) { const int e = TOPE[t * 4 + k]; const float g = TOPG[t * 4 + k] * 0.0625f; const size_t row = (size_t)base_s[e] * MOE_RT + TOPP[t * 4 + k];
#pragma unroll
            for (int j = 0; j < 4; ++j) { const int w = (int)*(const unsigned*)(YS8 + row * 1024 + 4 * (lane + 64 * j));
                v[j].x += g * __builtin_amdgcn_cvt_f32_fp8(w, 0); v[j].y += g * __builtin_amdgcn_cvt_f32_fp8(w, 1); v[j].z += g * __builtin_amdgcn_cvt_f32_fp8(w, 2); v[j].w += g * __builtin_amdgcn_cvt_f32_fp8(w, 3); } }
        float s = 0.f;
#pragma unroll
        for (int j = 0; j < 4; ++j) s += (v[j].x + v[j].y) + (v[j].z + v[j].w);
        const float mean = wave_sum(s) * (1.0f / 1024.0f); float s2 = 0.f;
#pragma unroll
        for (int j = 0; j < 4; ++j) { v[j] = v[j] - mean; s2 += (v[j].x * v[j].x + v[j].y * v[j].y) + (v[j].z * v[j].z + v[j].w * v[j].w); }
        const float rstd = 1.0f / sqrtf(wave_sum(s2) * (1.0f / 1024.0f) + LN_EPS);
#pragma unroll
        for (int j = 0; j < 4; ++j) { const int c0 = 4 * (lane + 64 * j); const f32x4 gg = *(const f32x4*)(G2 + c0), bb = *(const f32x4*)(B2 + c0); *(f32x4*)(OUTP + (size_t)t * 1024 + c0) = v[j] * rstd * gg + bb; }
    }
}

constexpr int N_PHASES = 11;
__global__ void __launch_bounds__(NTHREADS, 2) mk_fwd(Args args) {
    extern __shared__ __attribute__((aligned(16))) unsigned char lds_raw[];
    Frame F;
    F.lds = (LAS unsigned char*)lds_raw; F.ws = args.ws; F.in = args.in; F.out = args.out;
    F.tid = threadIdx.x; F.lane = F.tid & 63; F.wave = __builtin_amdgcn_readfirstlane(F.tid >> 6); F.G = gridDim.x; F.bid = blockIdx.x;
    volatile LAS unsigned* MISC = (volatile LAS unsigned*)(F.lds + MISC_OFF);
    if (F.tid < 64) MISC[F.tid] = 0u;
    __syncthreads();
    const int lo = args.ph_lo, hi = args.ph_hi;
    XcdBarrier bar; bar.bar = (unsigned*)(args.ws + WS_CTL) + CW_BAR; bar.x = 0; bar.st = nullptr;
    if (hi - lo > 1) bar = xcd_barrier_post((unsigned*)(args.ws + WS_CTL) + CW_BAR, MISC + 8);
#define IN(k) (lo <= (k) && (k) < hi)
#define SEAM(k) do { if (IN(k) && IN((k) + 1)) xcd_barrier(bar); } while (0)
    if (IN(0)) { phase_prologue<0>(F); SEAM(0); }
    if (IN(1)) { phase_inproj(F); SEAM(1); }
    if (IN(2)) { phase_cmp_swa(F, (char*)lds_raw); SEAM(2); }
    if (IN(3)) { phase_cmp_attn(F, (char*)lds_raw); SEAM(3); }
    if (IN(4)) { phase_attn_fast(F, (char*)lds_raw); SEAM(4); }
    if (IN(5)) { phase_branch(F); SEAM(5); }
    if (IN(6)) { phase_wout(F); SEAM(6); }
    if (IN(7)) { phase_ln_route(F); SEAM(7); }
    if (IN(8)) { phase_expert_up(F); SEAM(8); }
    if (IN(9)) { phase_expert_down(F); SEAM(9); }
    if (IN(10)) { phase_final(F); }
#undef IN
#undef SEAM
}

extern "C" void kernel_launch(void* const* d_in, const int* in_sizes, int n_in, void* d_out, int out_size, void* d_ws, size_t ws_size, hipStream_t stream) {
    static int grid = 0;
    if (grid == 0) {
        if (n_in != N_IN || out_size != NTOK * DM || ws_size < WS_END) { fprintf(stderr, "kernel_launch: unexpected shapes (n_in %d, out %d, ws %zu)\n", n_in, out_size, ws_size); grid = -1; return; }
        int dev = 0, cus = 0;
        if (hipGetDevice(&dev) != hipSuccess || hipDeviceGetAttribute(&cus, hipDeviceAttributeMultiprocessorCount, dev) != hipSuccess) { grid = -1; return; }
        if (hipFuncSetAttribute((const void*)mk_fwd, hipFuncAttributeMaxDynamicSharedMemorySize, LDS_BYTES) != hipSuccess) { fprintf(stderr, "kernel_launch: hipFuncSetAttribute failed\n"); grid = -1; return; }
        int per_cu = 0;
        if (hipOccupancyMaxActiveBlocksPerMultiprocessor(&per_cu, (const void*)mk_fwd, NTHREADS, LDS_BYTES) != hipSuccess || per_cu < 1) { fprintf(stderr, "kernel_launch: occupancy query says %d\n", per_cu); }
        (void)hipGetLastError();
        grid = cus;
    }
    if (grid < 0) return;
    (void)hipMemsetAsync((char*)d_ws + WS_CTL, 0, CTL_ZERO_BYTES, stream);
    Args a{};
    for (int i = 0; i < N_IN; ++i) a.in[i] = (const float*)d_in[i];
    a.out = (float*)d_out; a.ws = (unsigned char*)d_ws;
#if MK_ONE_LAUNCH
    a.ph_lo = 0; a.ph_hi = N_PHASES;
    hipLaunchKernelGGL(mk_fwd, dim3(grid), dim3(NTHREADS), LDS_BYTES, stream, a);
#else
    for (int p = 0; p < N_PHASES; ++p) { a.ph_lo = p; a.ph_hi = p + 1; hipLaunchKernelGGL(mk_fwd, dim3(grid), dim3(NTHREADS), LDS_BYTES, stream, a); }
#endif
}
```

```cpp
#include <hip/hip_runtime.h>
#include <cstdio>
#include <cstdint>

#ifndef MK_ONE_LAUNCH
#define MK_ONE_LAUNCH 1
#endif

#define LAS __attribute__((address_space(3)))
#define GAS __attribute__((address_space(1)))
typedef unsigned short bf16_t;
typedef short bf16x8 __attribute__((ext_vector_type(8)));
typedef float f32x4 __attribute__((ext_vector_type(4)));
typedef unsigned u32x4 __attribute__((ext_vector_type(4)));
typedef unsigned u32x2 __attribute__((ext_vector_type(2)));
typedef GAS unsigned gu32;
#define RLX_AGENT __ATOMIC_RELAXED, __HIP_MEMORY_SCOPE_AGENT
#define WSYNC() asm volatile("s_waitcnt lgkmcnt(0)" ::: "memory")
#define VM_WAIT() asm volatile("s_waitcnt vmcnt(0)" ::: "memory")

constexpr int NB = 2, SEQ = 8192, DM = 1024, NTOK = NB * SEQ, HD = 64;
constexpr int NVG = 2048;
constexpr int NVC = 2048;
constexpr int IN_COLS = 4120;
constexpr int NEXP = 32, DFF = 1024;
constexpr int NCMP = 511, NCMP_PAD = 512, NSEL = 128;
constexpr float C2 = 0.125f * 1.4426950408889634f;
constexpr float LOG2E = 1.4426950408889634f;
constexpr float DN_ALPHA = 1.189207115002721f;
constexpr float LN_EPS = 1e-5f;
constexpr int NWAVES = 8, NTHREADS = 512;
constexpr int MOE_RT = 256;

enum { I_X = 0, I_WIN, I_KPE, I_KW1, I_KW2, I_VPE, I_VW1, I_VW2, I_SINK, I_WBRN, I_WBRS, I_WOUT, I_LN1G, I_LN1B, I_WR, I_BR, I_WEIN, I_BEIN, I_WEOUT, I_BEOUT, I_LN2G, I_LN2B, N_IN };

constexpr size_t MiB = 1u << 20;
constexpr size_t WS_CTL = 0, CTL_ZERO_BYTES = 128 * 1024;
constexpr size_t WS_COS = 1 * MiB, WS_SIN = 2 * MiB;
constexpr size_t WS_C1P = 3 * MiB + 8192;
constexpr size_t WS_C1K = 3 * MiB, WS_C1V = 3 * MiB + 4096;
constexpr size_t WS_W1KT = 3 * MiB + 65536, WS_W1VT = WS_W1KT + 524288;
constexpr size_t WS_W2KT = WS_W1VT + 524288, WS_W2VT = WS_W2KT + 32768;
constexpr size_t WS_WBRN = 5 * MiB, WS_WBRS = 6 * MiB;
constexpr size_t WS_WOUT = 7 * MiB;
constexpr size_t WS_WIN = 9 * MiB;
constexpr size_t WS_KV = 18 * MiB, KV_BYTES = 4 * MiB;
constexpr size_t WS_CMP = 50 * MiB;
constexpr size_t WS_KCMP = WS_CMP, WS_VCMP = WS_CMP + 262144, WS_HIDK = WS_CMP + 524288, WS_HIDV = WS_CMP + 1048576;
constexpr size_t WS_QC = 52 * MiB, WS_QR = 68 * MiB, WS_QS = 84 * MiB;
constexpr size_t WS_GN = 100 * MiB;
constexpr size_t WS_SEL = 102 * MiB;
constexpr size_t WS_TOPE = 103 * MiB, WS_TOPG = WS_TOPE + 262144, WS_TOPP = WS_TOPG + 262144, WS_TOK = 104 * MiB;
constexpr size_t WS_XB = 108 * MiB;
constexpr size_t WS_ZB = 108 * MiB;
constexpr size_t WS_GM = 140 * MiB;
constexpr size_t WS_OF32 = 204 * MiB;
constexpr size_t WS_ONSA = 236 * MiB, WS_OSWA = 252 * MiB;
constexpr size_t WS_OSEL = 404 * MiB, WS_OWIN = 404 * MiB;
constexpr size_t WS_HB16 = 268 * MiB;
constexpr size_t WS_MIXED = 268 * MiB;
constexpr size_t WS_HB = 300 * MiB;
constexpr size_t WS_WEIN = 332 * MiB;
constexpr size_t WS_WEOUT = 460 * MiB;
constexpr size_t WS_ACT = 140 * MiB;
constexpr size_t WS_YS = 332 * MiB;
constexpr size_t WS_XB8 = 316 * MiB;
constexpr size_t WS_WG8 = 13 * MiB, WS_SCG = 15 * MiB;
constexpr size_t WS_SC1 = 420 * MiB, WS_SC2 = 422 * MiB;
constexpr size_t WS_END = 492 * MiB;
constexpr int CW_BAR = 4096;
constexpr int CW_CNT = 16384;

constexpr int LDS_BYTES = 147456;
constexpr int MISC_OFF = 145408;

__device__ __forceinline__ float bf2f(bf16_t v) { return __uint_as_float(((unsigned)v) << 16); }
__device__ __forceinline__ unsigned f2bf(float f) { unsigned u = __float_as_uint(f); return (u + 0x7fffu + ((u >> 16) & 1u)) >> 16; }
__device__ __forceinline__ unsigned pk2(float lo, float hi) { return f2bf(lo) | (f2bf(hi) << 16); }
__device__ __forceinline__ unsigned f4_to_fp8(float a, float b, float c, float d) { int p = __builtin_amdgcn_cvt_pk_fp8_f32(a, b, 0, false); p = __builtin_amdgcn_cvt_pk_fp8_f32(c, d, p, true); return (unsigned)p; }
__device__ __forceinline__ float frcp(float x) { return __builtin_amdgcn_rcpf(x); }
__device__ __forceinline__ float sigmoidf_(float x) { return frcp(1.0f + __expf(-x)); }
__device__ __forceinline__ float dppf(float v, int ctrl_sel) {
    const int x = __builtin_bit_cast(int, v);
    int r = ctrl_sel == 0 ? __builtin_amdgcn_mov_dpp(x, 0xB1, 0xF, 0xF, true) : ctrl_sel == 1 ? __builtin_amdgcn_mov_dpp(x, 0x4E, 0xF, 0xF, true) : ctrl_sel == 2 ? __builtin_amdgcn_mov_dpp(x, 0x141, 0xF, 0xF, true) : __builtin_amdgcn_mov_dpp(x, 0x140, 0xF, 0xF, true);
    return __builtin_bit_cast(float, r);
}
__device__ __forceinline__ float wave_sum(float v) {
    v += dppf(v, 0); v += dppf(v, 1); v += dppf(v, 2); v += dppf(v, 3);
    { auto r = __builtin_amdgcn_permlane16_swap(__float_as_uint(v), __float_as_uint(v), false, false); v = __uint_as_float(r[0]) + __uint_as_float(r[1]); }
    { auto r = __builtin_amdgcn_permlane32_swap(__float_as_uint(v), __float_as_uint(v), false, false); v = __uint_as_float(r[0]) + __uint_as_float(r[1]); }
    return v;
}
__device__ __forceinline__ float wave_max(float v) {
    v = fmaxf(v, dppf(v, 0)); v = fmaxf(v, dppf(v, 1)); v = fmaxf(v, dppf(v, 2)); v = fmaxf(v, dppf(v, 3));
    { auto r = __builtin_amdgcn_permlane16_swap(__float_as_uint(v), __float_as_uint(v), false, false); v = fmaxf(__uint_as_float(r[0]), __uint_as_float(r[1])); }
    { auto r = __builtin_amdgcn_permlane32_swap(__float_as_uint(v), __float_as_uint(v), false, false); v = fmaxf(__uint_as_float(r[0]), __uint_as_float(r[1])); }
    return v;
}
#define XB_TMO      128
#define XB_XCNT(j)  (256  + 64 * (j))
#define XB_XSUB(j)  (1280 + 64 * (j))
#define XB_XGEN(j)  (2304 + 64 * (j))
#define XB_TOP      3328
#define XB_TOPGEN   3392
#define XCD_BAR_WORDS 3456
#define XB_SPIN_CAP (1u << 22)
__device__ __forceinline__ unsigned xb_ld(unsigned* p)              { return __hip_atomic_load(p, __ATOMIC_RELAXED, __HIP_MEMORY_SCOPE_AGENT); }
__device__ __forceinline__ unsigned xb_add(unsigned* p, unsigned v) { return __hip_atomic_fetch_add(p, v, __ATOMIC_RELAXED, __HIP_MEMORY_SCOPE_AGENT); }
__device__ __forceinline__ unsigned xb_xcc_id() { return (unsigned)__builtin_amdgcn_s_getreg((3 << 11) | 20) & 0xFu; }
#define XB_SPIN(cond, bar) do { unsigned _sp = 0; while (cond) { __builtin_amdgcn_s_sleep(1); \
    if ((++_sp & 255u) == 0u) { if (xb_ld(&(bar)[XB_TMO])) break; if (_sp > XB_SPIN_CAP) { atomicAdd(&(bar)[XB_TMO], 1u); break; } } } } while (0)
struct XcdBarrier { unsigned* bar; unsigned x; volatile LAS unsigned* st; };
__device__ __forceinline__ XcdBarrier xcd_barrier_post(unsigned* bar, volatile LAS unsigned* st) {
    XcdBarrier b; b.bar = bar; b.x = xb_xcc_id(); b.st = st;
    if (threadIdx.x == 0) (void)xb_add(&bar[XB_XCNT(b.x)], 1u);
    return b;
}
__device__ __forceinline__ void xcd_barrier_complete(unsigned* bar, unsigned x, unsigned& nloc, unsigned& nx) {
    const unsigned G = gridDim.x * gridDim.y * gridDim.z;
    unsigned sum, cnt, mine, sp = 0u;
    for (;;) {
        sum = 0u; cnt = 0u; mine = 0u;
#pragma unroll
        for (unsigned j = 0; j < 16; ++j) { const unsigned c = xb_ld(&bar[XB_XCNT(j)]); sum += c; cnt += (c > 0u) ? 1u : 0u; mine = (j == x) ? c : mine; }
        if (sum == G) break;
        __builtin_amdgcn_s_sleep(1);
        if ((++sp & 255u) == 0u) { if (xb_ld(&bar[XB_TMO])) break; if (sp > XB_SPIN_CAP) { atomicAdd(&bar[XB_TMO], 1u); break; } }
    }
    nloc = mine > 0u ? mine : 1u; nx = cnt > 0u ? cnt : 1u;
}
__device__ __forceinline__ void xcd_barrier(const XcdBarrier& b) {
    asm volatile("s_waitcnt vmcnt(0)" ::: "memory");
    __syncthreads();
    if (threadIdx.x == 0) {
        unsigned* bar = b.bar;
        __builtin_amdgcn_s_waitcnt(0);
        unsigned nloc = b.st[0], nx = b.st[1];
        if (nloc == 0u) { xcd_barrier_complete(bar, b.x, nloc, nx); b.st[0] = nloc; b.st[1] = nx; }
        const unsigned old = xb_add(&bar[XB_XSUB(b.x)], 1u);
        const unsigned gen = old / nloc;
        if (old + 1u == (gen + 1u) * nloc) {
            __builtin_amdgcn_fence(__ATOMIC_RELEASE, "agent");
            asm volatile("s_waitcnt vmcnt(0)" ::: "memory");
            const unsigned og = xb_add(&bar[XB_TOP], 1u);
            const unsigned tg = og / nx;
            if (og + 1u == (tg + 1u) * nx) xb_add(&bar[XB_TOPGEN], 1u);
            else XB_SPIN(xb_ld(&bar[XB_TOPGEN]) == tg, bar);
            __builtin_amdgcn_fence(__ATOMIC_ACQUIRE, "agent");
            xb_add(&bar[XB_XGEN(b.x)], 1u);
            asm volatile("s_waitcnt vmcnt(0)" ::: "memory");
        } else {
            XB_SPIN(xb_ld(&bar[XB_XGEN(b.x)]) == gen, bar);
            __builtin_amdgcn_fence(__ATOMIC_ACQUIRE, "agent");
            asm volatile("s_waitcnt vmcnt(0)" ::: "memory");
        }
    }
    __syncthreads();
}

struct Args { const float* in[N_IN]; float* out; unsigned char* ws; int ph_lo, ph_hi; };
__device__ __forceinline__ int fresh_lane() { int l; asm volatile("v_mbcnt_lo_u32_b32 %0, -1, 0\n\tv_mbcnt_hi_u32_b32 %0, -1, %0" : "=v"(l)); return l; }
struct Frame {
    LAS unsigned char* lds;
    unsigned char* ws;
    const float* const* in;
    float* out;
    int tid, lane, wave, G, bid;
};

template <bool HAS_B1>
__device__ __forceinline__ void gemm_kloop(LAS unsigned char* lds, const bf16_t* a, const bf16_t* b0, const bf16_t* b1, int K, f32x4 (&acc)[4][2][2], int wid, int lane) {
    const int wr = wid >> 2, wc = wid & 3, fr = lane & 15, fq = lane >> 4;
    const unsigned ldsw = (unsigned)wid * 1024u;
    constexpr int SB = 24576;
    const int nsteps = K / 32;
#define KL_STAGE(s) do { LAS unsigned char* d_ = lds + ((s) & 3) * SB + ldsw; \
        __builtin_amdgcn_global_load_lds((const unsigned*)(a + (s) * 32), (LAS unsigned*)(d_), 16, 0, 0); \
        __builtin_amdgcn_global_load_lds((const unsigned*)(b0 + (s) * 32), (LAS unsigned*)(d_ + 8192), 16, 0, 0); \
        if (HAS_B1) __builtin_amdgcn_global_load_lds((const unsigned*)(b1 + (s) * 32), (LAS unsigned*)(d_ + 16384), 16, 0, 0); } while (0)
    for (int s = 0; s < 3 && s < nsteps; ++s) KL_STAGE(s);
    for (int k = 0; k < nsteps; ++k) {
        const int rem = nsteps - 1 - k;
        if (rem >= 2) { if (HAS_B1) asm volatile("s_waitcnt vmcnt(6)" ::: "memory"); else asm volatile("s_waitcnt vmcnt(4)" ::: "memory"); }
        else if (rem == 1) { if (HAS_B1) asm volatile("s_waitcnt vmcnt(3)" ::: "memory"); else asm volatile("s_waitcnt vmcnt(2)" ::: "memory"); }
        else asm volatile("s_waitcnt vmcnt(0)" ::: "memory");
        asm volatile("s_waitcnt lgkmcnt(0)" ::: "memory"); __builtin_amdgcn_s_barrier(); asm volatile("" ::: "memory");
        if (k + 3 < nsteps) KL_STAGE(k + 3);
        const LAS unsigned char* bufp = lds + (k & 3) * SB;
        bf16x8 af[4], bfr[2][2];
#pragma unroll
        for (int m = 0; m < 4; ++m) af[m] = *(const LAS bf16x8*)(bufp + (wr * 64 + m * 16 + fr) * 64 + fq * 16);
#pragma unroll
        for (int bj = 0; bj < (HAS_B1 ? 2 : 1); ++bj)
#pragma unroll
            for (int n = 0; n < 2; ++n) bfr[bj][n] = *(const LAS bf16x8*)(bufp + 8192 + bj * 8192 + (wc * 32 + n * 16 + fr) * 64 + fq * 16);
#pragma unroll
        for (int m = 0; m < 4; ++m)
#pragma unroll
            for (int bj = 0; bj < (HAS_B1 ? 2 : 1); ++bj)
#pragma unroll
                for (int n = 0; n < 2; ++n) acc[m][bj][n] = __builtin_amdgcn_mfma_f32_16x16x32_bf16(bfr[bj][n], af[m], acc[m][bj][n], 0, 0, 0);
    }
    asm volatile("s_waitcnt vmcnt(0) lgkmcnt(0)" ::: "memory"); __builtin_amdgcn_s_barrier(); asm volatile("" ::: "memory");
#undef KL_STAGE
}
__device__ __forceinline__ void acc_zero(f32x4 (&acc)[4][2][2]) {
#pragma unroll
    for (int m = 0; m < 4; ++m)
#pragma unroll
        for (int bj = 0; bj < 2; ++bj)
#pragma unroll
            for (int n = 0; n < 2; ++n) acc[m][bj][n] = (f32x4){0.f, 0.f, 0.f, 0.f};
}

__device__ __forceinline__ int win_src_col(int v, int& nvalid) {
    const int pn = v >> 8, bj = (v >> 7) & 1, hd = (v >> 5) & 3;
    nvalid = 32;
    if (pn < 2) return (4 * pn + hd) * 64 + 32 * bj;
    if (pn == 2) return (hd < 2 ? 512 + hd * 64 : 640 + (hd - 2) * 64) + 32 * bj;
    if (pn == 3) return (hd < 2 ? 768 + hd * 64 : 896 + (hd - 2) * 64) + 32 * bj;
    if (pn == 4) return (hd < 2 ? 1024 + hd * 64 : 1152 + (hd - 2) * 64) + 32 * bj;
    if (pn < 7) return 1304 + (4 * (pn - 5) + hd) * 64 + 32 * bj;
    if (pn == 7) return (hd < 2 ? 1816 + hd * 64 : 1944 + (hd - 2) * 64) + 32 * bj;
    return 2072 + (v - 2048);
}
struct TrItem { const float* W; bf16_t* WT; int ldw, srccol0, nvalid, K, k0; };
__device__ __forceinline__ void tr_load(const TrItem& it, float (&r)[32], int lane) {
    const int n = lane & 31; const float* p = it.W + (size_t)(it.k0 + (lane >> 5)) * it.ldw + it.srccol0 + n; const bool ok = n < it.nvalid;
#pragma unroll
    for (int i = 0; i < 32; ++i) r[i] = ok ? p[(size_t)(2 * i) * it.ldw] : 0.f;
}
__device__ __forceinline__ void tr_finish(const TrItem& it, const float (&r)[32], LAS float* scr, int lane) {
#pragma unroll
    for (int i = 0; i < 32; ++i) scr[(2 * i + (lane >> 5)) * 33 + (lane & 31)] = r[i];
    WSYNC();
    const int c = lane & 7;
#pragma unroll
    for (int j = 0; j < 4; ++j) { const int n = (lane >> 3) + 8 * j; const LAS float* s = scr + (8 * c) * 33 + n;
        u32x4 o; o.x = pk2(s[0 * 33], s[1 * 33]); o.y = pk2(s[2 * 33], s[3 * 33]); o.z = pk2(s[4 * 33], s[5 * 33]); o.w = pk2(s[6 * 33], s[7 * 33]);
        *(u32x4*)(it.WT + (size_t)n * it.K + it.k0 + 8 * c) = o; }
    WSYNC();
}
__device__ __forceinline__ void tr_item64(const float* W, int ldw, int sc0, int K, bf16_t* WT, int k0, LAS float* scr, int lane, int sc1 = -1, int nv0 = 32, int nv1 = 32) {
    const int kr = lane >> 4, nq = lane & 15;
    f32x4 r[16];
    { const int sc = (sc1 < 0) ? sc0 + 4 * nq : ((nq < 8 ? sc0 : sc1) + 4 * (nq & 7)); const bool ok = 4 * (nq & 7) + 3 < (nq < 8 ? nv0 : nv1);
      const float* p = W + (size_t)(k0 + kr) * ldw + sc;
#pragma unroll
      for (int i = 0; i < 16; ++i) r[i] = ok ? *(const f32x4*)(p + (size_t)(4 * i) * ldw) : (f32x4){0.f, 0.f, 0.f, 0.f}; }
#pragma unroll
    for (int i = 0; i < 16; ++i) { LAS float* d = scr + (4 * i + kr) * 65 + 4 * nq; d[0] = r[i].x; d[1] = r[i].y; d[2] = r[i].z; d[3] = r[i].w; }
    WSYNC();
    const int c = lane & 7;
#pragma unroll
    for (int j = 0; j < 8; ++j) { const int n = (lane >> 3) + 8 * j; const LAS float* s = scr + (8 * c) * 65 + n;
        u32x4 o; o.x = pk2(s[0 * 65], s[1 * 65]); o.y = pk2(s[2 * 65], s[3 * 65]); o.z = pk2(s[4 * 65], s[5 * 65]); o.w = pk2(s[6 * 65], s[7 * 65]);
        *(u32x4*)(WT + (size_t)n * K + k0 + 8 * c) = o; }
    WSYNC();
}
__device__ __forceinline__ void tr_item8(const float* W, int ldw, int sc_lo, int sc_hi, int k0, unsigned char* W8, unsigned char* SB, LAS float* scr, int lane) {
    const int kr = lane >> 3, nq = lane & 7;
    f32x4 r[16]; float amax = 0.f;
    { const float* p = W + (size_t)(k0 + kr) * ldw + (nq < 4 ? sc_lo + 4 * nq : sc_hi + 4 * (nq - 4));
#pragma unroll
      for (int i = 0; i < 16; ++i) r[i] = __builtin_nontemporal_load((const f32x4*)(p + (size_t)(8 * i) * ldw)); }
#pragma unroll
    for (int i = 0; i < 16; ++i) { const int kl = 8 * i + kr; LAS float* d = scr + (4 * nq) * 128 + (((kl >> 2) ^ nq) << 2) + (kl & 3); d[0] = r[i].x; d[128] = r[i].y; d[256] = r[i].z; d[384] = r[i].w;
        amax = fmaxf(amax, fmaxf(fmaxf(fabsf(r[i].x), fabsf(r[i].y)), fmaxf(fabsf(r[i].z), fabsf(r[i].w)))); }
    amax = wave_max(amax);
    int e = (int)((__float_as_uint(amax) >> 23) & 0xffu) - 127 - 8; e = e < -127 ? -127 : e;
    const float inv = __uint_as_float((unsigned)(127 - e) << 23);
    WSYNC();
    const int c = lane & 7;
#pragma unroll
    for (int j = 0; j < 4; ++j) { const int n = (lane >> 3) + 8 * j; const LAS float* s = scr + n * 128; float v[16];
#pragma unroll
        for (int m = 0; m < 4; ++m) { const f32x4 t = *(const LAS f32x4*)(s + (((4 * c + m) ^ (n >> 2)) << 2));
            v[4 * m] = fminf(fmaxf(t.x * inv, -448.0f), 448.0f); v[4 * m + 1] = fminf(fmaxf(t.y * inv, -448.0f), 448.0f); v[4 * m + 2] = fminf(fmaxf(t.z * inv, -448.0f), 448.0f); v[4 * m + 3] = fminf(fmaxf(t.w * inv, -448.0f), 448.0f); }
        u32x4 o; o.x = f4_to_fp8(v[0], v[1], v[2], v[3]); o.y = f4_to_fp8(v[4], v[5], v[6], v[7]); o.z = f4_to_fp8(v[8], v[9], v[10], v[11]); o.w = f4_to_fp8(v[12], v[13], v[14], v[15]);
        *(u32x4*)(W8 + (size_t)n * 1024 + k0 + 16 * c) = o; }
    if (lane == 0) SB[k0 >> 7] = (unsigned char)(e + 127);
    WSYNC();
}
template <int PART>
__device__ __forceinline__ void phase_prologue(Frame& F) {
    const int gw = F.bid * NWAVES + F.wave, NGW = F.G * NWAVES;
    const int gt = F.bid * NTHREADS + F.tid, NGT = F.G * NTHREADS;
    LAS float* scr = (LAS float*)(F.lds + F.wave * 17408);
    unsigned char* ws = F.ws;
    if (PART == 0) {
        constexpr int WGS = 1024 + 16;
        LAS bf16_t* wg = (LAS bf16_t*)F.lds;
        for (int r = F.tid; r < 1024; r += NTHREADS) { const float* p = F.in[I_WIN] + (size_t)r * IN_COLS + 1280;
#pragma unroll
            for (int j = 0; j < 6; ++j) { const f32x4 v = *(const f32x4*)(p + 4 * j); wg[(4 * j) * WGS + r] = (bf16_t)f2bf(v.x); wg[(4 * j + 1) * WGS + r] = (bf16_t)f2bf(v.y); wg[(4 * j + 2) * WGS + r] = (bf16_t)f2bf(v.z); wg[(4 * j + 3) * WGS + r] = (bf16_t)f2bf(v.w); }
#pragma unroll
            for (int j = 24; j < 32; ++j) wg[j * WGS + r] = 0; }
        __syncthreads();
        const int fr = F.lane & 15, fq = F.lane >> 4, kh = F.wave >> 2, wq = F.wave & 3;
        LAS float* part = (LAS float*)(F.lds + 69632) + (wq * 64 + F.lane) * 8;
        for (int base = 0; base < NTOK / 16; base += 4 * F.G) {
            const int grp = base + wq * F.G + F.bid; const bool act = grp < NTOK / 16;
            f32x4 a0 = {0.f, 0.f, 0.f, 0.f}, a1 = {0.f, 0.f, 0.f, 0.f};
            if (act) {
                const size_t o = (size_t)(grp * 16 + fr) * 1024 + 8 * fq + 512 * kh;
                const float* xr = F.in[I_X] + o; bf16_t* xb = (bf16_t*)(ws + WS_XB) + o; unsigned char* xb8 = ws + WS_XB8 + o;
                const LAS bf16_t* w0 = wg + fr * WGS + 8 * fq + 512 * kh; const LAS bf16_t* w1 = wg + (16 + fr) * WGS + 8 * fq + 512 * kh;
                f32x4 xv0[16], xv1[16];
#pragma unroll
                for (int st = 0; st < 16; ++st) { xv0[st] = *(const f32x4*)(xr + st * 32); xv1[st] = *(const f32x4*)(xr + st * 32 + 4); }
                __builtin_amdgcn_sched_barrier(0);
#pragma unroll
                for (int st = 0; st < 16; ++st) { const f32x4 v0 = xv0[st], v1 = xv1[st];
                    u32x4 w; w.x = pk2(v0.x, v0.y); w.y = pk2(v0.z, v0.w); w.z = pk2(v1.x, v1.y); w.w = pk2(v1.z, v1.w); *(u32x4*)(xb + st * 32) = w;
                    { const f32x4 lo4 = {-448.f, -448.f, -448.f, -448.f}, hi4 = {448.f, 448.f, 448.f, 448.f}; const f32x4 c0 = __builtin_elementwise_min(__builtin_elementwise_max(v0 * 16.0f, lo4), hi4), c1 = __builtin_elementwise_min(__builtin_elementwise_max(v1 * 16.0f, lo4), hi4);
                      u32x2 w8; w8.x = f4_to_fp8(c0.x, c0.y, c0.z, c0.w); w8.y = f4_to_fp8(c1.x, c1.y, c1.z, c1.w); *(u32x2*)(xb8 + st * 32) = w8; }
                    const bf16x8 xa = __builtin_bit_cast(bf16x8, w);
                    a0 = __builtin_amdgcn_mfma_f32_16x16x32_bf16(*(const LAS bf16x8*)(w0 + st * 32), xa, a0, 0, 0, 0);
                    a1 = __builtin_amdgcn_mfma_f32_16x16x32_bf16(*(const LAS bf16x8*)(w1 + st * 32), xa, a1, 0, 0, 0); }
            }
            if (kh == 1) { *(LAS f32x4*)part = a0; *(LAS f32x4*)(part + 4) = a1; }
            __syncthreads();
            if (kh == 0 && act) { a0 += *(const LAS f32x4*)part; a1 += *(const LAS f32x4*)(part + 4);
                float* gn = (float*)(ws + WS_GN) + (size_t)(grp * 16 + fr) * 24 + 4 * fq;
                f32x4 s0, s1;
#pragma unroll
                for (int i = 0; i < 4; ++i) { s0[i] = sigmoidf_(a0[i]); s1[i] = sigmoidf_(a1[i]); }
                *(f32x4*)gn = s0; if (fq < 2) *(f32x4*)(gn + 16) = s1; }
            __syncthreads();
        }
    }
    if (PART == 0) { float* cs = (float*)(ws + WS_COS); float* sn = (float*)(ws + WS_SIN);
      for (int i = gt; i < SEQ * 32; i += NGT) { const int pos = i >> 5, j = i & 31;
          const float inv = powf(10000.0f, -(float)j / 32.0f); const float ang = (float)pos * inv;
          double t = (double)ang * 0.15915494309189535; t -= floor(t); const float tf = (float)t;
          cs[i] = __builtin_amdgcn_cosf(tf); sn[i] = __builtin_amdgcn_sinf(tf); } }
    if (PART == 0) { for (int o = F.wave * F.G + F.bid; o < 64; o += NWAVES * F.G) { const int which = o >> 5, ch = o & 31; const float* pe = F.in[which ? I_VPE : I_KPE] + ch * 64; const float* w1 = F.in[which ? I_VW1 : I_KW1] + (size_t)ch * 64 * 128;
          float s0 = 0.f, s1 = 0.f;
#pragma unroll 16
          for (int i = 0; i < 64; ++i) { const float p = pe[i]; s0 += p * w1[(size_t)i * 128 + F.lane]; s1 += p * w1[(size_t)i * 128 + 64 + F.lane]; }
          float* dst = (float*)(ws + WS_C1P) + (size_t)o * 128; dst[F.lane] = s0; dst[64 + F.lane] = s1; } }
    constexpr int IT_WIN = 16 * (NVC / 32), IT_BR = 8 * 32, IT_WOUT = 16 * 32, IT_W1 = 32 * 4, IT_W2 = 2 * 2, IT_EIN = 16 * 64, IT_EOUT = 16 * 32;
    constexpr int O_WIN = 0, O_BRN = O_WIN + IT_WIN, O_BRS = O_BRN + IT_BR, O_WOUT = O_BRS + IT_BR, O_W1K = O_WOUT + IT_WOUT, O_W1V = O_W1K + IT_W1, O_W2K = O_W1V + IT_W1, O_W2V = O_W2K + IT_W2,
                  O_EIN = O_W2V + IT_W2, O_EOUT = O_EIN + NEXP * IT_EIN, O_END = O_EOUT + NEXP * IT_EOUT;
    auto decode = [&](int it, TrItem& T) {
        if (it < O_BRN) { const int r = it - O_WIN, nblk = NVC / 32, kb = r / nblk, nb = r % nblk; int nv; const int sc = win_src_col(nb * 32, nv);
            T = TrItem{F.in[I_WIN], (bf16_t*)(ws + WS_WIN) + (size_t)nb * 32 * 1024, IN_COLS, sc, nv, 1024, kb * 64}; }
        else if (it < O_WOUT) { const bool s = it >= O_BRS; const int r = it - (s ? O_BRS : O_BRN), kb = r / 32, nb = r % 32;
            T = TrItem{F.in[s ? I_WBRS : I_WBRN], (bf16_t*)(ws + (s ? WS_WBRS : WS_WBRN)) + (size_t)nb * 32 * 512, 1024, nb * 32, 32, 512, kb * 64}; }
        else if (it < O_W1K) { const int r = it - O_WOUT, kb = r / 32, nb = r % 32;
            T = TrItem{F.in[I_WOUT], (bf16_t*)(ws + WS_WOUT) + (size_t)nb * 32 * 1024, 1024, nb * 32, 32, 1024, kb * 64}; }
        else if (it < O_W2K) { const bool s = it >= O_W1V; const int r = it - (s ? O_W1V : O_W1K), kb = r / 4, nb = r % 4;
            T = TrItem{F.in[s ? I_VW1 : I_KW1], (bf16_t*)(ws + (s ? WS_W1VT : WS_W1KT)) + (size_t)nb * 32 * 2048, 128, nb * 32, 32, 2048, kb * 64}; }
        else if (it < O_EIN) { const bool s = it >= O_W2V; const int r = it - (s ? O_W2V : O_W2K), kb = r / 2, nb = r % 2;
            T = TrItem{F.in[s ? I_VW2 : I_KW2], (bf16_t*)(ws + (s ? WS_W2VT : WS_W2KT)) + (size_t)nb * 32 * 128, 64, nb * 32, 32, 128, kb * 64}; }
        else if (it < O_EOUT) { const int r0 = it - O_EIN, e = r0 / IT_EIN, r = r0 % IT_EIN, kb = r / 64, nb = r % 64;
            const int sc = ((nb >> 2) & 1) * 1024 + (nb >> 3) * 128 + (nb & 3) * 32;
            T = TrItem{F.in[I_WEIN] + (size_t)e * 1024 * 2048, (bf16_t*)(ws + WS_WEIN) + ((size_t)e * 2048 + nb * 32) * 1024, 2048, sc, 32, 1024, kb * 64}; }
        else { const int r0 = it - O_EOUT, e = r0 / IT_EOUT, r = r0 % IT_EOUT, kb = r / 32, nb = r % 32;
            T = TrItem{F.in[I_WEOUT] + (size_t)e * 1024 * 1024, (bf16_t*)(ws + WS_WEOUT) + ((size_t)e * 1024 + nb * 32) * 1024, 1024, nb * 32, 32, 1024, kb * 64}; }
    };
    LAS float* scr2 = scr + 64 * 33;
    if (PART == 1) {
        for (int blk = F.bid; blk < NEXP * 8; blk += F.G) for (int j = 0; j < 8; ++j) { const int e = blk >> 3, kb = blk & 7, nb = 8 * j + F.wave; const size_t row0 = (size_t)e * 2048 + nb * 32;
            const int sc = ((nb >> 2) & 1) * 1024 + (nb >> 3) * 128 + (nb & 3) * 32;
            tr_item8(F.in[I_WEIN] + (size_t)e * 1024 * 2048, 2048, sc, sc + 16, kb * 128, (unsigned char*)(ws + WS_WEIN) + row0 * 1024, (unsigned char*)(ws + WS_SC1) + (row0 >> 5) * 8, scr, F.lane); }
        return;
    }
    if (PART == 2) {
        for (int blk = F.bid; blk < NEXP * 8; blk += F.G) for (int j = 0; j < 4; ++j) { const int e = blk >> 3, kb = blk & 7, nb = 8 * j + F.wave; const size_t row0 = (size_t)e * 1024 + nb * 32;
            tr_item8(F.in[I_WEOUT] + (size_t)e * 1024 * 1024, 1024, nb * 32, nb * 32 + 16, kb * 128, (unsigned char*)(ws + WS_WEOUT) + row0 * 1024, (unsigned char*)(ws + WS_SC2) + (row0 >> 5) * 8, scr, F.lane); }
        return;
    }
    const int gwA = (gw + NGW - (NGW * 3) / 4) % NGW, gwB = (gw + NGW - (NGW * 31) / 64) % NGW;
    for (int it = gwA; it < 8 * 64; it += NGW) { const int kb = it >> 6, nb = it & 63;
        tr_item8(F.in[I_WIN], IN_COLS, 2072 + 32 * nb, 2072 + 32 * nb + 16, kb * 128, (unsigned char*)(ws + WS_WG8) + (size_t)nb * 32 * 1024, (unsigned char*)(ws + WS_SCG) + nb * 8, scr, F.lane); }
    for (int it = gwB; it < 16 * (NVC / 64); it += NGW) { const int kb = it / (NVC / 64), nb = it % (NVC / 64); int nv0, nv1; const int s0 = win_src_col(nb * 64, nv0), s1 = win_src_col(nb * 64 + 32, nv1);
        tr_item64(F.in[I_WIN], IN_COLS, s0, 1024, (bf16_t*)(ws + WS_WIN) + (size_t)nb * 64 * 1024, kb * 64, scr, F.lane, s1, nv0, nv1); }
    for (int it = O_BRN + gw; it < O_EIN; it += 2 * NGW) {
        TrItem Ta, Tb; float ra[32], rb[32]; const bool two = it + NGW < O_EIN;
        decode(it, Ta); tr_load(Ta, ra, F.lane);
        if (two) { decode(it + NGW, Tb); tr_load(Tb, rb, F.lane); }
        tr_finish(Ta, ra, scr, F.lane);
        if (two) tr_finish(Tb, rb, scr2, F.lane);
    }
}

__device__ __forceinline__ bf16_t* kv_tensor(unsigned char* ws, int idx) { return (bf16_t*)(ws + WS_KV + (size_t)idx * KV_BYTES); }
namespace pg8 {
#define PG8_LAS __attribute__((address_space(3)))
typedef unsigned short bf16_t;
typedef short bf16x8 __attribute__((ext_vector_type(8)));
typedef float f32x4 __attribute__((ext_vector_type(4)));
typedef unsigned u32x4 __attribute__((ext_vector_type(4)));
typedef int i32x4 __attribute__((ext_vector_type(4)));
typedef int i32x8 __attribute__((ext_vector_type(8)));
constexpr int BM = 256, BK = 64, HALF = 128, HTB = HALF * BK * 2  , STAGE_BYTES = 8 * HTB, NXCD = 8, WGM = 8;
constexpr int BIASSTASH = STAGE_BYTES + 2048 + 8192;
constexpr int SCSTASH = STAGE_BYTES + 2048 + 8192 + 2048;
constexpr int TOKSTASH = STAGE_BYTES + 2048;

__host__ __device__ __forceinline__ int lds_byte(int r, int c) { const int st = (r >> 4) * 2 + (c >> 5), rr = r & 15, cc = c & 31, ob = rr * 64 + cc * 2; return st * 1024 + (ob ^ (((ob >> 9) & 1) << 5)); }
__host__ __device__ __forceinline__ void stage_rc(int b, int& R, int& C) { const int st = b / 1024, sb = b % 1024, swz = sb ^ (((sb >> 9) & 1) << 5); R = (st >> 1) * 16 + swz / 64; C = (st & 1) * 32 + (swz % 64) / 2; }
__host__ __device__ __forceinline__ int perm32(int rho) { const int n = rho >> 4, i = rho & 15; return 8 * (i >> 2) + 4 * n + (i & 3); }

struct Unit { int pm, pn; };
struct Gemm { const bf16_t* A; const bf16_t* Bt; int M, N, K; const unsigned char* Bs = nullptr; unsigned ascale = 0x7f7f7f7fu; };

struct StaticOrder {
    static constexpr bool GATHER = false;
    int nM, nN, nwg, G, c;
    __host__ __device__ void init(int M, int N, int G_, int c_) { nM = M / BM; nN = N / BM; nwg = nM * nN; G = G_; c = c_; }
    __host__ __device__ bool next(int i, Unit& u) const {
        const long L = (long)i * G + c; if (L >= nwg) return false;
        int wgid = (int)L; { const int q = nwg / NXCD, r = nwg % NXCD, xcd = wgid % NXCD, off = wgid / NXCD; wgid = (xcd < r ? xcd * (q + 1) : r * (q + 1) + (xcd - r) * q) + off; }
        const int nig = WGM * nN, gid = wgid / nig, fm = gid * WGM, gsz = (nM - fm) < WGM ? (nM - fm) : WGM;
        u.pm = fm + ((wgid % nig) % gsz); u.pn = (wgid % nig) / gsz; return true;
    }
    __device__ __forceinline__ void a_ready(const Unit&) const {}
    __device__ __forceinline__ void done(const Unit&) const {}
};

__device__ __forceinline__ unsigned cvt_pk_bf16(float lo, float hi) { typedef float f2_ __attribute__((ext_vector_type(2))); typedef __bf16 b2_ __attribute__((ext_vector_type(2))); const f2_ v = {lo, hi}; return __builtin_bit_cast(unsigned, __builtin_convertvector(v, b2_)); }
__device__ __forceinline__ unsigned pk2e(float lo, float hi) { return cvt_pk_bf16(lo, hi); }
__device__ __forceinline__ u32x4 pack8(const f32x4 a, const f32x4 b) { u32x4 w; w.x = pk2e(a[0], a[1]); w.y = pk2e(a[2], a[3]); w.z = pk2e(b[0], b[1]); w.w = pk2e(b[2], b[3]); return w; }
__device__ __forceinline__ f32x4 sig4(const f32x4 v) { f32x4 r; r[0] = frcp(1.0f + __expf(-v[0])); r[1] = frcp(1.0f + __expf(-v[1])); r[2] = frcp(1.0f + __expf(-v[2])); r[3] = frcp(1.0f + __expf(-v[3])); return r; }
struct EpiInProj {
    static constexpr bool CHAIN = false, LDS_BIAS = false;
    static constexpr bool PERM = true, AFTER_DRAIN = false;
    unsigned char* ws;
    __device__ __forceinline__ void operator()(const f32x4 (&acc)[2][2][4][2], const Unit& u, int wr, int wc, int fr, int fq) const {
        const int pn = u.pn; const float* COS = (const float*)(ws + WS_COS); const float* SIN = (const float*)(ws + WS_SIN);
#pragma unroll
        for (int ai = 0; ai < 2; ++ai)
#pragma unroll
            for (int m = 0; m < 4; ++m) {
                const int row = u.pm * BM + ai * HALF + wr * 64 + m * 16 + fr;
                if (pn < 8) {
                    const int pos = row & (SEQ - 1), bb = row >> 13, dlo = 8 * fq;
                    const f32x4 a0 = acc[ai][0][m][0], a1 = acc[ai][0][m][1], b0 = acc[ai][1][m][0], b1 = acc[ai][1][m][1];
                    const bool isq = (pn < 2) || pn == 5 || pn == 6;
                    const int pair = (pn == 2) ? 0 : (pn == 3) ? 1 : (pn == 4) ? 2 : 3; const bool isv = wc >= 2;
                    const bool rope = isq || (!isv && pair != 0);
                    f32x4 ra0 = a0, ra1 = a1, rb0 = b0, rb1 = b1;
                    if (rope) { const f32x4 c0 = *(const f32x4*)(COS + pos * 32 + dlo), c1 = *(const f32x4*)(COS + pos * 32 + dlo + 4), s0 = *(const f32x4*)(SIN + pos * 32 + dlo), s1 = *(const f32x4*)(SIN + pos * 32 + dlo + 4);
                        ra0 = a0 * c0 - b0 * s0; ra1 = a1 * c1 - b1 * s1; rb0 = b0 * c0 + a0 * s0; rb1 = b1 * c1 + a1 * s1; }
                    if (isq) {
                        const int head = (pn < 2 ? 4 * pn : 4 * (pn - 5)) + wc;
                        bf16_t* qr = (bf16_t*)(ws + (pn < 2 ? WS_QR : WS_QS)) + (size_t)row * 512 + head * 64 + dlo;
                        *(u32x4*)qr = pack8(ra0 * C2, ra1 * C2); *(u32x4*)(qr + 32) = pack8(rb0 * C2, rb1 * C2);
                        if (pn < 2) { bf16_t* qc = (bf16_t*)(ws + WS_QC) + (size_t)row * 512 + head * 64 + dlo; *(u32x4*)qc = pack8(a0 * C2, a1 * C2); *(u32x4*)(qc + 32) = pack8(b0 * C2, b1 * C2); }
                    } else {
                        bf16_t* dst = kv_tensor(ws, pair * 2 + (isv ? 1 : 0)) + ((size_t)(bb * 2 + (wc & 1)) * SEQ + pos) * 64 + dlo;
                        *(u32x4*)dst = pack8(ra0, ra1); *(u32x4*)(dst + 32) = pack8(rb0, rb1);
                    }
                }
            }
    }
};
struct EpiGate {
    static constexpr bool CHAIN = false, LDS_BIAS = false;
    static constexpr bool PERM = true, AFTER_DRAIN = false;
    unsigned char* ws;
    static __device__ __forceinline__ unsigned q8(float g) { const float q = fminf(fmaxf(g * 255.0f + 0.5f, 1.0f), 255.0f); return (unsigned)q; }
    __device__ __forceinline__ void operator()(const f32x4 (&acc)[2][2][4][2], const Unit& u, int wr, int wc, int fr, int fq) const {
#pragma unroll
        for (int ai = 0; ai < 2; ++ai)
#pragma unroll
            for (int m = 0; m < 4; ++m) { const int row = u.pm * BM + ai * HALF + wr * 64 + m * 16 + fr;
                unsigned char* gm = ws + WS_GM + (size_t)row * 2048 + u.pn * 256 + wc * 32 + 8 * fq;
#pragma unroll
                for (int bj = 0; bj < 2; ++bj) { const f32x4 s0 = sig4(acc[ai][bj][m][0]), s1 = sig4(acc[ai][bj][m][1]); u32x2 w;
                    w.x = q8(s0[0]) | (q8(s0[1]) << 8) | (q8(s0[2]) << 16) | (q8(s0[3]) << 24); w.y = q8(s1[0]) | (q8(s1[1]) << 8) | (q8(s1[2]) << 16) | (q8(s1[3]) << 24);
                    *(u32x2*)(gm + bj * HALF) = w; } }
    }
};
struct EpiResid {
    static constexpr bool CHAIN = false, LDS_BIAS = false;
    static constexpr bool PERM = true, AFTER_DRAIN = false;
    const float* X; bf16_t* Z;
    __device__ __forceinline__ void operator()(const f32x4 (&acc)[2][2][4][2], const Unit& u, int wr, int wc, int fr, int fq) const {
#pragma unroll
        for (int ai = 0; ai < 2; ++ai)
#pragma unroll
            for (int m = 0; m < 4; ++m) { const size_t off = (size_t)(u.pm * BM + ai * HALF + wr * 64 + m * 16 + fr) * 1024 + u.pn * BM + wc * 32 + 8 * fq;
#pragma unroll
                for (int bj = 0; bj < 2; ++bj) { const size_t o = off + bj * HALF;
                    *(u32x4*)(Z + o) = pack8(*(const f32x4*)(X + o) * DN_ALPHA + acc[ai][bj][m][0], *(const f32x4*)(X + o + 4) * DN_ALPHA + acc[ai][bj][m][1]); } }
    }
};
struct EpiSwiGLU {
    static constexpr bool CHAIN = false, LDS_BIAS = true;
    static constexpr bool PERM = true, AFTER_DRAIN = false;
    const float* bin; unsigned char* ACT;
    __device__ __forceinline__ const float* bias_src(const Unit& u, int part) const { return bin + (size_t)(u.pn >> 3) * 2048 + (u.pn & 7) * 128 + (part >> 1) * 1024 + (part & 1) * 64; }
    __device__ __forceinline__ void epi_lds(const f32x4 (&acc)[2][2][4][2], const Unit& u, int wr, int wc, int fr, int fq, const PG8_LAS float* bs) const {
        const int col0 = (u.pn & 7) * 128 + wc * 32 + 8 * fq; const PG8_LAS float* be = bs + wc * 32 + 8 * fq;
        const f32x4 bg0 = *(const PG8_LAS f32x4*)be, bg1 = *(const PG8_LAS f32x4*)(be + 4), bu0 = *(const PG8_LAS f32x4*)(be + 128), bu1 = *(const PG8_LAS f32x4*)(be + 132);
#pragma unroll
        for (int ai = 0; ai < 2; ++ai)
#pragma unroll
            for (int m = 0; m < 4; ++m) { const size_t row = (size_t)u.pm * BM + ai * HALF + wr * 64 + m * 16 + fr;
                f32x4 o[2];
#pragma unroll
                for (int n = 0; n < 2; ++n) { const f32x4 hg = acc[ai][0][m][n] + (n ? bg1 : bg0), hu = acc[ai][1][m][n] + (n ? bu1 : bu0);
#pragma unroll
                    for (int i = 0; i < 4; ++i) { const float g = fminf(hg[i], 7.0f), uu = fminf(fmaxf(hu[i], -7.0f), 7.0f); o[n][i] = g * frcp(1.0f + __expf(-1.702f * g)) * (uu + 1.0f); } }
                u32x2 w8; w8.x = f4_to_fp8(o[0][0], o[0][1], o[0][2], o[0][3]); w8.y = f4_to_fp8(o[1][0], o[1][1], o[1][2], o[1][3]); *(u32x2*)(ACT + row * 1024 + col0) = w8; }
    }
};
struct EpiDown {
    static constexpr bool CHAIN = false, LDS_BIAS = true;
    static constexpr bool PERM = true, AFTER_DRAIN = false;
    const float* bout; bf16_t* YS;
    __device__ __forceinline__ const float* bias_src(const Unit& u, int part) const { return bout + (size_t)(u.pn >> 2) * 1024 + (u.pn & 3) * 256 + part * 64; }
    __device__ __forceinline__ void epi_lds(const f32x4 (&acc)[2][2][4][2], const Unit& u, int wr, int wc, int fr, int fq, const PG8_LAS float* bs) const {
        const int col0 = (u.pn & 3) * 256 + wc * 32 + 8 * fq; const PG8_LAS float* be = bs + wc * 32 + 8 * fq;
#pragma unroll
        for (int bj = 0; bj < 2; ++bj) { const f32x4 b0 = *(const PG8_LAS f32x4*)(be + bj * HALF), b1 = *(const PG8_LAS f32x4*)(be + bj * HALF + 4);
#pragma unroll
            for (int ai = 0; ai < 2; ++ai)
#pragma unroll
                for (int m = 0; m < 4; ++m) { const size_t row = (size_t)u.pm * BM + ai * HALF + wr * 64 + m * 16 + fr;
                    const f32x4 lo4 = {-448.f, -448.f, -448.f, -448.f}, hi4 = {448.f, 448.f, 448.f, 448.f};
                    const f32x4 c0 = __builtin_elementwise_min(__builtin_elementwise_max((acc[ai][bj][m][0] + b0) * 16.0f, lo4), hi4), c1 = __builtin_elementwise_min(__builtin_elementwise_max((acc[ai][bj][m][1] + b1) * 16.0f, lo4), hi4);
                    u32x2 w8; w8.x = f4_to_fp8(c0[0], c0[1], c0[2], c0[3]); w8.y = f4_to_fp8(c1[0], c1[1], c1[2], c1[3]); *(u32x2*)((unsigned char*)YS + row * 1024 + col0 + bj * HALF) = w8; } }
    }
};
struct EpiBranch {
    static constexpr bool CHAIN = true, LDS_BIAS = false;
    static constexpr bool PERM = true, AFTER_DRAIN = false;
    const unsigned char* GM; bf16_t* MIXED;
    __device__ __forceinline__ bool keep(const Unit& u) const { return u.pm < 64; }
    __device__ __forceinline__ void mid(f32x4 (&acc)[2][2][4][2], const Unit& u, int wr, int wc, int fr, int fq) const {
#pragma unroll
        for (int ai = 0; ai < 2; ++ai)
#pragma unroll
            for (int m = 0; m < 4; ++m) { const size_t row = (size_t)(u.pm & 63) * BM + ai * HALF + wr * 64 + m * 16 + fr;
#pragma unroll
                for (int bj = 0; bj < 2; ++bj) { const int col0 = (u.pn & 3) * BM + bj * HALF + wc * 32 + 8 * fq;
                    const u32x2 g1 = *(const u32x2*)(GM + row * 2048 + col0), g2 = *(const u32x2*)(GM + row * 2048 + 1024 + col0);
#pragma unroll
                    for (int q = 0; q < 8; ++q) { const float a1 = (float)((g1[q >> 2] >> (8 * (q & 3))) & 0xffu), a2 = (float)((g2[q >> 2] >> (8 * (q & 3))) & 0xffu);
                        acc[ai][bj][m][q >> 2][q & 3] *= a1 * frcp(a2); } } }
    }
    __device__ __forceinline__ void operator()(const f32x4 (&acc)[2][2][4][2], const Unit& u, int wr, int wc, int fr, int fq) const {
#pragma unroll
        for (int ai = 0; ai < 2; ++ai)
#pragma unroll
            for (int m = 0; m < 4; ++m) { const size_t row = (size_t)(u.pm & 63) * BM + ai * HALF + wr * 64 + m * 16 + fr;
#pragma unroll
                for (int bj = 0; bj < 2; ++bj) { const int col0 = (u.pn & 3) * BM + bj * HALF + wc * 32 + 8 * fq;
                    const u32x2 g2 = *(const u32x2*)(GM + row * 2048 + 1024 + col0); f32x4 o0, o1;
#pragma unroll
                    for (int q = 0; q < 8; ++q) { const float a2 = (float)((g2[q >> 2] >> (8 * (q & 3))) & 0xffu) * (1.0f / 255.0f); const float v0 = acc[ai][bj][m][q >> 2][q & 3] * a2;
                        if (q < 4) o0[q] = v0; else o1[q - 4] = v0; }
                    *(u32x4*)(MIXED + row * 1024 + col0) = pack8(o0, o1); } }
    }
};
struct BranchOrder {
    static constexpr bool GATHER = false;
    StaticOrder so;
    __device__ __forceinline__ bool next(int i, Unit& u) const { if (!so.next(i >> 1, u)) return false; u.pm += (i & 1) * 64; u.pn += (i & 1) * 4; return true; }
    __device__ __forceinline__ void a_ready(const Unit&) const {}
    __device__ __forceinline__ void done(const Unit&) const {}
    __device__ __forceinline__ int a_row(const Unit&, int) const { return 0; }
};
template <bool GATHER_>
struct ExpertOrder {
    static constexpr bool GATHER = GATHER_;
    const PG8_LAS int* base_s; int ntiles, npn, G, c; const PG8_LAS int* cnt_s; const int* TOK;
    __device__ __forceinline__ bool next(int i, Unit& u) const {
        const int nwg = ntiles * npn; const int L = i * G + c; if (L >= nwg) return false;
        int wgid = L; { const int q = nwg / NXCD, r = nwg % NXCD, xcd = wgid % NXCD, off = wgid / NXCD; wgid = (xcd < r ? xcd * (q + 1) : r * (q + 1) + (xcd - r) * q) + off; }
        const int gt = wgid / npn, pp = wgid % npn; const int e = base_s[64 + gt];
        u.pm = gt; u.pn = e * npn + pp; return true;
    }
    __device__ __forceinline__ int a_row(const Unit& u, int r) const {
        const int e = u.pn / npn; int pos = (u.pm - base_s[e]) * BM + r; const int last = cnt_s[e] - 1; pos = pos < last ? pos : last;
        return TOK[e * NTOK + pos];
    }
    __device__ __forceinline__ const int* a_ptr(const Unit& u, int r) const {
        const int e = u.pn / npn; int pos = (u.pm - base_s[e]) * BM + r; const int last = cnt_s[e] - 1; pos = pos < last ? pos : last;
        return TOK + e * NTOK + pos;
    }
    __device__ __forceinline__ void a_ready(const Unit&) const {}
    __device__ __forceinline__ void done(const Unit&) const {}
};
template <class Epi, class Sched, bool ALIGN_EPI = false, bool SP2 = false, bool FP8 = false, bool HALFN = false>
__device__ __forceinline__ void gemm_phase(PG8_LAS unsigned char* lds, const Gemm g, const Sched& S, const Epi& E) {
    const int tid = threadIdx.x, wid = __builtin_amdgcn_readfirstlane(tid >> 6), lane = tid & 63, wr = wid >> 2, wc = wid & 3, fr = lane & 15, fq = lane >> 4;
    static_assert((!FP8 && !HALFN) || SP2, "the FP8 / HALFN paths are written for the SP2 loop");
    const int K = g.K, nt = K / BK;
    unsigned voffA[2][2], voffN[2][2], voffB[2]; int stR[2], stC[2];
#pragma unroll
    for (int i = 0; i < 2; ++i) { int R, C; stage_rc(tid * 16 + i * 8192, R, C); const int Rb = Epi::PERM ? ((R & ~31) + perm32(R & 31)) : R; stR[i] = R; stC[i] = C;
        voffA[0][i] = (unsigned)(R * K + C) * 2u; voffA[1][i] = (unsigned)((R + HALF) * K + C) * 2u; voffB[i] = (unsigned)(Rb * K + C) * 2u;
        voffN[0][i] = voffA[0][i]; voffN[1][i] = voffA[1][i]; }
#define PG8_AOFF(dst, u) do { if constexpr (Sched::GATHER) { _Pragma("unroll") for (int h_ = 0; h_ < 2; ++h_) _Pragma("unroll") for (int i_ = 0; i_ < 2; ++i_) \
        dst[h_][i_] = (unsigned)(S.a_row(u, h_ * HALF + stR[i_]) * K + stC[i_]) * 2u; } } while (0)
    const size_t kstep = (size_t)(BK * 2);
    const size_t hstep = (size_t)HALF * K * 2;
    const size_t tstep = 2 * hstep;
    const unsigned ldsw = (unsigned)wid * 1024u;
    const int aoff = lds_byte(wr * 64 + fr, fq * 8), boff = lds_byte(wc * 32 + fr, fq * 8);
    constexpr int KFS = 1024;
#define PG8_SA(b, h) (((b) * 2 + (h)) * HTB)
#define PG8_SB(b, h) ((4 + (b) * 2 + (h)) * HTB)
#define PG8_STAGE(bufoff, gbase, voff) do { _Pragma("unroll") for (int _i = 0; _i < 2; ++_i) \
        __builtin_amdgcn_global_load_lds((const unsigned*)((const char*)(gbase) + (voff)[_i]), (PG8_LAS unsigned*)(lds + (bufoff) + ldsw + _i * 8192), 16, 0, 0); } while (0)
#define PG8_LDA(dst, b, h) do { _Pragma("unroll") for (int m = 0; m < 4; ++m) _Pragma("unroll") for (int k = 0; k < 2; ++k) dst[m][k] = *(const PG8_LAS bf16x8*)(lds + PG8_SA(b, h) + aoff + m * 2048 + k * KFS); } while (0)
#define PG8_LDB(dst, b, h) do { _Pragma("unroll") for (int n = 0; n < 2; ++n) _Pragma("unroll") for (int k = 0; k < 2; ++k) dst[n][k] = *(const PG8_LAS bf16x8*)(lds + PG8_SB(b, h) + boff + n * 2048 + k * KFS); } while (0)
#define PG8_MMA(ai, bj, At, Bt) do { __builtin_amdgcn_s_setprio(1); \
        if constexpr (FP8) { const unsigned sb_ = (unsigned)bsc[bj]; _Pragma("unroll") for (int m = 0; m < 4; ++m) _Pragma("unroll") for (int n = 0; n < 2; ++n) { \
            const i32x8 bw_ = __builtin_shufflevector(__builtin_bit_cast(i32x4, Bt[n][0]), __builtin_bit_cast(i32x4, Bt[n][1]), 0, 1, 2, 3, 4, 5, 6, 7), aw_ = __builtin_shufflevector(__builtin_bit_cast(i32x4, At[m][0]), __builtin_bit_cast(i32x4, At[m][1]), 0, 1, 2, 3, 4, 5, 6, 7); \
            asm volatile("v_mfma_scale_f32_16x16x128_f8f6f4 %0, %1, %2, %0, %3, %4 op_sel_hi:[0,0,0]" : "+v"(acc[ai][bj][m][n]) : "v"(bw_), "v"(aw_), "v"(sb_), "v"(g.ascale)); } } \
        else { _Pragma("unroll") for (int m = 0; m < 4; ++m) _Pragma("unroll") for (int n = 0; n < 2; ++n) { _Pragma("unroll") for (int k = 0; k < 2; ++k) acc[ai][bj][m][n] = __builtin_amdgcn_mfma_f32_16x16x32_bf16(Bt[n][k], At[m][k], acc[ai][bj][m][n], 0, 0, 0); } } \
        __builtin_amdgcn_s_setprio(0); } while (0)
#define PG8_SCSHIFT() do { if constexpr (FP8) { bsc[0] >>= 8; bsc[1] >>= 8; } } while (0)
#define PG8_WAIT_V(n) asm volatile("s_waitcnt vmcnt(" #n ")" ::: "memory")
#define PG8_WAIT_L(n) asm volatile("s_waitcnt lgkmcnt(" #n ")" ::: "memory")
#define PG8_BAR __builtin_amdgcn_s_barrier()
#define PG8_SCHED __builtin_amdgcn_sched_barrier(0)
    Unit cur, nxt; int ui = 0;
    if (!S.next(0, cur)) return;
    f32x4 acc[2][2][4][2];
#pragma unroll
    for (int a = 0; a < 2; ++a)
#pragma unroll
        for (int b = 0; b < 2; ++b)
#pragma unroll
            for (int m = 0; m < 4; ++m)
#pragma unroll
                for (int n = 0; n < 2; ++n) acc[a][b][m][n] = (f32x4){0.f, 0.f, 0.f, 0.f};
    bf16x8 At[4][2], B0[2][2], B1[2][2];
    unsigned long long bsc[2] = {0ull, 0ull};
#define PG8_SCLOAD(u) do { if constexpr (FP8) { _Pragma("unroll") for (int bj_ = 0; bj_ < (HALFN ? 1 : 2); ++bj_) { const int grp_ = ((u).pn * (HALFN ? HALF : BM) + bj_ * HALF) / 32 + wc; \
        const unsigned long long v_ = *(const unsigned long long*)(g.Bs + (size_t)grp_ * 8); bsc[bj_] = ((unsigned long long)(unsigned)__builtin_amdgcn_readfirstlane((int)(v_ >> 32)) << 32) | (unsigned)__builtin_amdgcn_readfirstlane((int)v_); } } } while (0)
    const char* cA = Sched::GATHER ? (const char*)g.A : (const char*)g.A + (size_t)cur.pm * tstep; const char* cB = (const char*)g.Bt + (size_t)cur.pn * (HALFN ? hstep : tstep);
    PG8_AOFF(voffA, cur);
    PG8_SCLOAD(cur);
    S.a_ready(cur);
    if constexpr (SP2) {
        PG8_STAGE(PG8_SB(0, 0), cB, voffB); if constexpr (!HALFN) { PG8_STAGE(PG8_SB(0, 1), cB + hstep, voffB); } PG8_STAGE(PG8_SA(0, 0), cA, voffA[0]); PG8_STAGE(PG8_SA(0, 1), cA, voffA[1]);
        if (wr == 1) PG8_BAR;
        PG8_WAIT_V(2); PG8_BAR;
        PG8_STAGE(PG8_SB(1, 0), cB + kstep, voffB); PG8_STAGE(PG8_SA(1, 0), cA + kstep, voffA[0]); if constexpr (!HALFN) { PG8_STAGE(PG8_SB(1, 1), cB + hstep + kstep, voffB); }
        if constexpr (HALFN) { PG8_WAIT_V(4); } else { PG8_WAIT_V(6); } PG8_BAR;
    } else {
        PG8_STAGE(PG8_SB(0, 0), cB, voffB); PG8_STAGE(PG8_SA(0, 0), cA, voffA[0]); PG8_STAGE(PG8_SB(0, 1), cB + hstep, voffB); PG8_STAGE(PG8_SA(0, 1), cA, voffA[1]);
        if (wr == 1) PG8_BAR;
        PG8_WAIT_V(4); PG8_BAR;
        PG8_STAGE(PG8_SB(1, 0), cB + kstep, voffB); PG8_STAGE(PG8_SA(1, 0), cA + kstep, voffA[0]); PG8_STAGE(PG8_SB(1, 1), cB + hstep + kstep, voffB);
        PG8_WAIT_V(6); PG8_BAR;
    }
    for (;;) {
        const bool has_next = S.next(ui + 1, nxt);
        if constexpr (Epi::LDS_BIAS && FP8 && !HALFN) { if (wid == 4 && has_next) __builtin_amdgcn_global_load_lds((const unsigned*)(g.Bs + (size_t)nxt.pn * 64 + (lane & 15) * 4), (PG8_LAS unsigned*)(lds + SCSTASH + ((ui + 1) & 1) * 256), 4, 0, 0); }
        if constexpr (Epi::LDS_BIAS) { if (wid < 4) __builtin_amdgcn_global_load_lds((const unsigned*)(E.bias_src(cur, wid) + lane), (PG8_LAS unsigned*)(lds + BIASSTASH + (ui & 1) * 1024 + wid * 256), 4, 0, 0); }
        const char* nA = (has_next && !Sched::GATHER) ? (const char*)g.A + (size_t)nxt.pm * tstep : cA; const char* nB = has_next ? (const char*)g.Bt + (size_t)nxt.pn * (HALFN ? hstep : tstep) : cB;
        if constexpr (Sched::GATHER) { if (has_next) {
#pragma unroll
            for (int h_ = 0; h_ < 2; ++h_)
#pragma unroll
                for (int i_ = 0; i_ < 2; ++i_) __builtin_amdgcn_global_load_lds((const unsigned*)S.a_ptr(nxt, h_ * HALF + stR[i_]), (PG8_LAS unsigned*)(lds + TOKSTASH + (h_ * 2 + i_) * 2048 + wid * 256), 4, 0, 0); } }
#pragma unroll 1
        for (int t = 0; t < nt; t += 2) {
            const bool last = (t == nt - 2);
            if constexpr (Sched::GATHER) { if (last && has_next) {
#pragma unroll
                for (int h_ = 0; h_ < 2; ++h_)
#pragma unroll
                    for (int i_ = 0; i_ < 2; ++i_) voffN[h_][i_] = (unsigned)(*(const PG8_LAS int*)(lds + TOKSTASH + (h_ * 2 + i_) * 2048 + tid * 4) * K + stC[i_]) * 2u; } }
            unsigned va2[2][2];
#pragma unroll
            for (int h_ = 0; h_ < 2; ++h_)
#pragma unroll
                for (int i_ = 0; i_ < 2; ++i_) va2[h_][i_] = (Sched::GATHER && last) ? voffN[h_][i_] : voffA[h_][i_];
            const char* a1 = cA + (size_t)(t + 1) * kstep;
            const char* a2 = last ? nA : cA + (size_t)(t + 2) * kstep; const char* b2 = last ? nB : cB + (size_t)(t + 2) * kstep;
            const char* a3 = a2 + kstep; const char* b3 = b2 + kstep;
            if (last && has_next) S.a_ready(nxt);
            if constexpr (SP2) {
            PG8_LDB(B0, 0, 0); if constexpr (!HALFN) { PG8_LDB(B1, 0, 1); } PG8_SCHED; PG8_LDA(At, 0, 0); PG8_STAGE(PG8_SA(1, 1), a1, voffA[1]);
            if constexpr (HALFN) { PG8_WAIT_V(6); } else { PG8_WAIT_V(8); } PG8_WAIT_L(0); PG8_BAR; PG8_MMA(0, 0, At, B0); if constexpr (!HALFN) { PG8_MMA(0, 1, At, B1); } PG8_BAR; PG8_SCHED;
            PG8_LDA(At, 0, 1); PG8_STAGE(PG8_SB(0, 0), b2, voffB); if constexpr (!HALFN) { PG8_STAGE(PG8_SB(0, 1), b2 + hstep, voffB); } PG8_STAGE(PG8_SA(0, 0), a2, va2[0]);
            if constexpr (HALFN) { PG8_WAIT_V(6); } else { PG8_WAIT_V(8); } PG8_WAIT_L(0); PG8_BAR; PG8_MMA(1, 0, At, B0); if constexpr (!HALFN) { PG8_MMA(1, 1, At, B1); } PG8_SCSHIFT(); PG8_BAR; PG8_SCHED;
            PG8_LDB(B0, 1, 0); if constexpr (!HALFN) { PG8_LDB(B1, 1, 1); } PG8_SCHED; PG8_LDA(At, 1, 0); PG8_STAGE(PG8_SA(0, 1), a2, va2[1]);
            if constexpr (HALFN) { PG8_WAIT_V(6); } else { PG8_WAIT_V(8); } PG8_WAIT_L(0); PG8_BAR; PG8_MMA(0, 0, At, B0); if constexpr (!HALFN) { PG8_MMA(0, 1, At, B1); } PG8_BAR; PG8_SCHED;
            PG8_LDA(At, 1, 1); PG8_STAGE(PG8_SB(1, 0), b3, voffB); if constexpr (!HALFN) { PG8_STAGE(PG8_SB(1, 1), b3 + hstep, voffB); } PG8_STAGE(PG8_SA(1, 0), a3, va2[0]);
            if constexpr (HALFN) { PG8_WAIT_V(6); } else { PG8_WAIT_V(8); } PG8_WAIT_L(0); PG8_BAR; PG8_MMA(1, 0, At, B0); if constexpr (!HALFN) { PG8_MMA(1, 1, At, B1); } PG8_SCSHIFT(); PG8_BAR; PG8_SCHED;
            } else {
            PG8_LDB(B0, 0, 0); PG8_SCHED; PG8_LDA(At, 0, 0); PG8_STAGE(PG8_SA(1, 1), a1, voffA[1]);
            PG8_WAIT_L(8); PG8_BAR; PG8_WAIT_L(0); PG8_MMA(0, 0, At, B0); PG8_BAR; PG8_SCHED;
            PG8_LDB(B1, 0, 1); PG8_STAGE(PG8_SB(0, 0), b2, voffB);
            PG8_BAR; PG8_WAIT_L(0); PG8_MMA(0, 1, At, B1); PG8_BAR;
            PG8_LDA(At, 0, 1); PG8_STAGE(PG8_SA(0, 0), a2, va2[0]);
            PG8_BAR; PG8_WAIT_L(0); PG8_MMA(1, 0, At, B0); PG8_BAR; PG8_SCHED;
            PG8_STAGE(PG8_SB(0, 1), b2 + hstep, voffB);
            PG8_WAIT_V(6); PG8_BAR; PG8_MMA(1, 1, At, B1); PG8_BAR;
            PG8_LDB(B0, 1, 0); PG8_SCHED; PG8_LDA(At, 1, 0); PG8_STAGE(PG8_SA(0, 1), a2, va2[1]);
            PG8_WAIT_L(8); PG8_BAR; PG8_WAIT_L(0); PG8_MMA(0, 0, At, B0); PG8_BAR; PG8_SCHED;
            PG8_LDB(B1, 1, 1); PG8_STAGE(PG8_SB(1, 0), b3, voffB);
            PG8_BAR; PG8_WAIT_L(0); PG8_MMA(0, 1, At, B1); PG8_BAR;
            PG8_LDA(At, 1, 1); PG8_STAGE(PG8_SA(1, 0), a3, va2[0]);
            PG8_BAR; PG8_WAIT_L(0); PG8_MMA(1, 0, At, B0); PG8_BAR; PG8_SCHED;
            PG8_STAGE(PG8_SB(1, 1), b3 + hstep, voffB);
            PG8_WAIT_V(6); PG8_BAR; PG8_MMA(1, 1, At, B1); PG8_BAR;
            }
        }
        if constexpr (ALIGN_EPI) { if (wr == 0) PG8_BAR; }
        if constexpr (FP8) {
#define PG8_ACC8(a, b, m0) "+v"(acc[a][b][m0][0]), "+v"(acc[a][b][m0][1]), "+v"(acc[a][b][m0 + 1][0]), "+v"(acc[a][b][m0 + 1][1])
            asm volatile("s_nop 7\n\ts_nop 7\n\ts_nop 7" : PG8_ACC8(0, 0, 0), PG8_ACC8(0, 0, 2), PG8_ACC8(0, 1, 0), PG8_ACC8(0, 1, 2));
            asm volatile("" : PG8_ACC8(1, 0, 0), PG8_ACC8(1, 0, 2), PG8_ACC8(1, 1, 0), PG8_ACC8(1, 1, 2));
#undef PG8_ACC8
        }
        bool keep = false;
        if constexpr (Epi::CHAIN) keep = E.keep(cur);
        const int lane_e = (int)__builtin_amdgcn_mbcnt_hi(~0u, __builtin_amdgcn_mbcnt_lo(~0u, 0u)); int fr_e = lane_e & 15, fq_e = lane_e >> 4; asm volatile("" : "+v"(fr_e), "+v"(fq_e));
        if constexpr (Epi::CHAIN) { if (keep) E.mid(acc, cur, wr, wc, fr_e, fq_e); }
        if constexpr (Epi::LDS_BIAS) { E.epi_lds(acc, cur, wr, wc, fr_e, fq_e, (const PG8_LAS float*)(lds + BIASSTASH + (ui & 1) * 1024)); S.done(cur); }
        else if constexpr (!Epi::AFTER_DRAIN) { if (!keep) E(acc, cur, wr, wc, fr_e, fq_e); S.done(cur); }
        if (!has_next) break;
        if (!keep)
#pragma unroll
        for (int a = 0; a < 2; ++a)
#pragma unroll
            for (int b = 0; b < 2; ++b)
#pragma unroll
                for (int m = 0; m < 4; ++m)
#pragma unroll
                    for (int n = 0; n < 2; ++n) acc[a][b][m][n] = (f32x4){0.f, 0.f, 0.f, 0.f};
        cur = nxt; cA = nA; cB = nB; ++ui;
        if constexpr (Epi::LDS_BIAS && FP8 && !HALFN) {
#pragma unroll
            for (int bj_ = 0; bj_ < 2; ++bj_) { const unsigned long long v_ = *(const PG8_LAS unsigned long long*)(lds + SCSTASH + (ui & 1) * 256 + (bj_ * 4 + wc) * 8);
                bsc[bj_] = ((unsigned long long)(unsigned)__builtin_amdgcn_readfirstlane((int)(v_ >> 32)) << 32) | (unsigned)__builtin_amdgcn_readfirstlane((int)v_); } }
        else { PG8_SCLOAD(cur); }
        if constexpr (Sched::GATHER) { _Pragma("unroll") for (int h_ = 0; h_ < 2; ++h_) _Pragma("unroll") for (int i_ = 0; i_ < 2; ++i_) voffA[h_][i_] = voffN[h_][i_]; }
        if constexpr (ALIGN_EPI) { if (wr == 1) PG8_BAR; }
    }
    PG8_WAIT_V(0);
    if constexpr (!ALIGN_EPI) { if (wr == 0) PG8_BAR; }
    PG8_BAR;
    if constexpr (Epi::AFTER_DRAIN) { E.fused(acc, cur, wr, wc, fr, fq, lds, wid, lane); S.done(cur); }
#undef PG8_AOFF
#undef PG8_SA
#undef PG8_SB
#undef PG8_STAGE
#undef PG8_LDA
#undef PG8_LDB
#undef PG8_MMA
#undef PG8_SCSHIFT
#undef PG8_SCLOAD
#undef PG8_WAIT_V
#undef PG8_WAIT_L
#undef PG8_BAR
#undef PG8_SCHED
}
}

__device__ __forceinline__ void phase_inproj(Frame& F) {
    pg8::Gemm g{(const bf16_t*)(F.ws + WS_XB), (const bf16_t*)(F.ws + WS_WIN), NTOK, NVC, 1024};
    pg8::StaticOrder S; S.init(NTOK, NVC, F.G, F.bid);
    pg8::EpiInProj E{F.ws};
    pg8::gemm_phase<pg8::EpiInProj, pg8::StaticOrder, true, true>(F.lds, g, S, E);
    pg8::Gemm g8{(const bf16_t*)(F.ws + WS_XB8), (const bf16_t*)(F.ws + WS_WG8), NTOK, NVG, 512, (const unsigned char*)(F.ws + WS_SCG), 0x7b7b7b7bu};
    pg8::StaticOrder S8; S8.init(NTOK, NVG, F.G, F.bid);
    pg8::EpiGate E8{F.ws};
    pg8::gemm_phase<pg8::EpiGate, pg8::StaticOrder, true, true, true, false>(F.lds, g8, S8, E8);
}

__device__ __forceinline__ float gelu_tanh(float x) { const float u = 0.7978845608028654f * (x + 0.044715f * x * x * x); return 0.5f * x * (1.0f + tanhf(u)); }
__device__ __forceinline__ void cmp1_unit(Frame& F, int u) {
    unsigned char* ws = F.ws;
    const int wr = F.wave >> 2, wc = F.wave & 3, fr = F.lane & 15, fq = F.lane >> 4;
    {
        const int which = u >> 4, bg = (u >> 2) & 3, rt = u & 3;
        const bf16_t* src = kv_tensor(ws, which) + (size_t)bg * SEQ * 64;
        const bf16_t* a = src + (size_t)(rt * 128 + (F.tid >> 2)) * 1024 + (F.tid & 3) * 8;
        const bf16_t* b0 = (const bf16_t*)(ws + (which ? WS_W1VT : WS_W1KT)) + (size_t)(F.tid >> 2) * 2048 + (F.tid & 3) * 8;
        const float* c1p = (const float*)(ws + WS_C1P) + (size_t)which * 32 * 128;
        bf16_t* HID = (bf16_t*)(ws + (which ? WS_HIDV : WS_HIDK)) + (size_t)bg * 512 * 128;
        f32x4 acc[4][2][2]; acc_zero(acc);
        gemm_kloop<false>(F.lds, a, b0, b0, 2048, acc, F.wave, F.lane);
#pragma unroll
        for (int m = 0; m < 4; ++m) { const int row = rt * 128 + wr * 64 + m * 16 + fr;
#pragma unroll
            for (int n = 0; n < 2; ++n) { const int col = wc * 32 + n * 16 + 4 * fq; f32x4 bv = {0.f, 0.f, 0.f, 0.f};
#pragma unroll 8
                for (int p2 = 0; p2 < 32; ++p2) bv += *(const f32x4*)(c1p + p2 * 128 + col);
                const f32x4 v = acc[m][0][n] + bv;
                u32x2 w; w.x = pk2(gelu_tanh(v.x), gelu_tanh(v.y)); w.y = pk2(gelu_tanh(v.z), gelu_tanh(v.w)); *(u32x2*)(HID + (size_t)row * 128 + col) = w; } }
    }
}
__device__ __forceinline__ void cmp2_unit(Frame& F, int u) {
    unsigned char* ws = F.ws;
    const int wr = F.wave >> 2, wc = F.wave & 3, fr = F.lane & 15, fq = F.lane >> 4;
    {
        const int which = u >> 4, bg = (u >> 2) & 3, rt = u & 3;
        const bf16_t* HID = (const bf16_t*)(ws + (which ? WS_HIDV : WS_HIDK)) + (size_t)bg * 512 * 128;
        const bf16_t* a = HID + (size_t)(rt * 128 + (F.tid >> 2)) * 128 + (F.tid & 3) * 8;
        const bf16_t* b0 = (const bf16_t*)(ws + (which ? WS_W2VT : WS_W2KT)) + (size_t)(F.tid >> 2) * 128 + (F.tid & 3) * 8;
        bf16_t* OUT = (bf16_t*)(ws + (which ? WS_VCMP : WS_KCMP)) + (size_t)bg * 512 * 64;
        f32x4 acc[4][2][2]; acc_zero(acc);
        gemm_kloop<false>(F.lds, a, b0, b0, 128, acc, F.wave, F.lane);
        if (wc < 2) {
#pragma unroll
            for (int m = 0; m < 4; ++m) { const int row = rt * 128 + wr * 64 + m * 16 + fr;
#pragma unroll
                for (int n = 0; n < 2; ++n) { const int col = wc * 32 + n * 16 + 4 * fq; const f32x4 v = acc[m][0][n];
                    u32x2 w; w.x = pk2(v.x, v.y); w.y = pk2(v.z, v.w); *(u32x2*)(OUT + (size_t)row * 64 + col) = w; } }
        }
    }
}

namespace att {
typedef short s16x4 __attribute__((ext_vector_type(4)));
typedef float f32x16 __attribute__((ext_vector_type(16)));
typedef float f32x2_t __attribute__((ext_vector_type(2))); typedef __bf16 bf16x2_t __attribute__((ext_vector_type(2)));
constexpr int NW = 8, QBLK = 32, QB = 256, KVBLK = 64, KP = 64, QP = 512;
constexpr int NSLOT = 3, SLOTB = 8192;
constexpr int LDS_K = 0, LDS_V = NSLOT * SLOTB, LDS_WS = 2 * NSLOT * SLOTB, LDS_OST = LDS_WS + NW * 256, LDS_Q = LDS_OST + NW * 4096, LDS_SW = LDS_Q + NW * 4096, LDS_BYTES = LDS_SW + NW * 1024;
enum { M_SEL = 0, M_WIN = 1, M_SWA = 2 };
__device__ __forceinline__ int crow(int r, int hi) { return (r & 3) + 8 * (r >> 2) + 4 * hi; }
#define SBAR() __builtin_amdgcn_sched_barrier(0)
__device__ __forceinline__ void cmask(f32x16& p0, f32x16& p1, int jb, int qrel, int hi) {
    const float NEG = -__builtin_inff(); const int kb = 64 * jb + 4 * hi;
#pragma unroll
    for (int r = 0; r < 16; ++r) { const int kv = kb + (r & 3) + 8 * (r >> 2); if (kv > qrel) p0[r] = NEG; if (kv + 32 > qrel) p1[r] = NEG; }
}
__device__ __forceinline__ void lmask(f32x16& p0, f32x16& p1, int t, int qrel, int hi) {
    const float NEG = -__builtin_inff(); const int kb = 64 * t + 4 * hi;
#pragma unroll
    for (int r = 0; r < 16; ++r) { const int kv = kb + (r & 3) + 8 * (r >> 2); if (kv <= qrel) p0[r] = NEG; if (kv + 32 <= qrel) p1[r] = NEG; }
}
__device__ __forceinline__ void glds16(const void* gsrc, unsigned lds_dst) { unsigned keep;
    asm volatile("s_mov_b32 %0, m0\n\ts_mov_b32 m0, %2\n\ts_nop 0\n\tglobal_load_lds_dwordx4 %1, off\n\ts_mov_b32 m0, %0" : "=&s"(keep) : "v"(gsrc), "s"(lds_dst) : "memory"); }
__device__ __forceinline__ float max3f(float a, float b, float c) { float r; asm("v_max3_f32 %0, %1, %2, %3" : "=v"(r) : "v"(a), "v"(b), "v"(c)); return r; }
__device__ __forceinline__ float max2f(float a, float b) { float r; asm("v_max_f32_e32 %0, %1, %2" : "=v"(r) : "v"(a), "v"(b)); return r; }
__device__ __forceinline__ float fadd_s(float a, float b) { float r; asm("v_add_f32_e32 %0, %1, %2" : "=v"(r) : "v"(a), "v"(b)); return r; }
__device__ __forceinline__ float fsub_s(float a, float b) { float r; asm("v_sub_f32_e32 %0, %1, %2" : "=v"(r) : "v"(a), "v"(b)); return r; }
__device__ __forceinline__ unsigned cvtpk_s(float lo, float hi) { f32x2_t v = {lo, hi}; bf16x2_t b = __builtin_convertvector(v, bf16x2_t); return __builtin_bit_cast(unsigned, b); }
#define WAIT_BAR(N) asm volatile("s_waitcnt vmcnt(" #N ") lgkmcnt(0)\n\ts_barrier" ::: "memory")
__device__ __forceinline__ void qkt(f32x16& p0, f32x16& p1, const char* Kslot, const bf16x8* qr, const f32x16& negm, int r32, int hi) {
    const char* kb = Kslot + hi * 1024 + r32 * 16;
#pragma unroll
    for (int d0 = 0; d0 < 4; ++d0) {
        const bf16x8 b0 = *reinterpret_cast<const bf16x8*>(kb + d0 * 2048);
        const bf16x8 b1 = *reinterpret_cast<const bf16x8*>(kb + d0 * 2048 + 512);
        if (d0 == 0) { p0 = __builtin_amdgcn_mfma_f32_32x32x16_bf16(b0, qr[0], negm, 0, 0, 0); p1 = __builtin_amdgcn_mfma_f32_32x32x16_bf16(b1, qr[0], negm, 0, 0, 0); }
        else { p0 = __builtin_amdgcn_mfma_f32_32x32x16_bf16(b0, qr[d0], p0, 0, 0, 0); p1 = __builtin_amdgcn_mfma_f32_32x32x16_bf16(b1, qr[d0], p1, 0, 0, 0); } }
}
typedef __attribute__((address_space(3))) const char* lds_cptr;
typedef short v4i16_t __attribute__((ext_vector_type(4)));
__device__ __forceinline__ void kload8(bf16x8* kf, lds_cptr kp) {
    kf[0] = *(const LAS bf16x8*)(kp);        kf[1] = *(const LAS bf16x8*)(kp + 512);
    kf[2] = *(const LAS bf16x8*)(kp + 2048); kf[3] = *(const LAS bf16x8*)(kp + 2560);
    kf[4] = *(const LAS bf16x8*)(kp + 4096); kf[5] = *(const LAS bf16x8*)(kp + 4608);
    kf[6] = *(const LAS bf16x8*)(kp + 6144); kf[7] = *(const LAS bf16x8*)(kp + 6656);
}
__device__ __forceinline__ void kload2(bf16x8* kf, lds_cptr kp, int j) { kf[2 * j] = *(const LAS bf16x8*)(kp + j * 2048); kf[2 * j + 1] = *(const LAS bf16x8*)(kp + j * 2048 + 512); }
__device__ __forceinline__ s16x4 vtr(lds_cptr p) { return __builtin_bit_cast(s16x4, __builtin_amdgcn_ds_read_tr16_b64_v4i16((LAS v4i16_t*)p)); }
__device__ __forceinline__ float rowmax(const f32x16& p0, const f32x16& p1) {
    float a = max3f(p0[0], p0[1], p1[0]), b = max3f(p0[2], p0[3], p1[1]); a = max3f(a, p1[2], p1[3]);
#pragma unroll
    for (int r = 4; r < 16; r += 4) { a = max3f(a, p0[r], p0[r + 1]); b = max3f(b, p0[r + 2], p0[r + 3]); a = max3f(a, p1[r], p1[r + 1]); b = max3f(b, p1[r + 2], p1[r + 3]); }
    const float m = max2f(a, b);
    auto rr = __builtin_amdgcn_permlane32_swap(__float_as_uint(m), __float_as_uint(m), false, false);
    return max2f(__uint_as_float(rr[0]), __uint_as_float(rr[1]));
}
__device__ __forceinline__ void pv(f32x16* o, int vb, bf16x8 pa0, bf16x8 pa1, bf16x8 pa2, bf16x8 pa3) {
#pragma unroll
    for (int d0 = 0; d0 < 2; ++d0) { s16x4 lo[4], hi[4];
#pragma unroll
        for (int ks = 0; ks < 4; ++ks) {
            asm volatile("ds_read_b64_tr_b16 %0,%1 offset:%c2" : "=&v"(lo[ks]) : "v"(vb), "i"(d0 * 4096 + ks * 1024) : "memory");
            asm volatile("ds_read_b64_tr_b16 %0,%1 offset:%c2" : "=&v"(hi[ks]) : "v"(vb), "i"(d0 * 4096 + ks * 1024 + 512) : "memory"); }
        asm volatile("s_waitcnt lgkmcnt(0)" ::: "memory"); SBAR();
#define PK(k) (bf16x8){lo[k][0], lo[k][1], lo[k][2], lo[k][3], hi[k][0], hi[k][1], hi[k][2], hi[k][3]}
        o[d0] = __builtin_amdgcn_mfma_f32_32x32x16_bf16(pa0, PK(0), o[d0], 0, 0, 0);
        o[d0] = __builtin_amdgcn_mfma_f32_32x32x16_bf16(pa1, PK(1), o[d0], 0, 0, 0);
        o[d0] = __builtin_amdgcn_mfma_f32_32x32x16_bf16(pa2, PK(2), o[d0], 0, 0, 0);
        o[d0] = __builtin_amdgcn_mfma_f32_32x32x16_bf16(pa3, PK(3), o[d0], 0, 0, 0);
#undef PK
    }
}
struct Tens { const bf16_t* Q; const bf16_t* K; const bf16_t* V; const unsigned* SEL; const float* GN; bf16_t* OB; const float* sinks; const bf16_t* add0 = nullptr; const bf16_t* add1 = nullptr; };
constexpr int S_K = 0, S_V = 16384, S_WS = 32768, S_OST = S_WS + NW * 256, S_BYTES = S_OST + NW * 4096;
template <int MODE, int THRL> __device__ __forceinline__ void attn_unit(int b, int h, int qb, const Tens& T, char* shm) {
    int tid_ = threadIdx.x; asm volatile("" : "+v"(tid_));
    const int tid = tid_, lane = tid & 63, r32 = lane & 31, hi = lane >> 5; const int wid = __builtin_amdgcn_readfirstlane(tid >> 6);
    const int bg = b * 2 + (h >> 2); const long rowbase = (long)b * SEQ; const int q0 = qb * QB;
    constexpr int W = (MODE == M_WIN) ? 512 : 128;
    const bool lower = (MODE != M_SEL) && (q0 + QB - 1 >= W);
    const int t0 = (MODE != M_SEL && q0 >= W) ? (q0 - W) / KVBLK : 0;
    const int NT = (q0 + QB) / KVBLK - t0;
    const int loff = q0 - W - t0 * KVBLK;
    const bf16_t* Qw = T.Q + (rowbase + q0 + wid * QBLK) * QP + h * 64;
    const bf16_t* Kh = T.K + ((long)bg * SEQ + (long)t0 * KVBLK) * KP; const bf16_t* Vh = T.V + ((long)bg * SEQ + (long)t0 * KVBLK) * KP;
    const unsigned lds0 = (unsigned)(uintptr_t)shm;
    float* wsf = (float*)(shm + S_WS) + wid * 64;
    const bf16_t* ksrc = Kh + (long)lane * KP + wid * 8;
    const bf16_t* vsrc = Vh + (long)(16 * (wid & 3) + (lane >> 2)) * KP + (wid >> 2) * 32 + (lane & 3) * 8;
    const unsigned kdst = lds0 + S_K + wid * 1024, vdst = lds0 + S_V + wid * 1024;
#define DMA_K(t, slot) glds16(ksrc + (long)(t) * KVBLK * KP, (unsigned)__builtin_amdgcn_readfirstlane(kdst + (slot)))
#define DMA_V(t, slot) glds16(vsrc + (long)(t) * KVBLK * KP, (unsigned)__builtin_amdgcn_readfirstlane(vdst + (slot)))
    const int vb0 = (int)(lds0 + S_V) + ((lane >> 4) & 1) * 32 + (lane & 3) * 8 + (4 * hi + ((lane & 15) >> 2)) * 64;
    const char* Kbase = shm + S_K;
    DMA_K(0, 0); DMA_V(0, 0);
    bf16x8 qr[4];
#pragma unroll
    for (int d0 = 0; d0 < 4; ++d0) qr[d0] = *reinterpret_cast<const bf16x8*>(&Qw[(long)r32 * QP + d0 * 16 + hi * 8]);
    const int qrel = wid * QBLK + r32;
    u32x4 sw = (u32x4){0u, 0u, 0u, 0u};
    if (MODE == M_SEL) sw = *(const u32x4*)(T.SEL + ((size_t)bg * SEQ + q0 + qrel) * 4);
    float mhat = 0.f, l_reg = 0.f; bool seen = false; f32x16 o[2]; o[0] = f32x16{}; o[1] = f32x16{}; f32x16 negm = f32x16{};
    const float NINF = -__builtin_inff();
#pragma unroll 1
    for (int t = 0; t < NT; ++t) {
        const int slot = (t & 1) * 8192;
        if (t + 1 < NT) { DMA_K(t + 1, slot ^ 8192); DMA_V(t + 1, slot ^ 8192); WAIT_BAR(2); } else { WAIT_BAR(0); }
        f32x16 p0, p1;
        qkt(p0, p1, Kbase + slot, qr, negm, r32, hi);
        { const int jb_ = t - (NT - 4); if (jb_ >= 0) cmask(p0, p1, jb_, qrel, hi); }
        if (MODE != M_SEL) { if (lower && t < 4) lmask(p0, p1, t, qrel + loff, hi); }
        unsigned onm = 0xffffffffu;
        if (MODE == M_SEL) { const unsigned wsel = t < 32 ? sw.x : t < 64 ? sw.y : t < 96 ? sw.z : sw.w; onm = 0u - ((wsel >> (t & 31)) & 1u); }
        float rm;
        { float a = __builtin_fmaxf(__builtin_fmaxf(p0[0], p0[1]), p1[0]), c = __builtin_fmaxf(__builtin_fmaxf(p0[2], p0[3]), p1[1]); a = __builtin_fmaxf(__builtin_fmaxf(a, p1[2]), p1[3]);
#pragma unroll
          for (int r = 4; r < 16; r += 4) { a = __builtin_fmaxf(__builtin_fmaxf(a, p0[r]), p0[r + 1]); c = __builtin_fmaxf(__builtin_fmaxf(c, p0[r + 2]), p0[r + 3]); a = __builtin_fmaxf(__builtin_fmaxf(a, p1[r]), p1[r + 1]); c = __builtin_fmaxf(__builtin_fmaxf(c, p1[r + 2]), p1[r + 3]); }
          rm = __builtin_fmaxf(a, c); auto rr = __builtin_amdgcn_permlane32_swap(__float_as_uint(rm), __float_as_uint(rm), false, false); rm = __builtin_fmaxf(__uint_as_float(rr[0]), __uint_as_float(rr[1])); }
        if (MODE == M_SEL) rm = onm ? rm : NINF;
        const bool live = rm > NINF; const bool need = live && (!seen || rm > (float)THRL);
        if (__any(need)) {
            const float dl = need ? rm : 0.f; mhat += dl;
#pragma unroll
            for (int r = 0; r < 16; ++r) { p0[r] -= dl; p1[r] -= dl; }
#pragma unroll
            for (int r = 0; r < 16; ++r) negm[r] = -mhat;
            const float f = (need && seen) ? __builtin_amdgcn_exp2f(-dl) : 1.0f; l_reg *= f;
            if (hi == 0) wsf[r32] = f;
            asm volatile("s_waitcnt lgkmcnt(0)" ::: "memory");
#pragma unroll
            for (int d_ = 0; d_ < 2; ++d_)
#pragma unroll
                for (int r = 0; r < 16; ++r) o[d_][r] *= wsf[crow(r, hi)];
        }
        seen = seen || live;
        float sacc = 0.f;
#pragma unroll
        for (int r = 0; r < 16; ++r) { p0[r] = __builtin_amdgcn_exp2f(p0[r]); p1[r] = __builtin_amdgcn_exp2f(p1[r]); sacc += p0[r] + p1[r]; }
        l_reg += __uint_as_float(__float_as_uint(sacc) & onm);
        u32x4 pw0, pw1, pw2, pw3;
        pw0 = (u32x4){cvtpk_s(p0[0], p0[1]), cvtpk_s(p0[2], p0[3]), cvtpk_s(p0[4], p0[5]), cvtpk_s(p0[6], p0[7])};
        pw1 = (u32x4){cvtpk_s(p0[8], p0[9]), cvtpk_s(p0[10], p0[11]), cvtpk_s(p0[12], p0[13]), cvtpk_s(p0[14], p0[15])};
        pw2 = (u32x4){cvtpk_s(p1[0], p1[1]), cvtpk_s(p1[2], p1[3]), cvtpk_s(p1[4], p1[5]), cvtpk_s(p1[6], p1[7])};
        pw3 = (u32x4){cvtpk_s(p1[8], p1[9]), cvtpk_s(p1[10], p1[11]), cvtpk_s(p1[12], p1[13]), cvtpk_s(p1[14], p1[15])};
        if (MODE == M_SEL) { pw0 &= onm; pw1 &= onm; pw2 &= onm; pw3 &= onm; }
        SBAR();
        pv(o, vb0 + slot, __builtin_bit_cast(bf16x8, pw0), __builtin_bit_cast(bf16x8, pw1), __builtin_bit_cast(bf16x8, pw2), __builtin_bit_cast(bf16x8, pw3));
        asm volatile("s_waitcnt lgkmcnt(0)\n\ts_barrier" ::: "memory");
    }
    { auto rr = __builtin_amdgcn_permlane32_swap(__float_as_uint(l_reg), __float_as_uint(l_reg), false, false); l_reg = __uint_as_float(rr[0]) + __uint_as_float(rr[1]); }
    if (MODE == M_SWA) l_reg += exp2f(T.sinks[h] * LOG2E - mhat);
    if (hi == 0) { float gate = 1.0f; if (MODE != M_SWA) gate = T.GN[(size_t)(rowbase + q0 + qrel) * 24 + h * 3 + (MODE == M_SEL ? 1 : 2)]; wsf[32 + r32] = l_reg / gate; }
    asm volatile("s_waitcnt lgkmcnt(0)" ::: "memory");
    float rli[16];
#pragma unroll
    for (int r = 0; r < 16; ++r) rli[r] = __builtin_amdgcn_rcpf(wsf[32 + crow(r, hi)]);
    { bf16_t* Ow = T.OB + (rowbase + q0 + wid * QBLK) * 512 + h * 64; bf16_t* stg = (bf16_t*)(shm + S_OST) + wid * 2048;
#pragma unroll
      for (int r = 0; r < 16; ++r) { const int orow = crow(r, hi);
#pragma unroll
          for (int d0 = 0; d0 < 2; ++d0) stg[orow * 64 + d0 * 32 + r32] = (bf16_t)f2bf(o[d0][r] * rli[r]); }
      asm volatile("s_waitcnt lgkmcnt(0)" ::: "memory");
#pragma unroll
      for (int i = 0; i < 4; ++i) { const int row = i * 8 + (lane >> 3), ch = lane & 7; u32x4 v = *(const u32x4*)(stg + row * 64 + ch * 8);
          if (MODE == M_WIN && T.add0) {
              const long off = (long)(rowbase + q0 + wid * QBLK + row) * 512 + h * 64 + ch * 8; const u32x4 a = *(const u32x4*)(T.add0 + off), c = *(const u32x4*)(T.add1 + off);
#pragma unroll
              for (int q = 0; q < 4; ++q) v[q] = pk2(__uint_as_float(v[q] << 16) + __uint_as_float(a[q] << 16) + __uint_as_float(c[q] << 16), __uint_as_float(v[q] & 0xffff0000u) + __uint_as_float(a[q] & 0xffff0000u) + __uint_as_float(c[q] & 0xffff0000u)); }
          *(u32x4*)(Ow + (long)row * 512 + ch * 8) = v; } }
    asm volatile("s_waitcnt vmcnt(0) lgkmcnt(0)\n\ts_barrier" ::: "memory");
#undef DMA_K
#undef DMA_V
}
template <int MODE, int THRL> __device__ __forceinline__ void attn_unit_t(int b, int h, int qb, const Tens& T, char* shm) {
    int tid_ = threadIdx.x; asm volatile("" : "+v"(tid_));
    const int tid = tid_, lane = tid & 63, r32 = lane & 31, hi = lane >> 5; const int wid = __builtin_amdgcn_readfirstlane(tid >> 6);
    const int bg = b * 2 + (h >> 2); const long rowbase = (long)b * SEQ; const int q0 = qb * QB;
    constexpr int W = (MODE == M_WIN) ? 512 : 128;
    const bool lower = (MODE != M_SEL) && (q0 + QB - 1 >= W);
    const int t0 = (MODE != M_SEL && q0 >= W) ? (q0 - W) / KVBLK : 0;
    const int loff = q0 - W - t0 * KVBLK;
    const int NT = (q0 + QB) / KVBLK - t0;
    const bf16_t* Qw = T.Q + (rowbase + q0 + wid * QBLK) * QP + h * 64;
    const bf16_t* Kh = T.K + ((long)bg * SEQ + (long)t0 * KVBLK) * KP; const bf16_t* Vh = T.V + ((long)bg * SEQ + (long)t0 * KVBLK) * KP;
    const unsigned lds0 = (unsigned)(uintptr_t)shm; const lds_cptr shm3 = (lds_cptr)shm;
    float* wsf = (float*)(shm + LDS_WS) + wid * 64;
    const bf16_t* ksrc = Kh + (long)lane * KP + wid * 8;
    const bf16_t* vsrc = Vh + (long)(16 * (wid & 3) + (lane >> 2)) * KP + (wid >> 2) * 32 + (lane & 3) * 8;
    const unsigned kdst = lds0 + LDS_K + wid * 1024, vdst = lds0 + LDS_V + wid * 1024;
#define DMA_K(t, slot) glds16(ksrc + (long)(t) * KVBLK * KP, (unsigned)__builtin_amdgcn_readfirstlane(kdst + (slot)))
#define DMA_V(t, slot) glds16(vsrc + (long)(t) * KVBLK * KP, (unsigned)__builtin_amdgcn_readfirstlane(vdst + (slot)))
    const int vb0 = (int)(lds0 + LDS_V) + ((lane >> 4) & 1) * 32 + (lane & 3) * 8 + (4 * hi + ((lane & 15) >> 2)) * 64;
    const char* Kbase = shm + LDS_K; bf16x8 kf[8];
    const lds_cptr kp0 = shm3 + LDS_K + hi * 1024 + r32 * 16; const lds_cptr vp0 = shm3 + LDS_V + ((lane >> 4) & 1) * 32 + (lane & 3) * 8 + (4 * hi + ((lane & 15) >> 2)) * 64;
    DMA_K(0, 0); DMA_V(0, 0); DMA_K(1, SLOTB);
    const LAS bf16x8* qlds = (const LAS bf16x8*)(shm3 + LDS_Q + wid * 4096 + lane * 16);
    const LAS unsigned* swl = (const LAS unsigned*)(shm3 + LDS_SW + wid * 1024 + lane * 4);
    const int qrel = wid * QBLK + r32;
    { bf16x8 qtmp[4];
#pragma unroll
      for (int d0 = 0; d0 < 4; ++d0) qtmp[d0] = *reinterpret_cast<const bf16x8*>(&Qw[(long)r32 * QP + d0 * 16 + hi * 8]);
#pragma unroll
      for (int d0 = 0; d0 < 4; ++d0) ((LAS bf16x8*)qlds)[64 * d0] = qtmp[d0];
      if (MODE == M_SEL) { const u32x4 sw = *(const u32x4*)(T.SEL + ((size_t)bg * SEQ + q0 + qrel) * 4); ((LAS unsigned*)swl)[0] = sw.x; ((LAS unsigned*)swl)[64] = sw.y; ((LAS unsigned*)swl)[128] = sw.z; ((LAS unsigned*)swl)[192] = sw.w; } }
#define QF(j) (qlds[64 * (j)])
#define SELMASK(t) ((MODE == M_SEL) ? (0u - ((swl[64 * ((t) >> 5)] >> ((t) & 31)) & 1u)) : 0xffffffffu)
    float mhat = 0.f, l_reg = 0.f; f32x16 o[2]; o[0] = f32x16{}; o[1] = f32x16{}; f32x16 negm = f32x16{}; asm volatile("" : "+v"(negm));
    unsigned pmk = 0xffffffffu;
#define MASK_T(P0, P1, t) do { const int jb_ = (t) - (NT - 4); if (jb_ >= 0) cmask(P0, P1, jb_, qrel, hi); if (MODE != M_SEL) { if (lower && (t) < 4) lmask(P0, P1, (t), qrel + loff, hi); } } while (0)
#define CMASK(P0, P1, t) MASK_T(P0, P1, t)
    bool resc = false, seen = false;
#define START(P0, P1) do { const float rm = rowmax(P0, P1); resc = false; \
    { const float dl = (rm > -__builtin_inff()) ? rm : 0.f; seen = rm > -__builtin_inff(); mhat = fadd_s(mhat, dl); \
      _Pragma("unroll") for (int r = 0; r < 16; ++r) { P0[r] = fsub_s(P0[r], dl); P1[r] = fsub_s(P1[r], dl); } \
      _Pragma("unroll") for (int r = 0; r < 16; ++r) negm[r] = -mhat; asm volatile("" : "+v"(negm)); } \
    _Pragma("unroll") for (int r = 0; r < 16; ++r) P0[r] = __builtin_amdgcn_exp2f(P0[r]); } while (0)
#define RESC() do { if (resc) { asm volatile("s_waitcnt lgkmcnt(0)" ::: "memory"); \
      _Pragma("unroll") for (int d_ = 0; d_ < 2; ++d_) _Pragma("unroll") for (int r = 0; r < 16; ++r) o[d_][r] *= wsf[crow(r, hi)]; } } while (0)
    f32x16 pA0, pA1, pB0, pB1;
    int sl_prev = 0, sl_cur = 0, sl_next = SLOTB;
#define ROT() do { sl_prev = sl_cur; sl_cur = sl_next; sl_next = (sl_next == (NSLOT - 1) * SLOTB) ? 0 : sl_next + SLOTB; } while (0)
    DMA_K(2, 2 * SLOTB);
    WAIT_BAR(3);
    { bf16x8 qr[4]; qr[0] = QF(0); qr[1] = QF(1); qr[2] = QF(2); qr[3] = QF(3); qkt(pA0, pA1, Kbase, qr, negm, r32, hi); } asm volatile("s_nop 15\n\ts_nop 7" : "+v"(pA0), "+v"(pA1)); CMASK(pA0, pA1, 0);
    START(pA0, pA1);
    _Pragma("unroll") for (int r = 0; r < 16; ++r) pA1[r] = __builtin_amdgcn_exp2f(pA1[r]);
    WAIT_BAR(0);
    DMA_K(3, 0); DMA_V(1, SLOTB);
    ROT();
    kload8(kf, kp0 + sl_cur);
    WAIT_BAR(2);
    s16x4 vlo[8], vhi[8]; u32x4 pw0, pw1, pw2, pw3;
#define PKW(P, B) (cvtpk_s(P[B], P[B + 1]) & pmk)
#define PAF(k) __builtin_bit_cast(bf16x8, pw##k)
#define VFR(i) (bf16x8){vlo[i][0], vlo[i][1], vlo[i][2], vlo[i][3], vhi[i][0], vhi[i][1], vhi[i][2], vhi[i][3]}
#define PIN(x) asm volatile("" : "+v"(x))
#define MX3(a, b, c) __builtin_fmaxf(__builtin_fmaxf((a), (b)), (c))
#define GAPA(MF, A0, A1, A2, A3, W0, W1, PW) do { MF; sacc += A0; sacc += A1; sacc += A2; sacc += A3; PIN(sacc); W0; W1; PIN(PW); SBAR(); } while (0)
#define EX(v) __builtin_amdgcn_exp2f(v)
#define GAPB(MF, X, B) do { MF; X[B] = EX(X[B]); X[B + 1] = EX(X[B + 1]); X[B + 2] = EX(X[B + 2]); X[B + 3] = EX(X[B + 3]); PIN(X); SBAR(); } while (0)
#define VRD(i) do { vlo[i] = vtr(vp_ + (((i) >> 2) * 4096 + ((i) & 3) * 1024)); vhi[i] = vtr(vp_ + (((i) >> 2) * 4096 + ((i) & 3) * 1024 + 512)); } while (0)
#define KRD(G, j) do { if (G) { kload2(kf, kp0 + sl_next, j); SBAR(); } } while (0)
#define STEP(C0, C1, P0, P1, t, GK, GV, GL, FIRST) do { SBAR(); \
    const lds_cptr vp_ = vp0 + sl_prev; const unsigned cmk_ = SELMASK(t); \
    bf16x8 qa_ = QF(0), qb_ = QF(1); \
    VRD(0); SBAR(); float sacc = (P0[0] + P0[1]); \
    GAPA(C0 = __builtin_amdgcn_mfma_f32_32x32x16_bf16(kf[0], qa_, negm, 0, 0, 0), P0[2], P0[3], P0[4], P0[5],     pw0[0] = PKW(P0, 0), pw0[1] = PKW(P0, 2), pw0); \
    VRD(4); SBAR(); GAPA(C1 = __builtin_amdgcn_mfma_f32_32x32x16_bf16(kf[1], qa_, negm, 0, 0, 0), P0[6], P0[7], P0[8], P0[9],     pw0[2] = PKW(P0, 4), pw0[3] = PKW(P0, 6), pw0); \
    qa_ = QF(2); \
    VRD(1); SBAR(); GAPA(C0 = __builtin_amdgcn_mfma_f32_32x32x16_bf16(kf[2], qb_, C0, 0, 0, 0),   P0[10], P0[11], P0[12], P0[13], pw1[0] = PKW(P0, 8), pw1[1] = PKW(P0, 10), pw1); \
    VRD(5); SBAR(); GAPA(C1 = __builtin_amdgcn_mfma_f32_32x32x16_bf16(kf[3], qb_, C1, 0, 0, 0),   P0[14], P0[15], P1[0], P1[1],   pw1[2] = PKW(P0, 12), pw1[3] = PKW(P0, 14), pw1); \
    qb_ = QF(3); \
    VRD(2); SBAR(); GAPA(C0 = __builtin_amdgcn_mfma_f32_32x32x16_bf16(kf[4], qa_, C0, 0, 0, 0),   P1[2], P1[3], P1[4], P1[5],     pw2[0] = PKW(P1, 0), pw2[1] = PKW(P1, 2), pw2); \
    VRD(6); SBAR(); GAPA(C1 = __builtin_amdgcn_mfma_f32_32x32x16_bf16(kf[5], qa_, C1, 0, 0, 0),   P1[6], P1[7], P1[8], P1[9],     pw2[2] = PKW(P1, 4), pw2[3] = PKW(P1, 6), pw2); \
    VRD(3); SBAR(); GAPA(C0 = __builtin_amdgcn_mfma_f32_32x32x16_bf16(kf[6], qb_, C0, 0, 0, 0),   P1[10], P1[11], P1[12], P1[13], pw3[0] = PKW(P1, 8), pw3[1] = PKW(P1, 10), pw3); \
    VRD(7); SBAR(); GAPA(C1 = __builtin_amdgcn_mfma_f32_32x32x16_bf16(kf[7], qb_, C1, 0, 0, 0),   P1[14], P1[15], 0.f, 0.f,       pw3[2] = PKW(P1, 12), pw3[3] = PKW(P1, 14), pw3); \
    l_reg += __uint_as_float(__float_as_uint(sacc) & pmk); \
    if (GK) { DMA_K((t) + 3, sl_cur); } if (GV) { DMA_V((t) + 1, sl_next); } \
    CMASK(C0, C1, t); \
    { float a = MX3(C0[0], C0[1], C1[0]), b_ = MX3(C0[2], C0[3], C1[1]); a = MX3(a, C1[2], C1[3]); \
      _Pragma("unroll") for (int r = 4; r < 16; r += 4) { a = MX3(a, C0[r], C0[r + 1]); b_ = MX3(b_, C0[r + 2], C0[r + 3]); a = MX3(a, C1[r], C1[r + 1]); b_ = MX3(b_, C1[r + 2], C1[r + 3]); } \
      float rm = __builtin_fmaxf(a, b_); { auto rr = __builtin_amdgcn_permlane32_swap(__float_as_uint(rm), __float_as_uint(rm), false, false); rm = __builtin_fmaxf(__uint_as_float(rr[0]), __uint_as_float(rr[1])); } \
      if (MODE == M_SEL) rm = cmk_ ? rm : -__builtin_inff(); \
      resc = false; \
      const bool live_ = rm > -__builtin_inff(); const bool need_ = (FIRST) ? (live_ && (!seen || rm > (float)THRL)) : (rm > (float)THRL); \
      if (__builtin_expect(__any(need_), 0)) { const float dl = (FIRST) ? (need_ ? rm : 0.f) : __builtin_fmaxf(rm, 0.f); mhat += dl; \
        _Pragma("unroll") for (int r = 0; r < 16; ++r) { C0[r] -= dl; C1[r] -= dl; } \
        _Pragma("unroll") for (int r = 0; r < 16; ++r) negm[r] = -mhat; asm volatile("" : "+v"(negm)); \
        const float f = ((FIRST) && !seen) ? 1.0f : __builtin_amdgcn_exp2f(-dl); l_reg *= f; if (hi == 0) wsf[r32] = f; resc = true; } \
      if (FIRST) seen = seen || live_; } \
    SBAR(); \
    GAPB(o[0] = __builtin_amdgcn_mfma_f32_32x32x16_bf16(PAF(0), VFR(0), o[0], 0, 0, 0), C0, 0); \
    GAPB(o[1] = __builtin_amdgcn_mfma_f32_32x32x16_bf16(PAF(0), VFR(4), o[1], 0, 0, 0), C0, 4); \
    KRD(GL, 0); GAPB(o[0] = __builtin_amdgcn_mfma_f32_32x32x16_bf16(PAF(1), VFR(1), o[0], 0, 0, 0), C0, 8); \
    KRD(GL, 1); GAPB(o[1] = __builtin_amdgcn_mfma_f32_32x32x16_bf16(PAF(1), VFR(5), o[1], 0, 0, 0), C0, 12); \
    KRD(GL, 2); GAPB(o[0] = __builtin_amdgcn_mfma_f32_32x32x16_bf16(PAF(2), VFR(2), o[0], 0, 0, 0), C1, 0); \
    KRD(GL, 3); GAPB(o[1] = __builtin_amdgcn_mfma_f32_32x32x16_bf16(PAF(2), VFR(6), o[1], 0, 0, 0), C1, 4); \
    GAPB(o[0] = __builtin_amdgcn_mfma_f32_32x32x16_bf16(PAF(3), VFR(3), o[0], 0, 0, 0), C1, 8); \
    GAPB(o[1] = __builtin_amdgcn_mfma_f32_32x32x16_bf16(PAF(3), VFR(7), o[1], 0, 0, 0), C1, 12); \
    pmk = cmk_; \
    } while (0)
    int t = 1;
#define ENDW(tt) do { if ((tt) + 3 < NT) { WAIT_BAR(2); } else if ((tt) + 2 < NT) { WAIT_BAR(1); } else { WAIT_BAR(0); } } while (0)
    if (MODE != M_SEL) { if (lower) {
#pragma unroll 1
        for (int k_ = 0; k_ < 2 && t + 1 < NT; ++k_, t += 2) {
            STEP(pB0, pB1, pA0, pA1, t, (t + 3 < NT), (t + 1 < NT), (t + 1 < NT), true);         ENDW(t);     RESC(); ROT();
            STEP(pA0, pA1, pB0, pB1, t + 1, (t + 4 < NT), (t + 2 < NT), (t + 2 < NT), true);     ENDW(t + 1); RESC(); ROT();
        } } }
#undef CMASK
#define CMASK(P0, P1, t) do { } while (0)
    for (; t + 5 < NT; t += 2) {
        STEP(pB0, pB1, pA0, pA1, t, true, true, true, false);     WAIT_BAR(2); RESC(); ROT();
        STEP(pA0, pA1, pB0, pB1, t + 1, true, true, true, false); WAIT_BAR(2); RESC(); ROT();
    }
#undef CMASK
#define CMASK(P0, P1, t) MASK_T(P0, P1, t)
    for (; t + 1 < NT; t += 2) {
        STEP(pB0, pB1, pA0, pA1, t, (t + 3 < NT), (t + 1 < NT), (t + 1 < NT), false);         ENDW(t);     RESC(); ROT();
        STEP(pA0, pA1, pB0, pB1, t + 1, (t + 4 < NT), (t + 2 < NT), (t + 2 < NT), false);     ENDW(t + 1); RESC(); ROT();
    }
    STEP(pB0, pB1, pA0, pA1, NT - 1, false, false, false, false); RESC();
    { float sacc = pB0[0] + pB0[1]; _Pragma("unroll") for (int r = 2; r < 16; ++r) sacc += pB0[r]; _Pragma("unroll") for (int r = 0; r < 16; ++r) sacc += pB1[r]; l_reg += __uint_as_float(__float_as_uint(sacc) & pmk);
      pw0 = (u32x4){PKW(pB0, 0), PKW(pB0, 2), PKW(pB0, 4), PKW(pB0, 6)}; pw1 = (u32x4){PKW(pB0, 8), PKW(pB0, 10), PKW(pB0, 12), PKW(pB0, 14)}; pw2 = (u32x4){PKW(pB1, 0), PKW(pB1, 2), PKW(pB1, 4), PKW(pB1, 6)}; pw3 = (u32x4){PKW(pB1, 8), PKW(pB1, 10), PKW(pB1, 12), PKW(pB1, 14)};
      SBAR(); pv(o, vb0 + sl_cur, PAF(0), PAF(1), PAF(2), PAF(3)); }
#undef PKW
#undef PAF
#undef VFR
#undef PIN
#undef MX3
#undef GAPA
#undef GAPB
#undef EX
#undef VRD
#undef KRD
#undef STEP
#undef ENDW
    { auto rr = __builtin_amdgcn_permlane32_swap(__float_as_uint(l_reg), __float_as_uint(l_reg), false, false); l_reg = __uint_as_float(rr[0]) + __uint_as_float(rr[1]); }
    if (MODE == M_SWA) l_reg += exp2f(T.sinks[h] * LOG2E - mhat);
    if (hi == 0) { float gate = 1.0f; if (MODE != M_SWA) gate = T.GN[(size_t)(rowbase + q0 + qrel) * 24 + h * 3 + (MODE == M_SEL ? 1 : 2)]; wsf[32 + r32] = l_reg / gate; }
    asm volatile("s_waitcnt lgkmcnt(0)" ::: "memory");
    float rli[16];
#pragma unroll
    for (int r = 0; r < 16; ++r) rli[r] = __builtin_amdgcn_rcpf(wsf[32 + crow(r, hi)]);
    { bf16_t* Ow = T.OB + (rowbase + q0 + wid * QBLK) * 512 + h * 64; bf16_t* stg = (bf16_t*)(shm + LDS_OST) + wid * 2048;
#pragma unroll
      for (int r = 0; r < 16; ++r) { const int orow = crow(r, hi);
#pragma unroll
          for (int d0 = 0; d0 < 2; ++d0) stg[orow * 64 + d0 * 32 + r32] = (bf16_t)f2bf(o[d0][r] * rli[r]); }
      asm volatile("s_waitcnt lgkmcnt(0)" ::: "memory");
#pragma unroll
      for (int i = 0; i < 4; ++i) { const int row = i * 8 + (lane >> 3), ch = lane & 7; u32x4 v = *(const u32x4*)(stg + row * 64 + ch * 8);
          if (MODE == M_WIN && T.add0) {
              const long off = (long)(rowbase + q0 + wid * QBLK + row) * 512 + h * 64 + ch * 8; const u32x4 a = *(const u32x4*)(T.add0 + off), c = *(const u32x4*)(T.add1 + off);
#pragma unroll
              for (int q = 0; q < 4; ++q) v[q] = pk2(__uint_as_float(v[q] << 16) + __uint_as_float(a[q] << 16) + __uint_as_float(c[q] << 16), __uint_as_float(v[q] & 0xffff0000u) + __uint_as_float(a[q] & 0xffff0000u) + __uint_as_float(c[q] & 0xffff0000u)); }
          *(u32x4*)(Ow + (long)row * 512 + ch * 8) = v; } }
    asm volatile("s_waitcnt vmcnt(0) lgkmcnt(0)\n\ts_barrier" ::: "memory");
#undef DMA_K
#undef DMA_V
#undef CMASK
#undef MASK_T
#undef SELMASK
#undef QF
#undef START
#undef RESC
#undef ROT
}
constexpr int P_K = 0, P_V = 32768, P_WS = 65536, P_OST = P_WS + NW * 256, P_BYTES = P_OST + NW * 4096;
template <int MODE, int THRL> __device__ __forceinline__ void attn_unit_p(int b, int h, int qb, const Tens& T, char* shm) {
    const int tid = threadIdx.x, lane = tid & 63, r32 = lane & 31, hi = lane >> 5; const int wid = __builtin_amdgcn_readfirstlane(tid >> 6);
    const int bg = b * 2 + (h >> 2); const long rowbase = (long)b * SEQ; const int q0 = qb * QB;
    constexpr int W = (MODE == M_WIN) ? 512 : 128;
    const bool lower = (MODE != M_SEL) && (q0 + QB - 1 >= W);
    const int t0 = (MODE != M_SEL && q0 >= W) ? (q0 - W) / KVBLK : 0;
    const int NT = (q0 + QB) / KVBLK - t0;
    const int loff = q0 - W - t0 * KVBLK;
    const bf16_t* Qw = T.Q + (rowbase + q0 + wid * QBLK) * QP + h * 64;
    const bf16_t* Kh = T.K + ((long)bg * SEQ + (long)t0 * KVBLK) * KP; const bf16_t* Vh = T.V + ((long)bg * SEQ + (long)t0 * KVBLK) * KP;
    const unsigned lds0 = (unsigned)(uintptr_t)shm; const lds_cptr shm3 = (lds_cptr)shm;
    float* wsf = (float*)(shm + P_WS) + wid * 64;
    const bf16_t* ksrc = Kh + (long)lane * KP + wid * 8;
    const bf16_t* vsrc = Vh + (long)(16 * (wid & 3) + (lane >> 2)) * KP + (wid >> 2) * 32 + (lane & 3) * 8;
    const unsigned kdst = lds0 + P_K + wid * 1024, vdst = lds0 + P_V + wid * 1024;
#define DMA_KV(t, slot) do { glds16(ksrc + (long)(t) * KVBLK * KP, (unsigned)__builtin_amdgcn_readfirstlane(kdst + (slot))); glds16(vsrc + (long)(t) * KVBLK * KP, (unsigned)__builtin_amdgcn_readfirstlane(vdst + (slot))); } while (0)
    const lds_cptr kp0 = shm3 + P_K + hi * 1024 + r32 * 16;
    const lds_cptr vp0 = shm3 + P_V + ((lane >> 4) & 1) * 32 + (lane & 3) * 8 + (4 * hi + ((lane & 15) >> 2)) * 64;
    DMA_KV(0, 0); DMA_KV(1, 8192); DMA_KV(2, 16384);
    bf16x8 qr[4];
#pragma unroll
    for (int d0 = 0; d0 < 4; ++d0) qr[d0] = *reinterpret_cast<const bf16x8*>(&Qw[(long)r32 * QP + d0 * 16 + hi * 8]);
    const int qrel = wid * QBLK + r32;
    u32x4 sw = (u32x4){0u, 0u, 0u, 0u};
    if (MODE == M_SEL) sw = *(const u32x4*)(T.SEL + ((size_t)bg * SEQ + q0 + qrel) * 4);
#define SELM(t) ((MODE == M_SEL) ? (0u - ((((t) < 32 ? sw.x : (t) < 64 ? sw.y : (t) < 96 ? sw.z : sw.w) >> ((t) & 31)) & 1u)) : 0xffffffffu)
    float mhat = 0.f, l_reg = 0.f; bool seen = false; f32x16 o[2]; o[0] = f32x16{}; o[1] = f32x16{}; f32x16 negm = f32x16{}; asm volatile("" : "+v"(negm));
    const float NINF = -__builtin_inff();
#define KFR(slot, k) (*(const LAS bf16x8*)(kp0 + (slot) + ((k) >> 1) * 2048 + ((k) & 1) * 512))
#define MASKS(C0, C1, tt) do { const int jb_ = (tt) - (NT - 4); if (jb_ >= 0) cmask(C0, C1, jb_, qrel, hi); if (MODE != M_SEL) { if (lower && (tt) < 4) lmask(C0, C1, (tt), qrel + loff, hi); } } while (0)
#define REFUPD(C0, C1, rm) do { const bool live_ = (rm) > NINF; const bool need_ = live_ && (!seen || (rm) > (float)THRL); \
        if (__any(need_)) { const float dl_ = need_ ? (rm) : 0.f; mhat += dl_; \
            _Pragma("unroll") for (int r = 0; r < 16; ++r) { C0[r] -= dl_; C1[r] -= dl_; } \
            _Pragma("unroll") for (int r = 0; r < 16; ++r) negm[r] = -mhat; asm volatile("" : "+v"(negm)); \
            const float f_ = (need_ && seen) ? __builtin_amdgcn_exp2f(-dl_) : 1.0f; l_reg *= f_; if (hi == 0) wsf[r32] = f_; \
            asm volatile("s_waitcnt lgkmcnt(0)" ::: "memory"); \
            _Pragma("unroll") for (int d_ = 0; d_ < 2; ++d_) _Pragma("unroll") for (int r = 0; r < 16; ++r) o[d_][r] *= wsf[crow(r, hi)]; } \
        seen = seen || live_; } while (0)
#define ROWMAX(C0, C1, rm) do { float a_ = __builtin_fmaxf(__builtin_fmaxf(C0[0], C0[1]), C1[0]), c_ = __builtin_fmaxf(__builtin_fmaxf(C0[2], C0[3]), C1[1]); a_ = __builtin_fmaxf(__builtin_fmaxf(a_, C1[2]), C1[3]); \
        _Pragma("unroll") for (int r = 4; r < 16; r += 4) { a_ = __builtin_fmaxf(__builtin_fmaxf(a_, C0[r]), C0[r + 1]); c_ = __builtin_fmaxf(__builtin_fmaxf(c_, C0[r + 2]), C0[r + 3]); a_ = __builtin_fmaxf(__builtin_fmaxf(a_, C1[r]), C1[r + 1]); c_ = __builtin_fmaxf(__builtin_fmaxf(c_, C1[r + 2]), C1[r + 3]); } \
        rm = __builtin_fmaxf(a_, c_); auto rr_ = __builtin_amdgcn_permlane32_swap(__float_as_uint(rm), __float_as_uint(rm), false, false); rm = __builtin_fmaxf(__uint_as_float(rr_[0]), __uint_as_float(rr_[1])); } while (0)
    f32x16 pA0, pA1, pB0, pB1;
    asm volatile("s_waitcnt vmcnt(4) lgkmcnt(0)\n\ts_barrier" ::: "memory");
    qkt(pA0, pA1, shm + P_K, qr, negm, r32, hi);
    MASKS(pA0, pA1, 0);
    unsigned onm = SELM(0);
    { float rm; ROWMAX(pA0, pA1, rm); if (MODE == M_SEL) rm = onm ? rm : NINF; REFUPD(pA0, pA1, rm); }
    int sk_next = 8192, sv_cur = 0, s_n2 = 16384, s_free = 24576;
    u32x4 pw0, pw1, pw2, pw3;
#define PINV(x) asm volatile("" : "+v"(x))
#define EX4(P, B) do { P[B] = __builtin_amdgcn_exp2f(P[B]); P[B + 1] = __builtin_amdgcn_exp2f(P[B + 1]); P[B + 2] = __builtin_amdgcn_exp2f(P[B + 2]); P[B + 3] = __builtin_amdgcn_exp2f(P[B + 3]); sacc += (P[B] + P[B + 1]) + (P[B + 2] + P[B + 3]); } while (0)
#define PKW2(P, B, PW, I) do { PW[I] = cvtpk_s(P[B], P[B + 1]) & onm; PW[I + 1] = cvtpk_s(P[B + 2], P[B + 3]) & onm; } while (0)
#define VFRAG(i, sv) __builtin_bit_cast(s16x4, __builtin_amdgcn_ds_read_tr16_b64_v4i16((LAS v4i16_t*)(vp0 + (sv) + (((i) >> 2) * 4096 + ((i) & 3) * 1024))))
#define VFRAGH(i, sv) __builtin_bit_cast(s16x4, __builtin_amdgcn_ds_read_tr16_b64_v4i16((LAS v4i16_t*)(vp0 + (sv) + (((i) >> 2) * 4096 + ((i) & 3) * 1024 + 512))))
#define VF8(lo, hi_) (bf16x8){lo[0], lo[1], lo[2], lo[3], hi_[0], hi_[1], hi_[2], hi_[3]}
#define PSTEP(C0, C1, P0, P1, t, HN) do { \
        if ((t) > 0) { if ((t) + 2 < NT) asm volatile("s_waitcnt vmcnt(2) lgkmcnt(0)\n\ts_barrier" ::: "memory"); else asm volatile("s_waitcnt vmcnt(0) lgkmcnt(0)\n\ts_barrier" ::: "memory"); }     \
        if ((t) + 3 < NT) DMA_KV((t) + 3, s_free); \
        float sacc = 0.f; bf16x8 kf_; \
          \
        if (HN) { kf_ = KFR(sk_next, 0); C0 = __builtin_amdgcn_mfma_f32_32x32x16_bf16(kf_, qr[0], negm, 0, 0, 0); } EX4(P0, 0);  PKW2(P0, 0, pw0, 0);  PINV(sacc); PINV(pw0); SBAR(); \
        if (HN) { kf_ = KFR(sk_next, 1); C1 = __builtin_amdgcn_mfma_f32_32x32x16_bf16(kf_, qr[0], negm, 0, 0, 0); } EX4(P0, 4);  PKW2(P0, 4, pw0, 2);  PINV(sacc); PINV(pw0); SBAR(); \
        if (HN) { kf_ = KFR(sk_next, 2); C0 = __builtin_amdgcn_mfma_f32_32x32x16_bf16(kf_, qr[1], C0, 0, 0, 0); }   EX4(P0, 8);  PKW2(P0, 8, pw1, 0);  PINV(sacc); PINV(pw1); SBAR(); \
        if (HN) { kf_ = KFR(sk_next, 3); C1 = __builtin_amdgcn_mfma_f32_32x32x16_bf16(kf_, qr[1], C1, 0, 0, 0); }   EX4(P0, 12); PKW2(P0, 12, pw1, 2); PINV(sacc); PINV(pw1); SBAR(); \
        if (HN) { kf_ = KFR(sk_next, 4); C0 = __builtin_amdgcn_mfma_f32_32x32x16_bf16(kf_, qr[2], C0, 0, 0, 0); }   EX4(P1, 0);  PKW2(P1, 0, pw2, 0);  PINV(sacc); PINV(pw2); SBAR(); \
        if (HN) { kf_ = KFR(sk_next, 5); C1 = __builtin_amdgcn_mfma_f32_32x32x16_bf16(kf_, qr[2], C1, 0, 0, 0); }   EX4(P1, 4);  PKW2(P1, 4, pw2, 2);  PINV(sacc); PINV(pw2); SBAR(); \
        if (HN) { kf_ = KFR(sk_next, 6); C0 = __builtin_amdgcn_mfma_f32_32x32x16_bf16(kf_, qr[3], C0, 0, 0, 0); }   EX4(P1, 8);  PKW2(P1, 8, pw3, 0);  PINV(sacc); PINV(pw3); SBAR(); \
        if (HN) { kf_ = KFR(sk_next, 7); C1 = __builtin_amdgcn_mfma_f32_32x32x16_bf16(kf_, qr[3], C1, 0, 0, 0); }   EX4(P1, 12); PKW2(P1, 12, pw3, 2); PINV(sacc); PINV(pw3); SBAR(); \
        l_reg += __uint_as_float(__float_as_uint(sacc) & onm); \
        unsigned onn_ = 0xffffffffu; float rm_ = NINF; \
        if (HN) { MASKS(C0, C1, (t) + 1); onn_ = SELM((t) + 1); } \
          \
        { s16x4 vl_, vh_; \
          vl_ = VFRAG(0, sv_cur); vh_ = VFRAGH(0, sv_cur); o[0] = __builtin_amdgcn_mfma_f32_32x32x16_bf16(__builtin_bit_cast(bf16x8, pw0), VF8(vl_, vh_), o[0], 0, 0, 0); SBAR(); \
          vl_ = VFRAG(4, sv_cur); vh_ = VFRAGH(4, sv_cur); o[1] = __builtin_amdgcn_mfma_f32_32x32x16_bf16(__builtin_bit_cast(bf16x8, pw0), VF8(vl_, vh_), o[1], 0, 0, 0); SBAR(); \
          vl_ = VFRAG(1, sv_cur); vh_ = VFRAGH(1, sv_cur); o[0] = __builtin_amdgcn_mfma_f32_32x32x16_bf16(__builtin_bit_cast(bf16x8, pw1), VF8(vl_, vh_), o[0], 0, 0, 0); SBAR(); \
          vl_ = VFRAG(5, sv_cur); vh_ = VFRAGH(5, sv_cur); o[1] = __builtin_amdgcn_mfma_f32_32x32x16_bf16(__builtin_bit_cast(bf16x8, pw1), VF8(vl_, vh_), o[1], 0, 0, 0); SBAR(); \
          if (HN) { ROWMAX(C0, C1, rm_); } \
          vl_ = VFRAG(2, sv_cur); vh_ = VFRAGH(2, sv_cur); o[0] = __builtin_amdgcn_mfma_f32_32x32x16_bf16(__builtin_bit_cast(bf16x8, pw2), VF8(vl_, vh_), o[0], 0, 0, 0); SBAR(); \
          vl_ = VFRAG(6, sv_cur); vh_ = VFRAGH(6, sv_cur); o[1] = __builtin_amdgcn_mfma_f32_32x32x16_bf16(__builtin_bit_cast(bf16x8, pw2), VF8(vl_, vh_), o[1], 0, 0, 0); SBAR(); \
          vl_ = VFRAG(3, sv_cur); vh_ = VFRAGH(3, sv_cur); o[0] = __builtin_amdgcn_mfma_f32_32x32x16_bf16(__builtin_bit_cast(bf16x8, pw3), VF8(vl_, vh_), o[0], 0, 0, 0); SBAR(); \
          vl_ = VFRAG(7, sv_cur); vh_ = VFRAGH(7, sv_cur); o[1] = __builtin_amdgcn_mfma_f32_32x32x16_bf16(__builtin_bit_cast(bf16x8, pw3), VF8(vl_, vh_), o[1], 0, 0, 0); SBAR(); } \
        if (HN) { if (MODE == M_SEL) rm_ = onn_ ? rm_ : NINF; REFUPD(C0, C1, rm_); } \
        onm = onn_; { const int f_ = sv_cur; sv_cur = sk_next; sk_next = s_n2; s_n2 = s_free; s_free = f_; } \
    } while (0)
    int t = 0;
#pragma unroll 1
    for (; t + 2 < NT; t += 2) { PSTEP(pB0, pB1, pA0, pA1, t, true); PSTEP(pA0, pA1, pB0, pB1, t + 1, true); }
    PSTEP(pB0, pB1, pA0, pA1, t, true); PSTEP(pA0, pA1, pB0, pB1, t + 1, false);
#undef PSTEP
#undef VF8
#undef VFRAG
#undef VFRAGH
#undef PKW2
#undef EX4
#undef PINV
#undef ROWMAX
#undef REFUPD
#undef MASKS
#undef KFR
#undef SELM
    int lane_e = (int)__builtin_amdgcn_mbcnt_hi(~0u, __builtin_amdgcn_mbcnt_lo(~0u, 0u)); asm volatile("" : "+v"(lane_e));
    const int r32e = lane_e & 31, hie = lane_e >> 5, qrele = wid * QBLK + r32e;
    { auto rr = __builtin_amdgcn_permlane32_swap(__float_as_uint(l_reg), __float_as_uint(l_reg), false, false); l_reg = __uint_as_float(rr[0]) + __uint_as_float(rr[1]); }
    if (MODE == M_SWA) l_reg += exp2f(T.sinks[h] * LOG2E - mhat);
    if (hie == 0) { float gate = 1.0f; if (MODE != M_SWA) gate = T.GN[(size_t)(rowbase + q0 + qrele) * 24 + h * 3 + (MODE == M_SEL ? 1 : 2)]; wsf[32 + r32e] = l_reg / gate; }
    asm volatile("s_waitcnt lgkmcnt(0)" ::: "memory");
    float rli[16];
#pragma unroll
    for (int r = 0; r < 16; ++r) rli[r] = __builtin_amdgcn_rcpf(wsf[32 + crow(r, hie)]);
    { bf16_t* Ow = T.OB + (rowbase + q0 + wid * QBLK) * 512 + h * 64; bf16_t* stg = (bf16_t*)(shm + P_OST) + wid * 2048;
#pragma unroll
      for (int r = 0; r < 16; ++r) { const int orow = crow(r, hie);
#pragma unroll
          for (int d0 = 0; d0 < 2; ++d0) stg[orow * 64 + d0 * 32 + r32e] = (bf16_t)f2bf(o[d0][r] * rli[r]); }
      asm volatile("s_waitcnt lgkmcnt(0)" ::: "memory");
#pragma unroll
      for (int i = 0; i < 4; ++i) { const int row = i * 8 + (lane_e >> 3), ch = lane_e & 7; const u32x4 v = *(const u32x4*)(stg + row * 64 + ch * 8); *(u32x4*)(Ow + (long)row * 512 + ch * 8) = v; } }
    asm volatile("s_waitcnt vmcnt(0) lgkmcnt(0)\n\ts_barrier" ::: "memory");
#undef DMA_KV
}
#undef SBAR
#undef WAIT_BAR
}

__device__ __forceinline__ void phase_attn_fast(Frame& F, char* lds_generic) {
    unsigned char* ws = F.ws;
    const int vcu = (F.G % 8 == 0) ? (F.bid % 8) * (F.G / 8) + F.bid / 8 : F.bid;
    att::Tens Ts{(const bf16_t*)(ws + WS_QR), kv_tensor(ws, 2), kv_tensor(ws, 3), (const unsigned*)(ws + WS_SEL), (const float*)(ws + WS_GN), (bf16_t*)(ws + WS_OSEL), F.in[I_SINK]};
    att::Tens Tw = Ts; Tw.K = kv_tensor(ws, 4); Tw.V = kv_tensor(ws, 5); Tw.OB = (bf16_t*)(ws + WS_ONSA); Tw.add0 = (const bf16_t*)(ws + WS_OF32); Tw.add1 = (const bf16_t*)(ws + WS_OSEL);
    const int cls = (F.bid >> 3) & 3;
    for (int v = vcu; v < 256; v += F.G) {
        const int bh = v >> 4, s = v & 15, b = bh >> 3, h = bh & 7;
#pragma unroll 1
        for (int step = 0; step < 4; ++step) { const int qb = step < 2 ? 31 - s : s;
            if ((step & 1) == 0) att::attn_unit_t<att::M_SEL, 8>(b, h, qb, Ts, lds_generic);
            else att::attn_unit_t<att::M_WIN, 8>(b, h, qb, Tw, lds_generic);
            if (cls == step) { F.lane = fresh_lane(); F.tid = F.wave * 64 + F.lane; __syncthreads(); phase_prologue<1>(F); phase_prologue<2>(F); __syncthreads(); }
        }
    }
}

namespace cmpa {
using att::f32x16; using att::crow;
constexpr int C_K = 0, C_V = 65536, C_IMP = C_V + 16384, C_BYTES = C_IMP + 8 * 4096;
__device__ __forceinline__ u32x4 load_k(const bf16_t* Kg, int tau, int wid, int lane) { return *(const u32x4*)(Kg + (size_t)(64 * tau + lane) * 64 + wid * 8); }
__device__ __forceinline__ u32x4 load_v(const bf16_t* Vg, int tau, int wid, int lane) { return *(const u32x4*)(Vg + (size_t)(64 * tau + 16 * (wid & 3) + (lane >> 2)) * 64 + (wid >> 2) * 32 + (lane & 3) * 8); }
__device__ __forceinline__ float qx1(float v) { return __builtin_bit_cast(float, __builtin_amdgcn_mov_dpp(__builtin_bit_cast(int, v), 0xB1, 0xF, 0xF, true)); }
__device__ __forceinline__ float qx2(float v) { return __builtin_bit_cast(float, __builtin_amdgcn_mov_dpp(__builtin_bit_cast(int, v), 0x4E, 0xF, 0xF, true)); }
__device__ __forceinline__ void cmp_unit(int bg, int qb, unsigned char* ws, char* shm) {
    const int tid = threadIdx.x, lane = tid & 63, r32 = lane & 31, hi = lane >> 5; const int wid = __builtin_amdgcn_readfirstlane(tid >> 6);
    const int b = bg >> 1, g = bg & 1, ql = r32 >> 2, hh = r32 & 3;
    const int s = qb * 64 + wid * 8 + ql; const size_t tok = (size_t)b * SEQ + s;
    const int cmax = s < 31 ? -1 : (s - 31) >> 4;
    const int ntile = (4 * qb + 2) / 64 + 1;
    const bf16_t* Kg = (const bf16_t*)(ws + WS_KCMP) + (size_t)bg * 512 * 64; const bf16_t* Vg = (const bf16_t*)(ws + WS_VCMP) + (size_t)bg * 512 * 64;
    const unsigned lds0 = (unsigned)(uintptr_t)shm;
    float* IMPW = (float*)(shm + C_IMP) + wid * 1024;
    const float NINF = -__builtin_inff();
    __syncthreads();
    { u32x4 kt[8];
#pragma unroll
      for (int tau = 0; tau < 8; ++tau) if (tau < ntile) kt[tau] = load_k(Kg, tau, wid, lane);
#pragma unroll
      for (int tau = 0; tau < 8; ++tau) if (tau < ntile) *(u32x4*)(shm + C_K + tau * 8192 + wid * 1024 + lane * 16) = kt[tau]; }
    u32x4 vnext = load_v(Vg, 0, wid, lane);
    bf16x8 qr[4];
    { const bf16_t* qp = (const bf16_t*)(ws + WS_QC) + tok * 512 + (4 * g + hh) * 64 + hi * 8;
#pragma unroll
      for (int d0 = 0; d0 < 4; ++d0) qr[d0] = *(const bf16x8*)(qp + d0 * 16); }
#pragma unroll
    for (int i = 0; i < 16; ++i) IMPW[i * 64 + lane] = 0.f;
    f32x16 zero16 = f32x16{};
    __syncthreads();
    float m = NINF, l = 0.f;
#pragma unroll 1
    for (int tau = 0; tau < ntile; ++tau) {
        f32x16 p0, p1; att::qkt(p0, p1, shm + C_K + tau * 8192, qr, zero16, r32, hi);
        const int kb = 64 * tau + 4 * hi; float rm = NINF;
        if (tau >= ntile - 2) {
#pragma unroll
            for (int r = 0; r < 16; ++r) { const int c = kb + (r & 3) + 8 * (r >> 2); p0[r] = (c <= cmax) ? p0[r] : NINF; p1[r] = (c + 32 <= cmax) ? p1[r] : NINF; } }
#pragma unroll
        for (int r = 0; r < 16; ++r) rm = fmaxf(rm, fmaxf(p0[r], p1[r]));
        { auto rr = __builtin_amdgcn_permlane32_swap(__float_as_uint(rm), __float_as_uint(rm), false, false); rm = fmaxf(__uint_as_float(rr[0]), __uint_as_float(rr[1])); }
        const float mn = fmaxf(m, rm);
        if (mn > NINF) { float sacc = 0.f;
#pragma unroll
            for (int r = 0; r < 16; ++r) sacc += __builtin_amdgcn_exp2f(p0[r] - mn) + __builtin_amdgcn_exp2f(p1[r] - mn);
            l = l * __builtin_amdgcn_exp2f(m - mn) + sacc; m = mn; }
    }
    { auto rr = __builtin_amdgcn_permlane32_swap(__float_as_uint(l), __float_as_uint(l), false, false); l = __uint_as_float(rr[0]) + __uint_as_float(rr[1]); }
    const float rl = l > 0.f ? 1.0f / l : 0.f; const float mf = m > NINF ? m : 0.f;
    f32x16 o[2]; o[0] = f32x16{}; o[1] = f32x16{};
    float lcarry = 0.f;
    f32x16 negm16;
#pragma unroll
    for (int r = 0; r < 16; ++r) negm16[r] = -mf;
    const int vb0 = (int)(lds0 + C_V) + ((lane >> 4) & 1) * 32 + (lane & 3) * 8 + (4 * hi + ((lane & 15) >> 2)) * 64;
#pragma unroll 1
    for (int tau = 0; tau < ntile; ++tau) {
        const int vslot = (tau & 1) * 8192;
        *(u32x4*)(shm + C_V + vslot + wid * 1024 + lane * 16) = vnext;
        if (tau + 1 < ntile) vnext = load_v(Vg, tau + 1, wid, lane);
        __syncthreads();
        f32x16 p0, p1; att::qkt(p0, p1, shm + C_K + tau * 8192, qr, negm16, r32, hi);
        const int kb = 64 * tau + 4 * hi;
#pragma unroll
        for (int r = 0; r < 16; ++r) { p0[r] = __builtin_amdgcn_exp2f(p0[r]); p1[r] = __builtin_amdgcn_exp2f(p1[r]); }
        if (tau >= ntile - 2) {
#pragma unroll
            for (int r = 0; r < 16; ++r) { const int c = kb + (r & 3) + 8 * (r >> 2); p0[r] = (c <= cmax) ? p0[r] : 0.f; p1[r] = (c + 32 <= cmax) ? p1[r] : 0.f; } }
        float G[8], L[8];
#pragma unroll
        for (int k = 0; k < 4; ++k) { G[k] = ((p0[4 * k] + p0[4 * k + 1]) + (p0[4 * k + 2] + p0[4 * k + 3])) * rl; L[k] = p0[4 * k + 3] * rl; G[4 + k] = ((p1[4 * k] + p1[4 * k + 1]) + (p1[4 * k + 2] + p1[4 * k + 3])) * rl; L[4 + k] = p1[4 * k + 3] * rl; }
#pragma unroll
        for (int k = 0; k < 8; ++k) { G[k] += qx1(G[k]); G[k] += qx2(G[k]); L[k] += qx1(L[k]); L[k] += qx2(L[k]); }
        { float Lo[8];
#pragma unroll
          for (int k = 0; k < 8; ++k) { auto rr = __builtin_amdgcn_permlane32_swap(__float_as_uint(L[k]), __float_as_uint(L[k]), false, false); Lo[k] = __uint_as_float(hi ? rr[0] : rr[1]); }
#pragma unroll
          for (int k = 0; k < 8; ++k) { const float prev = hi ? Lo[k] : (k == 0 ? lcarry : Lo[k - 1]); G[k] += prev; }
          lcarry = Lo[7];
          if (hh == 0) {
#pragma unroll
              for (int k = 0; k < 8; ++k) { const int j = 16 * tau + (k < 4 ? 2 * k + hi : 8 + 2 * (k - 4) + hi); IMPW[ql * 128 + j] = G[k]; } } }
        u32x4 pw0, pw1, pw2, pw3;
        pw0 = (u32x4){att::cvtpk_s(p0[0], p0[1]), att::cvtpk_s(p0[2], p0[3]), att::cvtpk_s(p0[4], p0[5]), att::cvtpk_s(p0[6], p0[7])};
        pw1 = (u32x4){att::cvtpk_s(p0[8], p0[9]), att::cvtpk_s(p0[10], p0[11]), att::cvtpk_s(p0[12], p0[13]), att::cvtpk_s(p0[14], p0[15])};
        pw2 = (u32x4){att::cvtpk_s(p1[0], p1[1]), att::cvtpk_s(p1[2], p1[3]), att::cvtpk_s(p1[4], p1[5]), att::cvtpk_s(p1[6], p1[7])};
        pw3 = (u32x4){att::cvtpk_s(p1[8], p1[9]), att::cvtpk_s(p1[10], p1[11]), att::cvtpk_s(p1[12], p1[13]), att::cvtpk_s(p1[14], p1[15])};
        __builtin_amdgcn_sched_barrier(0);
        att::pv(o, vb0 + vslot, __builtin_bit_cast(bf16x8, pw0), __builtin_bit_cast(bf16x8, pw1), __builtin_bit_cast(bf16x8, pw2), __builtin_bit_cast(bf16x8, pw3));
    }
    { const float* GN = (const float*)(ws + WS_GN); bf16_t* OF = (bf16_t*)(ws + WS_OF32);
      float* RLW = (float*)(shm + C_BYTES) + wid * 32;
      if (hi == 0) RLW[r32] = rl;
      WSYNC();
      float rlrow[16];
#pragma unroll
      for (int r = 0; r < 16; ++r) rlrow[r] = RLW[crow(r, hi)];
#pragma unroll
      for (int r = 0; r < 16; ++r) { const int row = crow(r, hi), q2 = row >> 2, h2 = row & 3; const size_t t2 = (size_t)b * SEQ + qb * 64 + wid * 8 + q2;
          const float g0 = GN[t2 * 24 + (4 * g + h2) * 3] * rlrow[r];
          const float v0 = o[0][r] * g0, v1 = o[1][r] * g0, w0 = qx1(v0), w1 = qx1(v1);
          if ((lane & 1) == 0) { *(unsigned*)(OF + t2 * 512 + (4 * g + h2) * 64 + r32) = pk2(v0, w0); *(unsigned*)(OF + t2 * 512 + (4 * g + h2) * 64 + 32 + r32) = pk2(v1, w1); } } }
    WSYNC();
    const int cur = qb; const unsigned long long lt = (lane == 0) ? 0ull : (~0ull >> (64 - lane));
    unsigned k0[8], k1[8], T[8];
#pragma unroll
    for (int q = 0; q < 8; ++q) {
        float v0 = IMPW[q * 128 + lane], v1 = IMPW[q * 128 + 64 + lane];
        { const int j0 = lane, j1 = lane + 64;
          if (j0 > cur) v0 = -1.0f; else if (j0 == 0 || j0 == cur || j0 == cur - 1) v0 = 1e6f;
          if (j1 > cur) v1 = -1.0f; else if (j1 == cur || j1 == cur - 1) v1 = 1e6f; }
        const unsigned u0 = __float_as_uint(v0), u1 = __float_as_uint(v1);
        k0[q] = (u0 & 0x80000000u) ? ~u0 : (u0 | 0x80000000u); k1[q] = (u1 & 0x80000000u) ? ~u1 : (u1 | 0x80000000u); T[q] = 0u;
    }
#pragma unroll 1
    for (int bit = 31; bit >= 0; --bit) {
#pragma unroll
        for (int q = 0; q < 8; ++q) { const unsigned cand = T[q] | (1u << bit); const int cnt = __popcll(__ballot(k0[q] >= cand)) + __popcll(__ballot(k1[q] >= cand)); T[q] = (cnt >= 16) ? cand : T[q]; }
    }
#pragma unroll
    for (int q = 0; q < 8; ++q) {
        const bool gt0 = k0[q] > T[q], gt1 = k1[q] > T[q], eq0 = k0[q] == T[q], eq1 = k1[q] == T[q];
        const int need = 16 - (__popcll(__ballot(gt0)) + __popcll(__ballot(gt1)));
        const unsigned long long be0 = __ballot(eq0), be1 = __ballot(eq1);
        const bool s0 = (gt0 || (eq0 && __popcll(be0 & lt) < need)) && (lane <= cur);
        const bool s1 = (gt1 || (eq1 && (__popcll(be0) + __popcll(be1 & lt)) < need)) && (lane + 64 <= cur);
        const unsigned long long m0 = __ballot(s0), m1 = __ballot(s1);
        if (lane == 0) { u32x4 w; w.x = (unsigned)m0; w.y = (unsigned)(m0 >> 32); w.z = (unsigned)m1; w.w = (unsigned)(m1 >> 32); *(u32x4*)(ws + WS_SEL + ((size_t)bg * SEQ + qb * 64 + wid * 8 + q) * 16) = w; }
    }
    WSYNC();
}
}
__device__ __forceinline__ void phase_cmp_attn(Frame& F, char* lds_generic) {
    const int vcu = (F.G % 8 == 0) ? (F.bid % 8) * (F.G / 8) + F.bid / 8 : F.bid;
    for (int v = vcu; v < 256; v += F.G) { const int bg = v >> 6, sidx = v & 63;
        cmpa::cmp_unit(bg, 127 - sidx, F.ws, lds_generic);
        cmpa::cmp_unit(bg, sidx, F.ws, lds_generic); }
}

__device__ __forceinline__ void phase_cmp_swa(Frame& F, char* lds_generic) {
    unsigned char* ws = F.ws;
    att::Tens Ta{(const bf16_t*)(ws + WS_QS), kv_tensor(ws, 6), kv_tensor(ws, 7), (const unsigned*)(ws + WS_SEL), (const float*)(ws + WS_GN), (bf16_t*)(ws + WS_OSWA), F.in[I_SINK]};
    const int ncmp = F.G >= 64 ? 32 : 0;
    if (F.bid < ncmp || ncmp == 0) {
        for (int u = F.bid; u < 32; u += (ncmp ? ncmp : F.G)) {
            cmp1_unit(F, u);
            VM_WAIT(); __syncthreads();
            if (F.tid == 0) { __builtin_amdgcn_fence(__ATOMIC_ACQUIRE, "agent"); VM_WAIT(); }
            __syncthreads();
            cmp2_unit(F, u);
        }
    }
    if (F.bid >= ncmp) {
        const int nw = F.G - ncmp;
        for (int v = F.bid - ncmp; v < 512; v += nw) { const int bh = v >> 5, qb = v & 31; att::attn_unit<att::M_SWA, 8>(bh >> 3, bh & 7, qb, Ta, lds_generic); }
    }
}

__device__ __forceinline__ void phase_branch(Frame& F) {
    static_assert(WS_OSWA - WS_ONSA == (size_t)NTOK * 512 * 2 && WS_WBRS - WS_WBRN == (size_t)1024 * 512 * 2, "SWA operands stacked right behind the NSA ones");
    pg8::Gemm g{(const bf16_t*)(F.ws + WS_ONSA), (const bf16_t*)(F.ws + WS_WBRN), 2 * NTOK, 2 * 1024, 512};
    pg8::BranchOrder S; S.so.init(NTOK, 1024, F.G, F.bid);
    pg8::EpiBranch E{(const unsigned char*)(F.ws + WS_GM), (bf16_t*)(F.ws + WS_MIXED)};
    pg8::gemm_phase<pg8::EpiBranch, pg8::BranchOrder, true, true>(F.lds, g, S, E);
}

__device__ __forceinline__ void phase_wout(Frame& F) {
    pg8::Gemm g{(const bf16_t*)(F.ws + WS_MIXED), (const bf16_t*)(F.ws + WS_WOUT), NTOK, 1024, 1024};
    pg8::StaticOrder S; S.init(NTOK, 1024, F.G, F.bid);
    pg8::EpiResid E{F.in[I_X], (bf16_t*)(F.ws + WS_ZB)};
    pg8::gemm_phase<pg8::EpiResid, pg8::StaticOrder, true, true>(F.lds, g, S, E);
}

constexpr int WRP_LD = 33;
__device__ __forceinline__ void phase_ln_route(Frame& F) {
    bf16_t* const HB16 = (bf16_t*)(F.ws + WS_HB16); bf16_t* const HBOUT = (bf16_t*)(F.ws + WS_HB);
    unsigned char* ws = F.ws;
    LAS float* WRP = (LAS float*)F.lds;
    LAS float* LG = (LAS float*)(F.lds + 1024 * WRP_LD * 4);
    const int lane = F.lane;
    const float* G1 = F.in[I_LN1G]; const float* B1 = F.in[I_LN1B]; const float* BR = F.in[I_BR];
    LAS float* STAT = (LAS float*)(F.lds + 143872);
    { const float* src = F.in[I_WR]; const int e = F.tid & 31, part = F.tid >> 5; float a1 = 0.f, a2 = 0.f;
#pragma unroll 8
      for (int j = 0; j < 64; ++j) { const int k = part + 16 * j; const float w = src[k * 32 + e], gw = w * G1[k]; WRP[k * WRP_LD + e] = gw; a1 += gw; a2 += w * B1[k]; }
      LG[part * 32 + e] = a1; LG[512 + part * 32 + e] = a2; }
    __syncthreads();
    if (F.tid < 64) { const int e = F.tid & 31, wh = F.tid >> 5; float sacc = 0.f;
#pragma unroll
        for (int p2 = 0; p2 < 16; ++p2) sacc += LG[wh * 512 + p2 * 32 + e];
        STAT[128 + wh * 32 + e] = sacc; }
    __syncthreads();
    gu32* ctl = (gu32*)(ws + WS_CTL);
    int* TOPE = (int*)(ws + WS_TOPE); float* TOPG = (float*)(ws + WS_TOPG); int* TOPP = (int*)(ws + WS_TOPP); int* TOK = (int*)(ws + WS_TOK);
    for (int tb = F.bid; tb < NTOK / 64; tb += F.G) {
        u32x4 zw8[8][2];
#pragma unroll
        for (int i = 0; i < 8; ++i) { const bf16_t* zr = (const bf16_t*)(ws + WS_ZB) + (size_t)(tb * 64 + F.wave * 8 + i) * 1024;
#pragma unroll
            for (int j2 = 0; j2 < 2; ++j2) zw8[i][j2] = *(const u32x4*)(zr + 8 * (lane + 64 * j2)); }
        f32x4 gg1[2][2], bb1[2][2];
#pragma unroll
        for (int j2 = 0; j2 < 2; ++j2)
#pragma unroll
            for (int q = 0; q < 2; ++q) { const int c0 = 8 * (lane + 64 * j2); gg1[j2][q] = *(const f32x4*)(G1 + c0 + 4 * q); bb1[j2][q] = *(const f32x4*)(B1 + c0 + 4 * q); }
        __builtin_amdgcn_sched_barrier(0);
#pragma unroll
        for (int i = 0; i < 8; ++i) {
            const int t = tb * 64 + F.wave * 8 + i;
            f32x4 v[4]; float s = 0.f;
#pragma unroll
            for (int j2 = 0; j2 < 2; ++j2) { const u32x4 w = zw8[i][j2];
                v[2 * j2] = (f32x4){__uint_as_float(w.x << 16), __uint_as_float(w.x & 0xffff0000u), __uint_as_float(w.y << 16), __uint_as_float(w.y & 0xffff0000u)};
                v[2 * j2 + 1] = (f32x4){__uint_as_float(w.z << 16), __uint_as_float(w.z & 0xffff0000u), __uint_as_float(w.w << 16), __uint_as_float(w.w & 0xffff0000u)}; }
#pragma unroll
            for (int j = 0; j < 4; ++j) s += (v[j].x + v[j].y) + (v[j].z + v[j].w);
            const float mean = wave_sum(s) * (1.0f / 1024.0f); float s2 = 0.f;
#pragma unroll
            for (int j = 0; j < 4; ++j) { v[j] = v[j] - mean; s2 += (v[j].x * v[j].x + v[j].y * v[j].y) + (v[j].z * v[j].z + v[j].w * v[j].w); }
            const float rstd = 1.0f / sqrtf(wave_sum(s2) * (1.0f / 1024.0f) + LN_EPS);
            if (lane == 0) { STAT[F.wave * 8 + i] = mean; STAT[64 + F.wave * 8 + i] = rstd; }
#pragma unroll
            for (int j2 = 0; j2 < 2; ++j2) { const int c0 = 8 * (lane + 64 * j2); f32x4 h[2];
#pragma unroll
                for (int q = 0; q < 2; ++q) h[q] = v[2 * j2 + q] * rstd * gg1[j2][q] + bb1[j2][q];
                *(u32x4*)(HB16 + (size_t)t * 1024 + c0) = pg8::pack8(h[0], h[1]);
                u32x2 w8;
                w8.x = f4_to_fp8(fminf(fmaxf(h[0].x, -448.f), 448.f), fminf(fmaxf(h[0].y, -448.f), 448.f), fminf(fmaxf(h[0].z, -448.f), 448.f), fminf(fmaxf(h[0].w, -448.f), 448.f));
                w8.y = f4_to_fp8(fminf(fmaxf(h[1].x, -448.f), 448.f), fminf(fmaxf(h[1].y, -448.f), 448.f), fminf(fmaxf(h[1].z, -448.f), 448.f), fminf(fmaxf(h[1].w, -448.f), 448.f));
                *(u32x2*)((unsigned char*)HBOUT + (size_t)t * 1024 + c0) = w8; }
        }
        __syncthreads();
        { const int tg = F.wave >> 1, eh = F.wave & 1, kk = lane >> 4, n = lane & 15;
          const bf16_t* zrow = (const bf16_t*)(ws + WS_ZB) + (size_t)(tb * 64 + tg * 16 + n) * 1024 + 4 * kk;
          const LAS float* wcol = WRP + (4 * kk) * WRP_LD + eh * 16 + n;
          f32x4 acc = (f32x4){0.f, 0.f, 0.f, 0.f};
#pragma unroll 4
          for (int s4 = 0; s4 < 64; ++s4) { const u32x2 zw = *(const u32x2*)(zrow + 16 * s4); const f32x4 a = {__uint_as_float(zw.x << 16), __uint_as_float(zw.x & 0xffff0000u), __uint_as_float(zw.y << 16), __uint_as_float(zw.y & 0xffff0000u)}; const LAS float* wp = wcol + 16 * s4 * WRP_LD;
              acc = __builtin_amdgcn_mfma_f32_16x16x4f32(a.x, wp[0], acc, 0, 0, 0);
              acc = __builtin_amdgcn_mfma_f32_16x16x4f32(a.y, wp[WRP_LD], acc, 0, 0, 0);
              acc = __builtin_amdgcn_mfma_f32_16x16x4f32(a.z, wp[2 * WRP_LD], acc, 0, 0, 0);
              acc = __builtin_amdgcn_mfma_f32_16x16x4f32(a.w, wp[3 * WRP_LD], acc, 0, 0, 0); }
          const int ee = eh * 16 + n; const float br = BR[ee] + STAT[160 + ee], c1 = STAT[128 + ee];
#pragma unroll
          for (int r = 0; r < 4; ++r) { const int tt = tg * 16 + 4 * kk + r; LG[tt * WRP_LD + ee] = STAT[64 + tt] * (acc[r] - STAT[tt] * c1) + br; } }
        __syncthreads();
        LAS int* lcnt = (LAS int*)(LG + 64 * WRP_LD); LAS int* lbase = lcnt + 32;
        if (F.tid < 32) lcnt[F.tid] = 0;
        __syncthreads();
        int be[4], lpos[4]; float gk[4];
        if (F.tid < 64) {
            float lg[32];
#pragma unroll
            for (int e = 0; e < 32; ++e) lg[e] = LG[F.tid * WRP_LD + e];
            float bv[4];
#pragma unroll
            for (int k = 0; k < 4; ++k) { float best = -__builtin_inff(); int bi = 0;
#pragma unroll
                for (int e = 0; e < 32; ++e) if (lg[e] > best) { best = lg[e]; bi = e; }
                be[k] = bi; bv[k] = best;
#pragma unroll
                for (int e = 0; e < 32; ++e) if (e == bi) lg[e] = -__builtin_inff(); }
            const float e1 = __expf(bv[1] - bv[0]), e2 = __expf(bv[2] - bv[0]), e3 = __expf(bv[3] - bv[0]); const float rs = 1.0f / (1.0f + e1 + e2 + e3);
            gk[0] = rs; gk[1] = e1 * rs; gk[2] = e2 * rs; gk[3] = e3 * rs;
#pragma unroll
            for (int k = 0; k < 4; ++k) lpos[k] = __hip_atomic_fetch_add(lcnt + be[k], 1, __ATOMIC_RELAXED, __HIP_MEMORY_SCOPE_WORKGROUP);
        }
        __syncthreads();
        if (F.tid < 32) { const int c = lcnt[F.tid]; lbase[F.tid] = (c > 0) ? (int)__hip_atomic_fetch_add(ctl + CW_CNT + 64 * F.tid, (unsigned)c, RLX_AGENT) : 0; }
        __syncthreads();
        if (F.tid < 64) { const int t = tb * 64 + F.tid;
#pragma unroll
            for (int k = 0; k < 4; ++k) { const int pos = lbase[be[k]] + lpos[k];
                TOK[be[k] * NTOK + pos] = t; TOPE[t * 4 + k] = be[k]; TOPP[t * 4 + k] = pos; TOPG[t * 4 + k] = gk[k]; } }
        __syncthreads();
    }
}

constexpr int EMAP_OFF = 131072;
__device__ __forceinline__ void load_expert_map(Frame& F, LAS int* cnt_s, LAS int* base_s) {
    if (F.tid < NEXP) cnt_s[F.tid] = (int)__hip_atomic_load((gu32*)(F.ws + WS_CTL) + CW_CNT + 64 * F.tid, RLX_AGENT);
    __syncthreads();
    if (F.tid == 0) { int acc = 0; for (int e = 0; e < NEXP; ++e) { base_s[e] = acc; acc += (cnt_s[e] + MOE_RT - 1) / MOE_RT; } base_s[NEXP] = acc; }
    __syncthreads();
    if (F.tid < base_s[NEXP]) { int e = 0;
#pragma unroll 1
        for (int k = 1; k < NEXP; ++k) if (base_s[k] <= F.tid) e = k;
        base_s[64 + F.tid] = e; }
    __syncthreads();
}
__device__ __forceinline__ void phase_expert_up(Frame& F) {
    LAS int* cnt_s = (LAS int*)(F.lds + EMAP_OFF); LAS int* base_s = cnt_s + 64;
    load_expert_map(F, cnt_s, base_s);
    const int ntiles = base_s[NEXP];
    pg8::Gemm g{(const bf16_t*)(F.ws + WS_HB), (const bf16_t*)(F.ws + WS_WEIN), ntiles * 256, NEXP * 2048, 512, (const unsigned char*)(F.ws + WS_SC1)};
    pg8::ExpertOrder<true> S{base_s, ntiles, 8, F.G, F.bid, cnt_s, (const int*)(F.ws + WS_TOK)};
    pg8::EpiSwiGLU E{F.in[I_BEIN], (unsigned char*)(F.ws + WS_ACT)};
    pg8::gemm_phase<pg8::EpiSwiGLU, pg8::ExpertOrder<true>, true, true, true, false>(F.lds, g, S, E);
}
__device__ __forceinline__ void phase_expert_down(Frame& F) {
    LAS int* cnt_s = (LAS int*)(F.lds + EMAP_OFF); LAS int* base_s = cnt_s + 64;
    load_expert_map(F, cnt_s, base_s);
    const int ntiles = base_s[NEXP];
    pg8::Gemm g{(const bf16_t*)(F.ws + WS_ACT), (const bf16_t*)(F.ws + WS_WEOUT), ntiles * 256, NEXP * 1024, 512, (const unsigned char*)(F.ws + WS_SC2)};
    pg8::ExpertOrder<false> S{base_s, ntiles, 4, F.G, F.bid, cnt_s, nullptr};
    pg8::EpiDown E{F.in[I_BEOUT], (bf16_t*)(F.ws + WS_YS)};
    pg8::gemm_phase<pg8::EpiDown, pg8::ExpertOrder<false>, true, true, true, false>(F.lds, g, S, E);
}

__device__ __forceinline__ void phase_final(Frame& F) {
    float* const OUTP = F.out;
    unsigned char* ws = F.ws;
    LAS int* cnt_s = (LAS int*)(F.lds + EMAP_OFF); LAS int* base_s = cnt_s + 64;
    load_expert_map(F, cnt_s, base_s);
    const int lane = F.lane, gw = F.bid * NWAVES + F.wave, NGW = F.G * NWAVES;
    const int* TOPE = (const int*)(ws + WS_TOPE); const float* TOPG = (const float*)(ws + WS_TOPG); const int* TOPP = (const int*)(ws + WS_TOPP);
    const bf16_t* YS = (const bf16_t*)(ws + WS_YS); const float* G2 = F.in[I_LN2G]; const float* B2 = F.in[I_LN2B];
    const unsigned char* YS8 = (const unsigned char*)YS;
    f32x4 gg[4], bb[4];
#pragma unroll
    for (int j = 0; j < 4; ++j) { const int c0 = 4 * (lane + 64 * j); gg[j] = *(const f32x4*)(G2 + c0); bb[j] = *(const f32x4*)(B2 + c0); }
    constexpr int TB = 4;
    for (int t0 = gw; t0 < NTOK; t0 += TB * NGW) {
        u32x2 hw[TB][4]; unsigned yw[TB][4][4]; float gk[TB][4];
#pragma unroll
        for (int b = 0; b < TB; ++b) { const int t = t0 + b * NGW, tt = t < NTOK ? t : NTOK - 1;
            const bf16_t* hr = (const bf16_t*)(ws + WS_HB16) + (size_t)tt * 1024;
#pragma unroll
            for (int j = 0; j < 4; ++j) hw[b][j] = *(const u32x2*)(hr + 4 * (lane + 64 * j));
#pragma unroll
            for (int k = 0; k < 4; ++k) { const int e = TOPE[tt * 4 + k]; gk[b][k] = TOPG[tt * 4 + k] * 0.0625f; const size_t row = (size_t)base_s[e] * MOE_RT + TOPP[tt * 4 + k];
#pragma unroll
                for (int j = 0; j < 4; ++j) yw[b][k][j] = *(const unsigned*)(YS8 + row * 1024 + 4 * (lane + 64 * j)); } }
        __builtin_amdgcn_sched_barrier(0);
#pragma unroll
        for (int b = 0; b < TB; ++b) { const int t = t0 + b * NGW; if (t >= NTOK) break;
            f32x4 v[4];
#pragma unroll
            for (int j = 0; j < 4; ++j) { const u32x2 h2 = hw[b][j]; v[j] = (f32x4){__uint_as_float(h2.x << 16), __uint_as_float(h2.x & 0xffff0000u), __uint_as_float(h2.y << 16), __uint_as_float(h2.y & 0xffff0000u)} * DN_ALPHA; }
#pragma unroll
            for (int k = 0; k < 4; ++k) { const float g = gk[b][k];
#pragma unroll
                for (int j = 0; j < 4; ++j) { const int w = (int)yw[b][k][j];
                    v[j].x += g * __builtin_amdgcn_cvt_f32_fp8(w, 0); v[j].y += g * __builtin_amdgcn_cvt_f32_fp8(w, 1); v[j].z += g * __builtin_amdgcn_cvt_f32_fp8(w, 2); v[j].w += g * __builtin_amdgcn_cvt_f32_fp8(w, 3); } }
            float s = 0.f;
#pragma unroll
            for (int j = 0; j < 4; ++j) s += (v[j].x + v[j].y) + (v[j].z + v[j].w);
            const float mean = wave_sum(s) * (1.0f / 1024.0f); float s2 = 0.f;
#pragma unroll
            for (int j = 0; j < 4; ++j) { v[j] = v[j] - mean; s2 += (v[j].x * v[j].x + v[j].y * v[j].y) + (v[j].z * v[j].z + v[j].w * v[j].w); }
            const float rstd = 1.0f / sqrtf(wave_sum(s2) * (1.0f / 1024.0f) + LN_EPS);
#pragma unroll
            for (int j = 0; j < 4; ++j) { const int c0 = 4 * (lane + 64 * j); *(f32x4*)(OUTP + (size_t)t * 1024 + c0) = v[j] * rstd * gg[j] + bb[j]; }
        }
    }
}

constexpr int N_PHASES = 11;
__global__ void __launch_bounds__(NTHREADS, 2) mk_fwd(Args args) {
    extern __shared__ __attribute__((aligned(16))) unsigned char lds_raw[];
    Frame F;
    F.lds = (LAS unsigned char*)lds_raw; F.ws = args.ws; F.in = args.in; F.out = args.out;
    F.tid = threadIdx.x; F.lane = F.tid & 63; F.wave = __builtin_amdgcn_readfirstlane(F.tid >> 6); F.G = gridDim.x; F.bid = blockIdx.x;
    volatile LAS unsigned* MISC = (volatile LAS unsigned*)(F.lds + MISC_OFF);
    if (F.tid < 64) MISC[F.tid] = 0u;
    __syncthreads();
    const int lo = args.ph_lo, hi = args.ph_hi;
    XcdBarrier bar; bar.bar = (unsigned*)(args.ws + WS_CTL) + CW_BAR; bar.x = 0; bar.st = nullptr;
    if (hi - lo > 1) bar = xcd_barrier_post((unsigned*)(args.ws + WS_CTL) + CW_BAR, MISC + 8);
#define IN(k) (lo <= (k) && (k) < hi)
#define SEAM(k) do { if (IN(k) && IN((k) + 1)) xcd_barrier(bar); F.lane = fresh_lane(); F.tid = F.wave * 64 + F.lane; } while (0)
    if (IN(0)) { phase_prologue<0>(F); SEAM(0); }
    if (IN(1)) { phase_inproj(F); SEAM(1); }
    if (IN(2)) { phase_cmp_swa(F, (char*)lds_raw); SEAM(2); }
    if (IN(3)) { phase_cmp_attn(F, (char*)lds_raw); SEAM(3); }
    if (IN(4)) { phase_attn_fast(F, (char*)lds_raw); SEAM(4); }
    if (IN(5)) { phase_branch(F); SEAM(5); }
    if (IN(6)) { phase_wout(F); SEAM(6); }
    if (IN(7)) { phase_ln_route(F); SEAM(7); }
    if (IN(8)) { phase_expert_up(F); SEAM(8); }
    if (IN(9)) { phase_expert_down(F); SEAM(9); }
    if (IN(10)) { phase_final(F); }
#undef IN
#undef SEAM
}

extern "C" void kernel_launch(void* const* d_in, const int* in_sizes, int n_in, void* d_out, int out_size, void* d_ws, size_t ws_size, hipStream_t stream) {
    static int grid = 0;
    if (grid == 0) {
        if (n_in != N_IN || out_size != NTOK * DM || ws_size < WS_END) { fprintf(stderr, "kernel_launch: unexpected shapes (n_in %d, out %d, ws %zu)\n", n_in, out_size, ws_size); grid = -1; return; }
        int dev = 0, cus = 0;
        if (hipGetDevice(&dev) != hipSuccess || hipDeviceGetAttribute(&cus, hipDeviceAttributeMultiprocessorCount, dev) != hipSuccess) { grid = -1; return; }
        if (hipFuncSetAttribute((const void*)mk_fwd, hipFuncAttributeMaxDynamicSharedMemorySize, LDS_BYTES) != hipSuccess) { fprintf(stderr, "kernel_launch: hipFuncSetAttribute failed\n"); grid = -1; return; }
        int per_cu = 0;
        if (hipOccupancyMaxActiveBlocksPerMultiprocessor(&per_cu, (const void*)mk_fwd, NTHREADS, LDS_BYTES) != hipSuccess || per_cu < 1) { fprintf(stderr, "kernel_launch: occupancy query says %d\n", per_cu); }
        (void)hipGetLastError();
        grid = cus;
    }
    if (grid < 0) return;
    (void)hipMemsetAsync((char*)d_ws + WS_CTL, 0, CTL_ZERO_BYTES, stream);
    Args a{};
    for (int i = 0; i < N_IN; ++i) a.in[i] = (const float*)d_in[i];
    a.out = (float*)d_out; a.ws = (unsigned char*)d_ws;
#if MK_ONE_LAUNCH
    a.ph_lo = 0; a.ph_hi = N_PHASES;
    hipLaunchKernelGGL(mk_fwd, dim3(grid), dim3(NTHREADS), LDS_BYTES, stream, a);
#else
    for (int p = 0; p < N_PHASES; ++p) { a.ph_lo = p; a.ph_hi = p + 1; hipLaunchKernelGGL(mk_fwd, dim3(grid), dim3(NTHREADS), LDS_BYTES, stream, a); }
#endif
}
```
